# Optimizing an MI355X kernel written in HIP

```python
import math
import jax, jax.numpy as jnp
from jax import lax
import numpy as np

D_MODEL = 1024
BATCH = 4
SEQ = 4096
DEPTH = 4

MLA_HEADS = 4
MLA_NOPE = 128
MLA_ROPE = 64
MLA_V = 128
MLA_Q_RANK = 384
MLA_KV_RANK = 256
ROPE_THETA = 10000.0
DIFF_HEADS = 4
DIFF_QK = 64
DIFF_V = 2 * DIFF_QK
MIX_WIDTH = MLA_HEADS * MLA_V + DIFF_HEADS * DIFF_V
IN_SIZES = (MLA_Q_RANK, MLA_KV_RANK, MLA_ROPE,
            DIFF_HEADS * 2 * DIFF_QK, DIFF_HEADS * 2 * DIFF_QK, DIFF_HEADS * DIFF_V)
IN_COLS = MLA_Q_RANK + MLA_KV_RANK + MLA_ROPE + 3 * DIFF_HEADS * 2 * DIFF_QK
NUM_BUCKETS = 32
MAX_DISTANCE = 128
D_FF_DENSE = 2816
N_EXPERTS = 8
TOP_K = 2
D_FF_EXPERT = 3584
N_DENSE = (DEPTH + 1) // 2
N_MOE = DEPTH // 2
DN_ALPHA = (2 * DEPTH) ** 0.25
DN_BETA = (8 * DEPTH) ** -0.25
BLOCK_Q = 128

kernel_name = "hybrid_mla_diffattn_deepnorm_moe"


def layer_norm(x, g, b, eps=1e-5):
    xf = x.astype(jnp.float32)
    mu = jnp.mean(xf, -1, keepdims=True)
    var = jnp.mean(jnp.square(xf - mu), -1, keepdims=True)
    return ((xf - mu) * lax.rsqrt(var + eps) * g.astype(jnp.float32) + b.astype(jnp.float32)).astype(x.dtype)


def rms_norm(x, g, eps):
    xf = x.astype(jnp.float32)
    return (xf * lax.rsqrt(jnp.mean(jnp.square(xf), -1, keepdims=True) + eps) * g.astype(jnp.float32)).astype(x.dtype)


def rope_tables(seq):
    pos = jnp.arange(seq, dtype=jnp.float32)
    inv = 1.0 / (ROPE_THETA ** (jnp.arange(0, MLA_ROPE, 2, dtype=jnp.float32) / MLA_ROPE))
    ang = pos[:, None] * inv[None, :]
    return jnp.cos(ang), jnp.sin(ang)


def apply_rope(x, cos, sin):
    xf = x.astype(jnp.float32)
    x1, x2 = jnp.split(xf, 2, axis=-1)
    return jnp.concatenate([x1 * cos - x2 * sin, x2 * cos + x1 * sin], -1).astype(x.dtype)


def t5_causal_bucket(n):
    max_exact = NUM_BUCKETS // 2
    nf = jnp.maximum(n, 1).astype(jnp.float32)
    large = max_exact + (jnp.log(nf / max_exact) / math.log(MAX_DISTANCE / max_exact)
                         * (NUM_BUCKETS - max_exact)).astype(jnp.int32)
    large = jnp.minimum(large, NUM_BUCKETS - 1)
    return jnp.where(n < max_exact, n, large)


def _block_positions(q0, seq):
    qpos = q0 + jnp.arange(BLOCK_Q)
    kpos = jnp.arange(seq)
    return qpos, kpos, kpos[None, :] <= qpos[:, None]


def mla_attention(q_nope, q_rope, k_nope, k_rope, v):
    b, s, h, dv = v.shape
    scale = (MLA_NOPE + MLA_ROPE) ** -0.5

    def block(q0):
        qn = lax.dynamic_slice_in_dim(q_nope, q0, BLOCK_Q, 1)
        qr = lax.dynamic_slice_in_dim(q_rope, q0, BLOCK_Q, 1)
        logits = (jnp.einsum('bqhd,bkhd->bhqk', qn, k_nope).astype(jnp.float32)
                  + jnp.einsum('bqhd,bkd->bhqk', qr, k_rope).astype(jnp.float32)) * scale
        _, _, mask = _block_positions(q0, s)
        p = jax.nn.softmax(jnp.where(mask, logits, -jnp.inf), axis=-1).astype(v.dtype)
        return jnp.einsum('bhqk,bkhd->bqhd', p, v)

    out = lax.map(block, jnp.arange(s // BLOCK_Q) * BLOCK_Q)
    return jnp.moveaxis(out, 0, 1).reshape(b, s, h, dv)


def diff_attention(q, k, v, bias_dist, lam):
    b, s, h, dv = v.shape
    scale = DIFF_QK ** -0.5

    def block(q0):
        qb = lax.dynamic_slice_in_dim(q, q0, BLOCK_Q, 1)
        logits = jnp.einsum('bqhcd,bkhcd->bhcqk', qb, k).astype(jnp.float32) * scale
        qpos, kpos, mask = _block_positions(q0, s)
        rel = jnp.maximum(qpos[:, None] - kpos[None, :], 0)
        bias = jnp.transpose(bias_dist[rel], (2, 0, 1))
        logits = jnp.where(mask, logits + bias[None, :, None], -jnp.inf)
        p = jax.nn.softmax(logits, axis=-1)
        a = (p[:, :, 0] - lam * p[:, :, 1]).astype(v.dtype)
        return jnp.einsum('bhqk,bkhd->bqhd', a, v)

    out = lax.map(block, jnp.arange(s // BLOCK_Q) * BLOCK_Q)
    return jnp.moveaxis(out, 0, 1).reshape(b, s, h, dv)


def hybrid_mixer(x, w_in, q_norm, kv_norm, w_uq, w_uk, w_uv, lam_params, diff_norm, w_o,
                 cos, sin, bias_dist, lambda_init):
    b, s, _ = x.shape
    h = x @ w_in
    splits, acc = [], 0
    for size in IN_SIZES[:-1]:
        acc += size
        splits.append(acc)
    c_q, c_kv, k_r, dq, dk, dv = jnp.split(h, splits, axis=-1)

    q = (rms_norm(c_q, q_norm, 1e-6) @ w_uq).reshape(b, s, MLA_HEADS, MLA_NOPE + MLA_ROPE)
    q_nope = q[..., :MLA_NOPE]
    q_rope = apply_rope(q[..., MLA_NOPE:], cos[None, :, None], sin[None, :, None])
    c_kv = rms_norm(c_kv, kv_norm, 1e-6)
    k_nope = (c_kv @ w_uk).reshape(b, s, MLA_HEADS, MLA_NOPE)
    v_mla = (c_kv @ w_uv).reshape(b, s, MLA_HEADS, MLA_V)
    k_rope = apply_rope(k_r, cos[None], sin[None])
    mla_out = mla_attention(q_nope, q_rope, k_nope, k_rope, v_mla).reshape(b, s, MLA_HEADS * MLA_V)

    lp = lam_params.astype(jnp.float32)
    lam = jnp.exp(jnp.sum(lp[0] * lp[1])) - jnp.exp(jnp.sum(lp[2] * lp[3])) + lambda_init
    dq = dq.reshape(b, s, DIFF_HEADS, 2, DIFF_QK)
    dk = dk.reshape(b, s, DIFF_HEADS, 2, DIFF_QK)
    dv = dv.reshape(b, s, DIFF_HEADS, DIFF_V)
    d_out = diff_attention(dq, dk, dv, bias_dist, lam)
    d_out = rms_norm(d_out, diff_norm, 1e-5) * (1.0 - lambda_init)

    merged = jnp.concatenate([mla_out, d_out.reshape(b, s, DIFF_HEADS * DIFF_V)], axis=-1)
    return merged @ w_o


def swiglu(x, wg, wu, wd):
    return (jax.nn.silu(x @ wg) * (x @ wu)) @ wd


def moe_swiglu(x, router, wg, wu, wd):
    b, s, d = x.shape
    xf = x.reshape(b * s, d)
    logits = (xf @ router).astype(jnp.float32)
    top_v, top_i = lax.top_k(logits, TOP_K)
    gates = jax.nn.softmax(top_v, axis=-1)
    dense_g = jnp.sum(jax.nn.one_hot(top_i, N_EXPERTS, dtype=jnp.float32) * gates[..., None], axis=1).astype(x.dtype)
    y = jnp.zeros_like(xf)
    for e in range(N_EXPERTS):
        y = y + dense_g[:, e:e + 1] * swiglu(xf, wg[e], wu[e], wd[e])
    return y.reshape(b, s, d)


def setup_inputs(seed: int = 0) -> dict:
    key = jax.random.key(seed)
    ks = jax.random.split(key, 24)

    def nrm(k, shape, scale):
        return jax.random.normal(k, shape, jnp.float32) * scale

    col_scale = jnp.concatenate([jnp.ones((IN_COLS - DIFF_HEADS * DIFF_V,), jnp.float32),
                                 jnp.full((DIFF_HEADS * DIFF_V,), DN_BETA, jnp.float32)])
    return {
        "x": nrm(ks[0], (BATCH, SEQ, D_MODEL), 1.0),
        "rel_bias": nrm(ks[1], (NUM_BUCKETS, DIFF_HEADS), 0.5),
        "w_in": nrm(ks[2], (DEPTH, D_MODEL, IN_COLS), D_MODEL ** -0.5) * col_scale,
        "mla_q_norm": 1.0 + nrm(ks[3], (DEPTH, MLA_Q_RANK), 0.02),
        "mla_kv_norm": 1.0 + nrm(ks[4], (DEPTH, MLA_KV_RANK), 0.02),
        "mla_w_uq": nrm(ks[5], (DEPTH, MLA_Q_RANK, MLA_HEADS * (MLA_NOPE + MLA_ROPE)), MLA_Q_RANK ** -0.5),
        "mla_w_uk": nrm(ks[6], (DEPTH, MLA_KV_RANK, MLA_HEADS * MLA_NOPE), MLA_KV_RANK ** -0.5),
        "mla_w_uv": nrm(ks[7], (DEPTH, MLA_KV_RANK, MLA_HEADS * MLA_V), MLA_KV_RANK ** -0.5 * DN_BETA),
        "diff_lambda": nrm(ks[8], (DEPTH, 4, DIFF_QK), 0.1),
        "diff_norm": 1.0 + nrm(ks[9], (DEPTH, DIFF_V), 0.02),
        "w_o": nrm(ks[10], (DEPTH, MIX_WIDTH, D_MODEL), MIX_WIDTH ** -0.5 * DN_BETA),
        "ln1_g": 1.0 + nrm(ks[11], (DEPTH, D_MODEL), 0.02),
        "ln1_b": nrm(ks[12], (DEPTH, D_MODEL), 0.02),
        "ln2_g": 1.0 + nrm(ks[13], (DEPTH, D_MODEL), 0.02),
        "ln2_b": nrm(ks[14], (DEPTH, D_MODEL), 0.02),
        "ffn_w_gate": nrm(ks[15], (N_DENSE, D_MODEL, D_FF_DENSE), D_MODEL ** -0.5 * DN_BETA),
        "ffn_w_up": nrm(ks[16], (N_DENSE, D_MODEL, D_FF_DENSE), D_MODEL ** -0.5 * DN_BETA),
        "ffn_w_down": nrm(ks[17], (N_DENSE, D_FF_DENSE, D_MODEL), D_FF_DENSE ** -0.5 * DN_BETA),
        "moe_router": nrm(ks[18], (N_MOE, D_MODEL, N_EXPERTS), D_MODEL ** -0.5),
        "moe_w_gate": nrm(ks[19], (N_MOE, N_EXPERTS, D_MODEL, D_FF_EXPERT), D_MODEL ** -0.5 * DN_BETA),
        "moe_w_up": nrm(ks[20], (N_MOE, N_EXPERTS, D_MODEL, D_FF_EXPERT), D_MODEL ** -0.5 * DN_BETA),
        "moe_w_down": nrm(ks[21], (N_MOE, N_EXPERTS, D_FF_EXPERT, D_MODEL), D_FF_EXPERT ** -0.5 * DN_BETA),
    }


def reference(x, rel_bias, w_in, mla_q_norm, mla_kv_norm, mla_w_uq, mla_w_uk, mla_w_uv,
              diff_lambda, diff_norm, w_o, ln1_g, ln1_b, ln2_g, ln2_b,
              ffn_w_gate, ffn_w_up, ffn_w_down, moe_router, moe_w_gate, moe_w_up, moe_w_down):
    seq = x.shape[1]
    cos, sin = rope_tables(seq)
    bias_dist = rel_bias.astype(jnp.float32)[t5_causal_bucket(jnp.arange(seq))]
    for l in range(DEPTH):
        lambda_init = 0.8 - 0.6 * math.exp(-0.3 * l)
        mix = hybrid_mixer(x, w_in[l], mla_q_norm[l], mla_kv_norm[l], mla_w_uq[l], mla_w_uk[l],
                           mla_w_uv[l], diff_lambda[l], diff_norm[l], w_o[l],
                           cos, sin, bias_dist, lambda_init)
        x = layer_norm(DN_ALPHA * x + mix, ln1_g[l], ln1_b[l])
        if l % 2 == 0:
            f = swiglu(x, ffn_w_gate[l // 2], ffn_w_up[l // 2], ffn_w_down[l // 2])
        else:
            f = moe_swiglu(x, moe_router[l // 2], moe_w_gate[l // 2], moe_w_up[l // 2], moe_w_down[l // 2])
        x = layer_norm(DN_ALPHA * x + f, ln2_g[l], ln2_b[l])
    return x
```

```cpp
#include <hip/hip_runtime.h>
#include <hip/hip_cooperative_groups.h>
#include <cstdint>
#include <cstdio>
#include <cmath>
namespace cg = cooperative_groups;

#ifndef PIPE_MLA
#define PIPE_MLA true
#endif
#ifndef PIPE_DIFF
#define PIPE_DIFF true
#endif
#ifndef MK_SPLIT
#define MK_SPLIT 0
#endif

#define LAS __attribute__((address_space(3)))
typedef unsigned short bf16_t;
typedef short bf16x8 __attribute__((ext_vector_type(8)));
typedef short s16x4 __attribute__((ext_vector_type(4)));
typedef float f32x2 __attribute__((ext_vector_type(2)));
typedef float f32x4 __attribute__((ext_vector_type(4)));
typedef float f32x16 __attribute__((ext_vector_type(16)));
typedef unsigned u32x2 __attribute__((ext_vector_type(2)));
typedef unsigned u32x4 __attribute__((ext_vector_type(4)));
typedef int i32x4 __attribute__((ext_vector_type(4)));
typedef int i32x8 __attribute__((ext_vector_type(8)));

constexpr int M = 16384, DM = 1024, SEQ = 4096, DEPTH = 4;
constexpr int HC = 2304;
constexpr int QMC = 768, KVC = 1024;
constexpr int FFD = 2816, FFE = 3584, NEXP = 8;
constexpr int SLOTS = 32768 + 8 * 256;
constexpr float LOG2E = 1.4426950408889634f;
constexpr float DN_ALPHA = 1.681792830507429f;
constexpr int C_CQ = 0, C_CKV = 384, C_KR = 640, C_DQ = 704, C_DK = 1216, C_DV = 1728;

constexpr size_t MiB = 1u << 20;
constexpr size_t WS_CTL = 0, WS_TAB = 1 * MiB, WS_SS = 2 * MiB;
constexpr size_t WS_WIN = 4 * MiB, WS_WUQ = 22 * MiB, WS_WUKV = 25 * MiB, WS_WO = 27 * MiB, WS_WGU = 35 * MiB, WS_WD = 57 * MiB;
constexpr size_t WS_MGU = 68 * MiB, WS_MD = 180 * MiB;
constexpr size_t WS_X = 236 * MiB, WS_XB = 300 * MiB, WS_Y = 332 * MiB, WS_OV = 396 * MiB;
constexpr size_t WS_H = WS_OV, WS_QM = WS_OV + 72 * MiB, WS_KVB = WS_OV + 96 * MiB, WS_MRG = WS_OV + 128 * MiB, WS_O0 = WS_OV + 160 * MiB;
constexpr size_t WS_ACT = WS_OV;
constexpr size_t WS_XG = WS_OV, WS_MACT = WS_OV + 68 * MiB, WS_OSLOT = WS_OV + 306 * MiB;
constexpr size_t WS_ROUTE = WS_OV + 374 * MiB;
constexpr size_t WS_OSLOT2 = WS_OV + 376 * MiB;
constexpr size_t WS_XB8 = WS_OV + 444 * MiB;
constexpr size_t WS_END = WS_OV + 460 * MiB;
constexpr int CW_CNT = 0, CW_CUR = 64;

constexpr int LDS_BYTES = 147456;
constexpr float W8_GU = 64.0f, W8_D = 128.0f, A8_ACT = 8.0f, O8 = 64.0f;

__device__ __forceinline__ unsigned cvt_pk_bf16(float lo, float hi) { unsigned r; asm volatile("v_cvt_pk_bf16_f32 %0, %1, %2" : "=v"(r) : "v"(lo), "v"(hi)); return r; }
__device__ __forceinline__ i32x8 cat8(bf16x8 a, bf16x8 b) { const i32x4 x = __builtin_bit_cast(i32x4, a), y = __builtin_bit_cast(i32x4, b); return __builtin_shufflevector(x, y, 0, 1, 2, 3, 4, 5, 6, 7); }
__device__ __forceinline__ bf16x8 lo8(i32x8 v) { return __builtin_bit_cast(bf16x8, __builtin_shufflevector(v, v, 0, 1, 2, 3)); }
__device__ __forceinline__ bf16x8 hi8(i32x8 v) { return __builtin_bit_cast(bf16x8, __builtin_shufflevector(v, v, 4, 5, 6, 7)); }
__device__ __forceinline__ unsigned cvt4_fp8(float a, float b, float c, float d) { unsigned w = __builtin_amdgcn_cvt_pk_fp8_f32(a, b, 0u, false); return (unsigned)__builtin_amdgcn_cvt_pk_fp8_f32(c, d, (int)w, true); }
__device__ __forceinline__ float bf2f(unsigned short b) { return __uint_as_float(((unsigned)b) << 16); }
__device__ __forceinline__ float wave_sum(float v) {
#pragma unroll
    for (int o = 1; o < 64; o <<= 1) v += __shfl_xor(v, o);
    return v;
}
__device__ __forceinline__ int fresh_lane() { int t = threadIdx.x; asm volatile("" : "+v"(t)); return t & 63; }
__device__ __forceinline__ int obx() { int b = blockIdx.x; asm volatile("" : "+s"(b)); return b; }
__device__ __forceinline__ int oi(int k) { asm volatile("" : "+s"(k)); return k; }
typedef __attribute__((address_space(1))) unsigned char* gptr_t;
typedef __attribute__((address_space(1))) const float* gfptr_t;
#if defined(__HIP_DEVICE_COMPILE__)
#define ASSUME_GLOBAL(p) __builtin_assume(!__builtin_amdgcn_is_shared((const __attribute__((address_space(0))) void*)(p)) && !__builtin_amdgcn_is_private((const __attribute__((address_space(0))) void*)(p)))
#else
#define ASSUME_GLOBAL(p) ((void)0)
#endif
__device__ __forceinline__ size_t oz() { size_t z = 0; asm volatile("" : "+s"(z)); return z; }
#define opq(p) ((p) + oz())
__device__ __forceinline__ const float* gfp(const float* p) { ASSUME_GLOBAL(p); return p; }
#define LDS_WAIT() asm volatile("s_waitcnt lgkmcnt(0)" ::: "memory")
#define VM_WAIT() asm volatile("s_waitcnt vmcnt(0)" ::: "memory")

namespace pg8 {
constexpr int BM = 256, BK = 64, HALF = 128, HTB = HALF * BK * 2, NXCD = 8, WGM = 8;
__host__ __device__ __forceinline__ int lds_byte(int r, int c) { const int st = (r >> 4) * 2 + (c >> 5), rr = r & 15, cc = c & 31, ob = rr * 64 + cc * 2; return st * 1024 + (ob ^ (((ob >> 9) & 1) << 5)); }
__host__ __device__ __forceinline__ void stage_rc(int b, int& R, int& C) { const int st = b / 1024, sb = b % 1024, swz = sb ^ (((sb >> 9) & 1) << 5); R = (st >> 1) * 16 + swz / 64; C = (st & 1) * 32 + (swz % 64) / 2; }
__host__ __device__ __forceinline__ int perm32(int rho) { const int n = rho >> 4, i = rho & 15; return 8 * (i >> 2) + 4 * n + (i & 3); }

struct Unit { int pm, pn, bt, ko, os; };

struct StaticOrder {
    int nM, nN, nwg, G, c;
    __device__ __forceinline__ void init(int Mr, int N, int G_, int c_) { nM = Mr / BM; nN = N / BM; nwg = nM * nN; G = G_; c = c_; }
    __device__ __forceinline__ bool next(int i, Unit& u) const {
        const long L = (long)i * G + c; if (L >= nwg) return false;
        int wgid = (int)L; { const int q = nwg / NXCD, r = nwg % NXCD, xcd = wgid % NXCD, off = wgid / NXCD; wgid = (xcd < r ? xcd * (q + 1) : r * (q + 1) + (xcd - r) * q) + off; }
        const int nig = WGM * nN, gid = wgid / nig, fm = gid * WGM, gsz = (nM - fm) < WGM ? (nM - fm) : WGM;
        u.pm = fm + ((wgid % nig) % gsz); u.pn = (wgid % nig) / gsz; u.bt = u.pn; u.ko = 0; u.os = 0; return true;
    }
};
struct OneUnit {
    int pm, pn; bool valid;
    __device__ __forceinline__ bool next(int i, Unit& u) const { if (i != 0 || !valid) return false; u.pm = pm; u.pn = pn; u.bt = pn; u.ko = 0; u.os = 0; return true; }
};
struct MoeOrder {
    int t0, t1, t2, t3, t4, t5, t6, t7; int NT, G, c, total, ks, kh;
    __device__ __forceinline__ bool next(int i, Unit& u) const {
        const int cc = (G % 8 == 0) ? (c % 8) * (G / 8) + c / 8 : c;
        const long L = (long)i * G + cc; if (L >= total) return false;
        int acc = 0, e = 0, base = 0, te = 1;
#define MO_STEP(j, tj) { if (tj > 0 && L >= (long)acc * NT * ks) { e = j; base = acc; te = tj; } acc += tj; }
        MO_STEP(0, t0) MO_STEP(1, t1) MO_STEP(2, t2) MO_STEP(3, t3) MO_STEP(4, t4) MO_STEP(5, t5) MO_STEP(6, t6) MO_STEP(7, t7)
#undef MO_STEP
        const int loc = (int)(L - (long)base * NT * ks), sp = loc % ks, rest = loc / ks;
        u.pm = base + rest % te; u.pn = rest / te; u.bt = e * NT + u.pn; u.ko = sp * kh; u.os = sp; return true;
    }
};

template <class Epi, class Sched, bool F8 = false>
__device__ __forceinline__ void gemm_phase(LAS unsigned char* lds, const bf16_t* Ag, int lda, const bf16_t* Btg, int ldb, int K, const Sched& S, const Epi& E) {
    asm volatile("" : "+s"(K));
    int tid_ = threadIdx.x; asm volatile("" : "+v"(tid_));
    const int tid = tid_, wid = __builtin_amdgcn_readfirstlane(tid >> 6), lane = tid & 63, wr = wid >> 2, wc = wid & 3, fr = lane & 15, fq = lane >> 4;
    const int nt = K / BK;
    unsigned voffA[2], voffB[2];
#pragma unroll
    for (int i = 0; i < 2; ++i) { int R, C; stage_rc(tid * 16 + i * 8192, R, C); const int Rb = Epi::PERM ? ((R & ~31) + perm32(R & 31)) : R;
        voffA[i] = (unsigned)(R * lda + C) * 2u; voffB[i] = (unsigned)(Rb * ldb + C) * 2u; }
    const size_t kstep = (size_t)(BK * 2);
    const size_t hstepA = (size_t)HALF * lda * 2, hstepB = (size_t)HALF * ldb * 2;
    const size_t tstepA = 2 * hstepA, tstepB = 2 * hstepB;
    const unsigned ldsw = (unsigned)wid * 1024u;
    const int aoff = lds_byte(wr * 64 + fr, fq * 8), boff = lds_byte(wc * 32 + fr, fq * 8);
#define PG8_SA(b, h) (((b) * 2 + (h)) * HTB)
#define PG8_SB(b, h) ((4 + (b) * 2 + (h)) * HTB)
#define PG8_STAGE(bufoff, gbase, voff) do { _Pragma("unroll") for (int _i = 0; _i < 2; ++_i) \
        __builtin_amdgcn_global_load_lds((const unsigned*)((const char*)(gbase) + (voff)[_i]), (LAS unsigned*)(lds + (bufoff) + ldsw + _i * 8192), 16, 0, 0); } while (0)
#define PG8_LDA(dst, b, h) do { _Pragma("unroll") for (int m = 0; m < 4; ++m) dst[m] = cat8(*(const LAS bf16x8*)(lds + PG8_SA(b, h) + aoff + m * 2048), *(const LAS bf16x8*)(lds + PG8_SA(b, h) + aoff + m * 2048 + 1024)); } while (0)
#define PG8_LDB(dst, b, h) do { _Pragma("unroll") for (int n = 0; n < 2; ++n) dst[n] = cat8(*(const LAS bf16x8*)(lds + PG8_SB(b, h) + boff + n * 2048), *(const LAS bf16x8*)(lds + PG8_SB(b, h) + boff + n * 2048 + 1024)); } while (0)
#define PG8_MMA(ai, bj, At, Bt) do { __builtin_amdgcn_s_setprio(1); _Pragma("unroll") for (int m = 0; m < 4; ++m) _Pragma("unroll") for (int n = 0; n < 2; ++n) { \
        if constexpr (F8) asm volatile("v_mfma_f32_16x16x128_f8f6f4 %0, %1, %2, %0" : "+v"(acc[ai][bj][m][n]) : "v"(Bt[n]), "v"(At[m]));   \
        else { acc[ai][bj][m][n] = __builtin_amdgcn_mfma_f32_16x16x32_bf16(lo8(Bt[n]), lo8(At[m]), acc[ai][bj][m][n], 0, 0, 0); \
               acc[ai][bj][m][n] = __builtin_amdgcn_mfma_f32_16x16x32_bf16(hi8(Bt[n]), hi8(At[m]), acc[ai][bj][m][n], 0, 0, 0); } } \
        __builtin_amdgcn_s_setprio(0); } while (0)
#define PG8_WAIT_V(n) asm volatile("s_waitcnt vmcnt(" #n ")" ::: "memory")
#define PG8_WAIT_L(n) asm volatile("s_waitcnt lgkmcnt(" #n ")" ::: "memory")
#define PG8_BAR __builtin_amdgcn_s_barrier()
#define PG8_SCHED __builtin_amdgcn_sched_barrier(0)
    Unit cur, nxt; int ui = 0;
    if (!S.next(0, cur)) return;
    f32x4 acc[2][2][4][2];
#pragma unroll
    for (int a = 0; a < 2; ++a)
#pragma unroll
        for (int b = 0; b < 2; ++b)
#pragma unroll
            for (int m = 0; m < 4; ++m)
#pragma unroll
                for (int n = 0; n < 2; ++n) acc[a][b][m][n] = (f32x4){0.f, 0.f, 0.f, 0.f};
    i32x8 At[4], B0[2], B1[2];
    const char* cA = (const char*)Ag + (size_t)cur.pm * tstepA + (size_t)cur.ko * 2; const char* cB = (const char*)Btg + (size_t)cur.bt * tstepB + (size_t)cur.ko * 2;
    PG8_STAGE(PG8_SB(0, 0), cB, voffB); PG8_STAGE(PG8_SB(0, 1), cB + hstepB, voffB); PG8_STAGE(PG8_SA(0, 0), cA, voffA); PG8_STAGE(PG8_SA(0, 1), cA + hstepA, voffA);
    if (wr == 1) PG8_BAR;
    PG8_WAIT_V(2); PG8_BAR;
    PG8_STAGE(PG8_SB(1, 0), cB + kstep, voffB); PG8_STAGE(PG8_SA(1, 0), cA + kstep, voffA); PG8_STAGE(PG8_SB(1, 1), cB + hstepB + kstep, voffB);
    PG8_WAIT_V(6); PG8_BAR;
    for (;;) {
        const bool has_next = S.next(ui + 1, nxt);
        const char* nA = has_next ? (const char*)Ag + (size_t)nxt.pm * tstepA + (size_t)nxt.ko * 2 : cA; const char* nB = has_next ? (const char*)Btg + (size_t)nxt.bt * tstepB + (size_t)nxt.ko * 2 : cB;
        for (int t = 0; t < nt; t += 2) {
            const bool last = (t == nt - 2);
            const char* a1 = cA + (size_t)(t + 1) * kstep;
            const char* a2 = last ? nA : cA + (size_t)(t + 2) * kstep; const char* b2 = last ? nB : cB + (size_t)(t + 2) * kstep;
            const char* a3 = a2 + kstep; const char* b3 = b2 + kstep;
            PG8_LDB(B0, 0, 0); PG8_LDB(B1, 0, 1); PG8_SCHED; PG8_LDA(At, 0, 0); PG8_STAGE(PG8_SA(1, 1), a1 + hstepA, voffA);
            PG8_WAIT_V(8); PG8_WAIT_L(0); PG8_BAR; PG8_MMA(0, 0, At, B0); PG8_MMA(0, 1, At, B1); PG8_BAR; PG8_SCHED;
            PG8_LDA(At, 0, 1); PG8_STAGE(PG8_SB(0, 0), b2, voffB); PG8_STAGE(PG8_SB(0, 1), b2 + hstepB, voffB); PG8_STAGE(PG8_SA(0, 0), a2, voffA);
            PG8_WAIT_V(8); PG8_WAIT_L(0); PG8_BAR; PG8_MMA(1, 0, At, B0); PG8_MMA(1, 1, At, B1); PG8_BAR; PG8_SCHED;
            PG8_LDB(B0, 1, 0); PG8_LDB(B1, 1, 1); PG8_SCHED; PG8_LDA(At, 1, 0); PG8_STAGE(PG8_SA(0, 1), a2 + hstepA, voffA);
            PG8_WAIT_V(8); PG8_WAIT_L(0); PG8_BAR; PG8_MMA(0, 0, At, B0); PG8_MMA(0, 1, At, B1); PG8_BAR; PG8_SCHED;
            PG8_LDA(At, 1, 1); PG8_STAGE(PG8_SB(1, 0), b3, voffB); PG8_STAGE(PG8_SB(1, 1), b3 + hstepB, voffB); PG8_STAGE(PG8_SA(1, 0), a3, voffA);
            PG8_WAIT_V(8); PG8_WAIT_L(0); PG8_BAR; PG8_MMA(1, 0, At, B0); PG8_MMA(1, 1, At, B1); PG8_BAR; PG8_SCHED;
        }
        if (wr == 0) PG8_BAR;
        if constexpr (F8) asm volatile("s_nop 15\n\ts_nop 15\n\ts_nop 15" ::: "memory");
        E(acc, cur, wr, wc, fr, fq);
        if (!has_next) break;
#pragma unroll
        for (int a = 0; a < 2; ++a)
#pragma unroll
            for (int b = 0; b < 2; ++b)
#pragma unroll
                for (int m = 0; m < 4; ++m)
#pragma unroll
                    for (int n = 0; n < 2; ++n) acc[a][b][m][n] = (f32x4){0.f, 0.f, 0.f, 0.f};
        cur = nxt; cA = nA; cB = nB; ++ui;
        if (wr == 1) PG8_BAR;
    }
    PG8_WAIT_V(0);
    PG8_BAR;
#undef PG8_SA
#undef PG8_SB
#undef PG8_STAGE
#undef PG8_LDA
#undef PG8_LDB
#undef PG8_MMA
#undef PG8_WAIT_V
#undef PG8_WAIT_L
#undef PG8_BAR
#undef PG8_SCHED
}

__device__ __forceinline__ void store8(bf16_t* p, f32x4 v0, f32x4 v1) {
    u32x4 w; w.x = cvt_pk_bf16(v0[0], v0[1]); w.y = cvt_pk_bf16(v0[2], v0[3]); w.z = cvt_pk_bf16(v1[0], v1[1]); w.w = cvt_pk_bf16(v1[2], v1[3]);
    *(u32x4*)p = w;
}
__device__ __forceinline__ void rope8(f32x4& v0, f32x4& v1, const float* cs) {
    const f32x4 c0 = *(const f32x4*)cs, c1 = *(const f32x4*)(cs + 4);
    f32x4 o0, o1;
    o0[0] = v0[0] * c0[0] - v0[1] * c0[1]; o0[1] = v0[1] * c0[0] + v0[0] * c0[1];
    o0[2] = v0[2] * c0[2] - v0[3] * c0[3]; o0[3] = v0[3] * c0[2] + v0[2] * c0[3];
    o1[0] = v1[0] * c1[0] - v1[1] * c1[1]; o1[1] = v1[1] * c1[0] + v1[0] * c1[1];
    o1[2] = v1[2] * c1[2] - v1[3] * c1[3]; o1[3] = v1[3] * c1[2] + v1[2] * c1[3];
    v0 = o0; v1 = o1;
}
struct EpiH {
    static constexpr bool PERM = true;
    bf16_t* H; float* ssq; float* sskv; const float* tab;
    __device__ __forceinline__ void operator()(const f32x4 (&acc)[2][2][4][2], const Unit& u, int wr, int wc, int fr, int fq) const {
        const int row0 = u.pm * BM + wr * 64 + fr;
#pragma unroll
        for (int bj = 0; bj < 2; ++bj) {
            const int g32 = u.pn * BM + bj * HALF + wc * 32, col0 = g32 + 8 * fq;
            const int seg = g32 < C_CKV ? 0 : (g32 < C_KR ? 1 : (g32 < C_DQ ? 2 : 3));
#pragma unroll
            for (int ai = 0; ai < 2; ++ai)
#pragma unroll
                for (int m = 0; m < 4; ++m) {
                    const int row = row0 + ai * HALF + m * 16;
                    f32x4 v0 = acc[ai][bj][m][0], v1 = acc[ai][bj][m][1];
                    if (seg < 2) {
                        float s = (v0[0] * v0[0] + v0[1] * v0[1]) + (v0[2] * v0[2] + v0[3] * v0[3]) + (v1[0] * v1[0] + v1[1] * v1[1]) + (v1[2] * v1[2] + v1[3] * v1[3]);
                        s += __shfl_xor(s, 16); s += __shfl_xor(s, 32);
                        if (fq == 0) ssq[(size_t)row * 32 + (g32 >> 5)] = s;
                    } else if (seg == 2) {
                        rope8(v0, v1, tab + (size_t)(row & (SEQ - 1)) * 64 + (col0 - C_KR));
                    }
                    store8(H + (size_t)row * HC + col0, v0, v1);
                    asm volatile("" ::: "memory");
                }
        }
    }
};
struct EpiQ {
    static constexpr bool PERM = true;
    bf16_t* Q; const float* ssq; const float* tab;
    __device__ __forceinline__ void operator()(const f32x4 (&acc)[2][2][4][2], const Unit& u, int wr, int wc, int fr, int fq) const {
        const int row0 = u.pm * BM + wr * 64 + fr;
#pragma unroll
        for (int ai = 0; ai < 2; ++ai)
#pragma unroll
            for (int m = 0; m < 4; ++m) {
                const int row = row0 + ai * HALF + m * 16;
                const f32x4 q0 = *(const f32x4*)(ssq + (size_t)row * 32), q1 = *(const f32x4*)(ssq + (size_t)row * 32 + 4), q2 = *(const f32x4*)(ssq + (size_t)row * 32 + 8);
                const float rs = __builtin_amdgcn_rsqf((((q0[0] + q0[1]) + (q0[2] + q0[3])) + ((q1[0] + q1[1]) + (q1[2] + q1[3])) + ((q2[0] + q2[1]) + (q2[2] + q2[3]))) * (1.0f / 384.0f) + 1e-6f);
#pragma unroll
                for (int bj = 0; bj < 2; ++bj) {
                    const int g32 = u.pn * BM + bj * HALF + wc * 32, col0 = g32 + 8 * fq;
                    const int inh = g32 % 192;
                    f32x4 v0 = acc[ai][bj][m][0] * rs, v1 = acc[ai][bj][m][1] * rs;
                    if (inh >= 128) rope8(v0, v1, tab + (size_t)(row & (SEQ - 1)) * 64 + (inh - 128 + 8 * fq));
                    store8(Q + (size_t)row * QMC + col0, v0, v1);
                }
                asm volatile("" ::: "memory");
            }
    }
};
struct EpiKV {
    static constexpr bool PERM = true;
    bf16_t* O; const float* sskv;
    __device__ __forceinline__ void operator()(const f32x4 (&acc)[2][2][4][2], const Unit& u, int wr, int wc, int fr, int fq) const {
        const int row0 = u.pm * BM + wr * 64 + fr;
#pragma unroll
        for (int ai = 0; ai < 2; ++ai)
#pragma unroll
            for (int m = 0; m < 4; ++m) {
                const int row = row0 + ai * HALF + m * 16;
                const f32x4 q0 = *(const f32x4*)(sskv + (size_t)row * 32 + 12), q1 = *(const f32x4*)(sskv + (size_t)row * 32 + 16);
                const float rs = __builtin_amdgcn_rsqf((((q0[0] + q0[1]) + (q0[2] + q0[3])) + ((q1[0] + q1[1]) + (q1[2] + q1[3]))) * (1.0f / 256.0f) + 1e-6f);
#pragma unroll
                for (int bj = 0; bj < 2; ++bj) {
                    const int col0 = u.pn * BM + bj * HALF + wc * 32 + 8 * fq;
                    store8(O + (size_t)row * KVC + col0, acc[ai][bj][m][0] * rs, acc[ai][bj][m][1] * rs);
                }
            }
    }
};
struct EpiY {
    static constexpr bool PERM = false;
    const float* X; float* Y; float asc;
    __device__ __forceinline__ void operator()(const f32x4 (&acc)[2][2][4][2], const Unit& u, int wr, int wc, int fr, int fq) const {
        const int row0 = u.pm * BM + wr * 64 + fr, colb = u.pn * BM + wc * 32 + 4 * fq;
#pragma unroll
        for (int ai = 0; ai < 2; ++ai)
#pragma unroll
            for (int m = 0; m < 4; ++m) {
                const size_t off = (size_t)(row0 + ai * HALF + m * 16) * DM + colb;
#pragma unroll
                for (int bj = 0; bj < 2; ++bj)
#pragma unroll
                    for (int n = 0; n < 2; ++n) { const f32x4 xv = *(const f32x4*)(X + off + bj * HALF + n * 16); *(f32x4*)(Y + off + bj * HALF + n * 16) = xv * DN_ALPHA + acc[ai][bj][m][n] * asc; }
            }
    }
};
struct EpiYLN {
    static constexpr bool PERM = false;
    float* Y; const float* st; const float* g; const float* b; float asc; int so;
    __device__ __forceinline__ void operator()(const f32x4 (&acc)[2][2][4][2], const Unit& u, int wr, int wc, int fr, int fq) const {
        const int row0 = u.pm * BM + wr * 64 + fr, colb = u.pn * BM + wc * 32 + 4 * fq;
#pragma unroll
        for (int ai = 0; ai < 2; ++ai)
#pragma unroll
            for (int m = 0; m < 4; ++m) {
                const int row = row0 + ai * HALF + m * 16;
                const float mu = st[(size_t)row * 32 + so], rs = st[(size_t)row * 32 + so + 1];
                const size_t off = (size_t)row * DM + colb;
#pragma unroll
                for (int bj = 0; bj < 2; ++bj)
#pragma unroll
                    for (int n = 0; n < 2; ++n) { const int c = colb + bj * HALF + n * 16;
                        const f32x4 gv = *(const f32x4*)(g + c), bv = *(const f32x4*)(b + c), yv = *(const f32x4*)(Y + off + bj * HALF + n * 16);
                        *(f32x4*)(Y + off + bj * HALF + n * 16) = ((yv - mu) * rs * gv + bv) * DN_ALPHA + acc[ai][bj][m][n] * asc; }
                asm volatile("" ::: "memory");
            }
    }
};
struct EpiSwiGLU {
    static constexpr bool PERM = true;
    bf16_t* O; int ldo;
    __device__ __forceinline__ void operator()(const f32x4 (&acc)[2][2][4][2], const Unit& u, int wr, int wc, int fr, int fq) const {
        const int row0 = u.pm * BM + wr * 64 + fr, col0 = u.pn * HALF + wc * 32 + 8 * fq;
#pragma unroll
        for (int ai = 0; ai < 2; ++ai)
#pragma unroll
            for (int m = 0; m < 4; ++m) {
                f32x4 r[2];
#pragma unroll
                for (int n = 0; n < 2; ++n) { const f32x4 g = acc[ai][0][m][n], up = acc[ai][1][m][n];
#pragma unroll
                    for (int j = 0; j < 4; ++j) { const float e = __builtin_amdgcn_exp2f(-g[j] * LOG2E); r[n][j] = g[j] * __builtin_amdgcn_rcpf(1.0f + e) * up[j]; } }
                store8(O + (size_t)(row0 + ai * HALF + m * 16) * ldo + col0, r[0], r[1]);
            }
    }
};
struct EpiSwiGLU8 {
    static constexpr bool PERM = true;
    unsigned char* O; int ldo;
    __device__ __forceinline__ void operator()(const f32x4 (&acc)[2][2][4][2], const Unit& u, int wr, int wc, int fr, int fq) const {
        const int row0 = u.pm * BM + wr * 64 + fr, col0 = u.pn * HALF + wc * 32 + 8 * fq;
#pragma unroll
        for (int ai = 0; ai < 2; ++ai)
#pragma unroll
            for (int m = 0; m < 4; ++m) {
                f32x4 r[2];
#pragma unroll
                for (int n = 0; n < 2; ++n) { const f32x4 g = acc[ai][0][m][n] * (1.0f / W8_GU), up = acc[ai][1][m][n] * (A8_ACT / W8_GU);
#pragma unroll
                    for (int j = 0; j < 4; ++j) { const float e = __builtin_amdgcn_exp2f(-g[j] * LOG2E); r[n][j] = g[j] * __builtin_amdgcn_rcpf(1.0f + e) * up[j]; } }
                u32x2 w; w.x = cvt4_fp8(r[0][0], r[0][1], r[0][2], r[0][3]); w.y = cvt4_fp8(r[1][0], r[1][1], r[1][2], r[1][3]);
                *(u32x2*)(O + (size_t)(row0 + ai * HALF + m * 16) * ldo + col0) = w;
            }
    }
};
struct EpiBf16 {
    static constexpr bool PERM = true;
    bf16_t* O; int ldo; size_t sstride; float osc;
    __device__ __forceinline__ void operator()(const f32x4 (&acc)[2][2][4][2], const Unit& u, int wr, int wc, int fr, int fq) const {
        const int row0 = u.pm * BM + wr * 64 + fr;
#pragma unroll
        for (int ai = 0; ai < 2; ++ai)
#pragma unroll
            for (int m = 0; m < 4; ++m)
#pragma unroll
                for (int bj = 0; bj < 2; ++bj)
                    store8(O + (size_t)u.os * sstride + (size_t)(row0 + ai * HALF + m * 16) * ldo + u.pn * BM + bj * HALF + wc * 32 + 8 * fq, acc[ai][bj][m][0] * osc, acc[ai][bj][m][1] * osc);
    }
};
struct EpiF8 {
    static constexpr bool PERM = true;
    unsigned char* O; int ldo; size_t sstride; float osc;
    __device__ __forceinline__ void operator()(const f32x4 (&acc)[2][2][4][2], const Unit& u, int wr, int wc, int fr, int fq) const {
        const int row0 = u.pm * BM + wr * 64 + fr;
#pragma unroll
        for (int ai = 0; ai < 2; ++ai)
#pragma unroll
            for (int m = 0; m < 4; ++m)
#pragma unroll
                for (int bj = 0; bj < 2; ++bj) { const f32x4 v0 = acc[ai][bj][m][0] * osc, v1 = acc[ai][bj][m][1] * osc;
                    u32x2 w; w.x = cvt4_fp8(v0[0], v0[1], v0[2], v0[3]); w.y = cvt4_fp8(v1[0], v1[1], v1[2], v1[3]);
                    *(u32x2*)(O + (size_t)u.os * sstride + (size_t)(row0 + ai * HALF + m * 16) * ldo + u.pn * BM + bj * HALF + wc * 32 + 8 * fq) = w; }
    }
};
}

namespace att {
constexpr int NW = 8, QBLK = 32, KVBLK = 64, QB = 256;
constexpr int SHM_V = KVBLK * 128 * 2;
constexpr int LDS_K = 2 * SHM_V, LDS_WS = LDS_K + 2 * 64 * 192 * 2, LDS_BIAS = LDS_WS + NW * 64 * 4, LDS_QR = LDS_BIAS + 512;
#define SBAR() __builtin_amdgcn_sched_barrier(0)
__device__ __forceinline__ int v_st(int k, int c) { const int kk = (k & ~0xC) | ((k & 4) << 1) | ((k & 8) >> 1); return ((kk >> 3) * 4 + (c >> 5)) * 512 + ((kk & 7) * 32 + (c & 31)) * 2; }
__device__ __forceinline__ int v_rd_base(int lane) { return ((lane & 3) << 3) | (((lane >> 2) & 3) << 6) | (((lane >> 4) & 1) << 5) | (((lane >> 5) & 1) << 8); }
constexpr int v_rd_off(int d0, int ks, int half) { return d0 * 512 + ks * 4096 + half * 2048; }
__device__ __forceinline__ int crow(int r, int hi) { return (r & 3) + 8 * (r >> 2) + 4 * hi; }
__device__ __forceinline__ unsigned cvtpk(float lo, float hi) { unsigned r; asm volatile("v_cvt_pk_bf16_f32 %0, %1, %2" : "=v"(r) : "v"(lo), "v"(hi)); return r; }

__device__ __forceinline__ void mask_tile(f32x16& p0, f32x16& p1, int dq) {
    const float NEG = -__builtin_inff();
#pragma unroll
    for (int r = 0; r < 16; ++r) {
        const int c = (r & 3) + 8 * (r >> 2);
        if (dq - c < 0) p0[r] = NEG;
        if (dq - c - 32 < 0) p1[r] = NEG;
    }
}
__device__ __forceinline__ void bias_tile(f32x16& p0, f32x16& p1, int dq, const float* tb) {
#pragma unroll
    for (int r = 0; r < 16; ++r) {
        const int c = (r & 3) + 8 * (r >> 2);
        int d0 = dq - c, d1 = dq - c - 32;
        d0 = d0 < 0 ? 0 : (d0 > 127 ? 127 : d0); d1 = d1 < 0 ? 0 : (d1 > 127 ? 127 : d1);
        p0[r] += tb[d0]; p1[r] += tb[d1];
    }
}
constexpr float THR = 8.f;
__device__ __forceinline__ void partialSM(f32x16& p0, f32x16& p1, float& m_reg, float& mn, float& alpha) {
    float pmax = p0[0];
#pragma unroll
    for (int r = 1; r < 16; ++r) pmax = fmaxf(pmax, p0[r]);
#pragma unroll
    for (int r = 0; r < 16; ++r) pmax = fmaxf(pmax, p1[r]);
    { auto rr = __builtin_amdgcn_permlane32_swap(__float_as_uint(pmax), __float_as_uint(pmax), false, false);
      pmax = fmaxf(__uint_as_float(rr[0]), __uint_as_float(rr[1])); }
    if (__builtin_expect(__all((pmax - m_reg) <= THR), 1)) { mn = m_reg; alpha = 1.f; }
    else { mn = fmaxf(m_reg, pmax); alpha = __builtin_amdgcn_exp2f(m_reg - mn); m_reg = mn; }
#pragma unroll
    for (int r = 0; r < 16; ++r) p0[r] = p0[r] - mn;
#pragma unroll
    for (int r = 0; r < 16; ++r) p1[r] = p1[r] - mn;
#pragma unroll
    for (int r = 0; r < 16; ++r) p0[r] = __builtin_amdgcn_exp2f(p0[r]);
}
__device__ __forceinline__ void finishSM(f32x16& p0, f32x16& p1, float alpha, float& l_reg, bf16x8& pa0, bf16x8& pa1, bf16x8& pa2, bf16x8& pa3) {
#pragma unroll
    for (int r = 0; r < 16; ++r) p1[r] = __builtin_amdgcn_exp2f(p1[r]);
    float ps = 0;
#pragma unroll
    for (int r = 0; r < 16; ++r) ps += p0[r];
#pragma unroll
    for (int r = 0; r < 16; ++r) ps += p1[r];
    { auto rr = __builtin_amdgcn_permlane32_swap(__float_as_uint(ps), __float_as_uint(ps), false, false);
      ps = __uint_as_float(rr[0]) + __uint_as_float(rr[1]); }
    l_reg = l_reg * alpha + ps;
#define PK4(P, B_, OUT) do { unsigned a0 = cvtpk(P[B_+0], P[B_+1]), a1 = cvtpk(P[B_+2], P[B_+3]);                          \
        unsigned b0 = cvtpk(P[B_+4], P[B_+5]), b1 = cvtpk(P[B_+6], P[B_+7]);                                             \
        auto r0 = __builtin_amdgcn_permlane32_swap(a0, b0, false, false); auto r1 = __builtin_amdgcn_permlane32_swap(a1, b1, false, false); \
        u32x4 w = {r0[0], r1[0], r0[1], r1[1]}; OUT = *reinterpret_cast<bf16x8*>(&w); } while (0)
    PK4(p0, 0, pa0); PK4(p0, 8, pa1); PK4(p1, 0, pa2); PK4(p1, 8, pa3);
#undef PK4
}
template <int DQK> __device__ __forceinline__ int kswz(int row, int colB) { return row * (DQK * 2) + (colB ^ ((row & 7) << 4)); }
template <int KB, int DQK>
__device__ __forceinline__ void qkt(f32x16& p0, f32x16& p1, const char* K_lds, int r32, int hi, const bf16x8* qr, const char* qrl) {
    constexpr int SHMK = 64 * DQK * 2, NF = DQK / 16, NFR = NF > 8 ? 8 : NF;
    p0 = f32x16{}; p1 = f32x16{};
    const char* kb[4];
#pragma unroll
    for (int dd = 0; dd < 4; ++dd) kb[dd] = K_lds + KB * SHMK + kswz<DQK>(r32, (dd * 16 + hi * 8) * 2);
#pragma unroll
    for (int d0 = 0; d0 < NF; ++d0) { const char* a = kb[d0 & 3] + (d0 >> 2) * 128;
        bf16x8 b0 = *reinterpret_cast<const bf16x8*>(a);
        bf16x8 b1 = *reinterpret_cast<const bf16x8*>(a + 32 * DQK * 2);
        bf16x8 q; if (d0 < NFR) q = qr[d0]; else q = *reinterpret_cast<const bf16x8*>(qrl + (d0 - NFR) * 1024);
        p0 = __builtin_amdgcn_mfma_f32_32x32x16_bf16(b0, q, p0, 0, 0, 0);
        p1 = __builtin_amdgcn_mfma_f32_32x32x16_bf16(b1, q, p1, 0, 0, 0); }
}
template <int VB>
__device__ __forceinline__ void pv_tile(f32x16* o, int vb0, bf16x8 pa0, bf16x8 pa1, bf16x8 pa2, bf16x8 pa3) {
#define TRRD(dst, off) asm volatile("ds_read_b64_tr_b16 %0, %1 offset:%2" : "=&v"(dst) : "v"(vb0), "i"(off) : "memory")
#define PV_D0(d0) do { s16x4 l0, l1, l2, l3, h0, h1, h2, h3; constexpr int b_ = VB * SHM_V + v_rd_off(d0, 0, 0); \
        TRRD(l0, b_); TRRD(h0, b_ + 2048); TRRD(l1, b_ + 4096); TRRD(h1, b_ + 6144); TRRD(l2, b_ + 8192); TRRD(h2, b_ + 10240); TRRD(l3, b_ + 12288); TRRD(h3, b_ + 14336); \
        asm volatile("s_waitcnt lgkmcnt(0)" ::: "memory"); SBAR();   \
        o[d0] = __builtin_amdgcn_mfma_f32_32x32x16_bf16(pa0, (bf16x8){l0[0], l0[1], l0[2], l0[3], h0[0], h0[1], h0[2], h0[3]}, o[d0], 0, 0, 0);   \
        o[d0] = __builtin_amdgcn_mfma_f32_32x32x16_bf16(pa1, (bf16x8){l1[0], l1[1], l1[2], l1[3], h1[0], h1[1], h1[2], h1[3]}, o[d0], 0, 0, 0);   \
        o[d0] = __builtin_amdgcn_mfma_f32_32x32x16_bf16(pa2, (bf16x8){l2[0], l2[1], l2[2], l2[3], h2[0], h2[1], h2[2], h2[3]}, o[d0], 0, 0, 0);   \
        o[d0] = __builtin_amdgcn_mfma_f32_32x32x16_bf16(pa3, (bf16x8){l3[0], l3[1], l3[2], l3[3], h3[0], h3[1], h3[2], h3[3]}, o[d0], 0, 0, 0); } while (0)
    PV_D0(0); PV_D0(1); PV_D0(2); PV_D0(3);
#undef PV_D0
#undef TRRD
}

struct AttnArgs {
    const bf16_t* Q; const bf16_t* K; const bf16_t* K2; const bf16_t* V; int P0;
    bf16_t* Out; float* O0; float lam; const float* dnorm; float oscale;
};
template <bool MLA, int MODE, bool PIPE>
__device__ __forceinline__ void attn_block(const AttnArgs& a, char* lds) {
    constexpr int DQK = MLA ? 192 : 64, NF = DQK / 16, KROW = DQK * 2, SHMK = 64 * KROW;
    constexpr bool BIAS = !MLA;
    int tid_ = threadIdx.x; asm volatile("" : "+v"(tid_));
    const int tid = tid_, wid = __builtin_amdgcn_readfirstlane(tid >> 6), lane = tid & 63, r32 = lane & 31, hi = lane >> 5;
    constexpr int ldq = MLA ? QMC : HC, ldk = KVC, ldk2 = HC, ldv = MLA ? KVC : HC;
    const int P0 = a.P0, NT = (P0 + QB) / KVBLK;
    const int qlo = P0 + wid * QBLK, qm = qlo + r32 - 4 * hi;
    char* V_lds = lds; char* K_lds = lds + LDS_K;
    float* ws = (float*)(lds + LDS_WS) + wid * 64; float* li_l = ws; float* al_l = ws + 32;
    const float* tb = (const float*)(lds + LDS_BIAS);
    float m_reg = -1e30f, l_reg = 0; f32x16 o[4] = {};
    const int sr = tid >> 4, sc = (tid & 15) * 8, vst0 = v_st(sr, sc), vst1 = v_st(32 + sr, sc);
    const int kws = kswz<DQK>(sr, sc * 2);
    const int kr_row = tid >> 3, kr_c = (tid & 7) * 8;
    const int kws2 = kswz<DQK>(kr_row, ((MLA ? 128 : 0) + kr_c) * 2);
    const int vb0 = (int)(uintptr_t)V_lds + v_rd_base(lane);
    bf16x8 st_v0, st_v1, st_k0, st_k1, st_k2;
    constexpr int NFR = NF > 8 ? 8 : NF;
    bf16x8 qr[NFR];
    char* qrl = lds + LDS_QR + wid * 4096 + lane * 16;
#pragma unroll
    for (int d0 = 0; d0 < NFR; ++d0) qr[d0] = *reinterpret_cast<const bf16x8*>(a.Q + (size_t)(qlo + r32) * ldq + d0 * 16 + hi * 8);
#pragma unroll
    for (int d0 = NFR; d0 < NF; ++d0) *reinterpret_cast<bf16x8*>(qrl + (d0 - NFR) * 1024) = *reinterpret_cast<const bf16x8*>(a.Q + (size_t)(qlo + r32) * ldq + d0 * 16 + hi * 8);
    const unsigned voV = (unsigned)(sr * ldv + sc) * 2u, voK = (unsigned)(sr * ldk + sc) * 2u, voK2 = (unsigned)(kr_row * ldk2 + kr_c) * 2u;
    constexpr size_t v32 = (size_t)32 * ldv * 2, k32 = (size_t)32 * ldk * 2;
#define VMW() asm volatile("s_waitcnt vmcnt(0)" ::: "memory")
#define SLOAD(k0) do { const char* vb_ = (const char*)a.V + (size_t)(k0) * ldv * 2; const char* k2b_ = (const char*)a.K2 + (size_t)(k0) * ldk2 * 2; \
        st_v0 = *reinterpret_cast<const bf16x8*>(vb_ + voV); st_v1 = *reinterpret_cast<const bf16x8*>(vb_ + v32 + voV); \
        if constexpr (MLA) { const char* kb_ = (const char*)a.K + (size_t)(k0) * ldk * 2; st_k0 = *reinterpret_cast<const bf16x8*>(kb_ + voK); st_k1 = *reinterpret_cast<const bf16x8*>(kb_ + k32 + voK); } \
        st_k2 = *reinterpret_cast<const bf16x8*>(k2b_ + voK2); } while (0)
#define SWRITE(bf) do { *(bf16x8*)(V_lds + (bf) * SHM_V + vst0) = st_v0; *(bf16x8*)(V_lds + (bf) * SHM_V + vst1) = st_v1; \
        if constexpr (MLA) { *(bf16x8*)(K_lds + (bf) * SHMK + kws) = st_k0; *(bf16x8*)(K_lds + (bf) * SHMK + kws + 32 * KROW) = st_k1; } \
        *(bf16x8*)(K_lds + (bf) * SHMK + kws2) = st_k2; } while (0)
#define RESC(al) do { if (__any((al) < 1.f)) { if (hi == 0) al_l[r32] = (al); asm volatile("s_waitcnt lgkmcnt(0)" ::: "memory");              \
                     for (int d_ = 0; d_ < 4; ++d_) for (int r = 0; r < 16; ++r) o[d_][r] *= al_l[crow(r, hi)]; } } while (0)
#define KBASE(t) ((t) * KVBLK)
#define MASKT(P0_, P1_, t) do { const int kb_ = KBASE(t); \
        if (BIAS && kb_ + 176 > qlo) bias_tile(P0_, P1_, qm - kb_, tb); \
        if (kb_ + KVBLK - 1 > qlo) mask_tile(P0_, P1_, qm - kb_); } while (0)
    bf16x8 pa0, pa1, pa2, pa3;
    if constexpr (!PIPE) {
    f32x16 p0, p1; float mn, al;
    SLOAD(0); VMW(); SWRITE(0);
    __syncthreads();
#define STEP(t, BF) do { \
        if ((t) + 1 < NT) { SLOAD(KBASE((t) + 1)); } SBAR(); \
        qkt<BF, DQK>(p0, p1, K_lds, r32, hi, qr, qrl); \
        MASKT(p0, p1, (t)); partialSM(p0, p1, m_reg, mn, al); RESC(al); \
        finishSM(p0, p1, al, l_reg, pa0, pa1, pa2, pa3); SBAR(); \
        pv_tile<BF>(o, vb0, pa0, pa1, pa2, pa3); SBAR(); \
        if ((t) + 1 < NT) { VMW(); SWRITE(1 - (BF)); } \
        __syncthreads(); } while (0)
    for (int t = 0; t < NT; t += 2) { STEP(t, 0); STEP(t + 1, 1); }
#undef STEP
    } else {
    f32x16 pA0, pA1, pB0, pB1; float mnA, mnB, alA, alB;
    SLOAD(0); VMW(); SWRITE(0); SBAR();
    SLOAD(KBASE(1));
    __syncthreads();
    SBAR(); qkt<0, DQK>(pA0, pA1, K_lds, r32, hi, qr, qrl);
    MASKT(pA0, pA1, 0); partialSM(pA0, pA1, m_reg, mnA, alA);
    VMW(); SWRITE(1);
    __syncthreads();
#define HALF_STEP(PX0, PX1, mnX, alX, PY0, PY1, alY, t, KB, VB, SB) do {                                                      \
        SBAR(); qkt<KB, DQK>(PX0, PX1, K_lds, r32, hi, qr, qrl);                                                              \
        finishSM(PY0, PY1, alY, l_reg, pa0, pa1, pa2, pa3); SBAR();                                                           \
        if ((t) + 1 < NT) { SLOAD(KBASE((t) + 1)); SBAR(); }                                                                  \
        pv_tile<VB>(o, vb0, pa0, pa1, pa2, pa3); MASKT(PX0, PX1, (t)); partialSM(PX0, PX1, m_reg, mnX, alX);                  \
        __syncthreads();                                                                                                      \
        if ((t) + 1 < NT) { VMW(); SWRITE(SB); }                                                                              \
        RESC(alX); __syncthreads(); } while (0)
    for (int t = 1; t + 1 < NT; t += 2) {
        HALF_STEP(pB0, pB1, mnB, alB, pA0, pA1, alA, t, 1, 0, 0);
        HALF_STEP(pA0, pA1, mnA, alA, pB0, pB1, alB, t + 1, 0, 1, 1);
    }
#undef HALF_STEP
    SBAR(); qkt<1, DQK>(pB0, pB1, K_lds, r32, hi, qr, qrl); SBAR();
    finishSM(pA0, pA1, alA, l_reg, pa0, pa1, pa2, pa3); SBAR();
    pv_tile<0>(o, vb0, pa0, pa1, pa2, pa3);
    MASKT(pB0, pB1, NT - 1); partialSM(pB0, pB1, m_reg, mnB, alB); RESC(alB);
    finishSM(pB0, pB1, alB, l_reg, pa0, pa1, pa2, pa3); SBAR(); pv_tile<1>(o, vb0, pa0, pa1, pa2, pa3);
    SBAR();
    __syncthreads();
    }
    if (hi == 0) li_l[r32] = l_reg; asm volatile("s_waitcnt lgkmcnt(0)" ::: "memory");
    float rli[16];
#pragma unroll
    for (int r = 0; r < 16; ++r) rli[r] = __builtin_amdgcn_rcpf(li_l[crow(r, hi)]);
    if constexpr (MODE == 0) {
        bf16_t* Ow = a.Out + (size_t)qlo * 1024;
#pragma unroll
        for (int r = 0; r < 16; ++r) { const int orow = crow(r, hi);
#pragma unroll
            for (int d0 = 0; d0 < 4; ++d0) { const float v = o[d0][r] * rli[r]; const float vn = __shfl_xor(v, 1);
                if ((r32 & 1) == 0) *(unsigned*)(Ow + (size_t)orow * 1024 + d0 * 32 + r32) = cvtpk(v, vn); } }
    } else if constexpr (MODE == 1) {
        bf16_t* Ow = (bf16_t*)a.O0 + (size_t)qlo * 512;
#pragma unroll
        for (int r = 0; r < 16; ++r) { const int orow = crow(r, hi);
#pragma unroll
            for (int d0 = 0; d0 < 4; ++d0) { const float v = o[d0][r] * rli[r]; const float vn = __shfl_xor(v, 1);
                if ((r32 & 1) == 0) *(unsigned*)(Ow + (size_t)orow * 512 + d0 * 32 + r32) = cvtpk(v, vn); } }
    } else {
        const float* O0w = a.O0 + (size_t)qlo * 512;
        bf16_t* Ow = a.Out + (size_t)qlo * 1024;
        float gn[4];
#pragma unroll
        for (int d0 = 0; d0 < 4; ++d0) gn[d0] = a.dnorm[d0 * 32 + r32] * a.oscale;
#pragma unroll
        for (int r = 0; r < 16; ++r) { const int orow = crow(r, hi);
            float d[4]; float ss = 0.f;
#pragma unroll
            for (int d0 = 0; d0 < 4; ++d0) { d[d0] = O0w[(size_t)orow * 512 + d0 * 32 + r32] - a.lam * (o[d0][r] * rli[r]); ss += d[d0] * d[d0]; }
#pragma unroll
            for (int s = 1; s < 32; s <<= 1) ss += __shfl_xor(ss, s);
            const float rs = __builtin_amdgcn_rsqf(ss * (1.0f / 128.0f) + 1e-5f);
#pragma unroll
            for (int d0 = 0; d0 < 4; ++d0) { const float v = d[d0] * rs * gn[d0]; const float vn = __shfl_xor(v, 1);
                if ((r32 & 1) == 0) *(unsigned*)(Ow + (size_t)orow * 1024 + d0 * 32 + r32) = cvtpk(v, vn); } }
    }
    __syncthreads();
#undef VMW
#undef SLOAD
#undef SWRITE
#undef RESC
#undef KBASE
#undef MASKT
#undef HALF_STEP
}
#undef SBAR
}

struct Args {
    const float* in[22]; float* out; unsigned char* ws;
    float inv[32];
    float lam_init[4];
    unsigned char bucket[128];
    unsigned short aq[32];
    int ph_lo, ph_hi;
};

template <class F, bool F8OUT = false>
__device__ __forceinline__ void cvt_item(const F& f, const float* kscale, int K, bf16_t* WT, LAS float* scr, int item, int nblk, int lane, float mul = 1.0f) {
    const int kb = item / nblk, nb = item % nblk, k0 = 64 * kb, n0 = 32 * nb;
    if (f.contig(n0)) {
        const float* base; int ld; float sc; f(n0, base, ld, sc); sc *= mul;
        const int r8 = lane >> 3, c4 = (lane & 7) * 4;
        f32x4 v[8];
#pragma unroll
        for (int i = 0; i < 8; ++i) v[i] = __builtin_nontemporal_load((const f32x4*)(base + (size_t)(k0 + 8 * i + r8) * ld + c4));
#pragma unroll
        for (int i = 0; i < 8; ++i) { const int kk = 8 * i + r8; const float m = kscale ? sc * kscale[k0 + kk] : sc;
            scr[kk * 33 + c4 + 0] = v[i][0] * m; scr[kk * 33 + c4 + 1] = v[i][1] * m; scr[kk * 33 + c4 + 2] = v[i][2] * m; scr[kk * 33 + c4 + 3] = v[i][3] * m; }
    } else {
        const float* src; int ld; float sc; f(n0 + (lane & 31), src, ld, sc); sc *= mul;
#pragma unroll 8
        for (int i = 0; i < 32; ++i) { const int kk = 2 * i + (lane >> 5); float v = src[(size_t)(k0 + kk) * ld] * sc; if (kscale) v *= kscale[k0 + kk]; scr[kk * 33 + (lane & 31)] = v; }
    }
    LDS_WAIT(); asm volatile("" ::: "memory");
    const int c = lane & 7;
#pragma unroll
    for (int j = 0; j < 4; ++j) { const int n = (lane >> 3) + 8 * j; const LAS float* s = scr + (8 * c) * 33 + n;
        if constexpr (F8OUT) {
            u32x2 o; o.x = cvt4_fp8(s[0 * 33], s[1 * 33], s[2 * 33], s[3 * 33]); o.y = cvt4_fp8(s[4 * 33], s[5 * 33], s[6 * 33], s[7 * 33]);
            *(u32x2*)((unsigned char*)WT + (size_t)(n0 + n) * K + k0 + 8 * c) = o;
        } else {
            u32x4 o; o.x = cvt_pk_bf16(s[0 * 33], s[1 * 33]); o.y = cvt_pk_bf16(s[2 * 33], s[3 * 33]); o.z = cvt_pk_bf16(s[4 * 33], s[5 * 33]); o.w = cvt_pk_bf16(s[6 * 33], s[7 * 33]);
            *(u32x4*)(WT + (size_t)(n0 + n) * K + k0 + 8 * c) = o; } }
    LDS_WAIT(); asm volatile("" ::: "memory");
}
struct MapWin { const float* W;
    __device__ __forceinline__ bool contig(int n0) const { return !(n0 >= C_KR && n0 < C_DQ); }
    __device__ __forceinline__ void operator()(int n, const float*& src, int& ld, float& sc) const {
        ld = 2240; sc = 1.f; int c = n;
        if (n >= 2240) { c = 0; sc = 0.f; }
        else if (n >= C_KR && n < C_DQ) { const int j = n - C_KR, i = j >> 1; c = C_KR + ((j & 1) ? 32 + i : i); }
        else if (n >= C_DQ && n < C_DK) sc = 0.125f * LOG2E;
        src = W + c; } };
struct MapWuq { const float* W;
    __device__ __forceinline__ bool contig(int n0) const { return (n0 % 192) < 128; }
    __device__ __forceinline__ void operator()(int n, const float*& src, int& ld, float& sc) const {
        ld = 768; sc = 0.07216878364870323f * LOG2E;
        const int hh = n / 192, j = n % 192; int c = j;
        if (j >= 128) { const int jj = j - 128, i = jj >> 1; c = 128 + ((jj & 1) ? 32 + i : i); }
        src = W + hh * 192 + c; } };
struct MapWukv { const float* Wk; const float* Wv;
    __device__ __forceinline__ bool contig(int) const { return true; }
    __device__ __forceinline__ void operator()(int n, const float*& src, int& ld, float& sc) const { ld = 512; sc = 1.f; src = n < 512 ? Wk + n : Wv + (n - 512); } };
struct MapPlain { const float* W; int N;
    __device__ __forceinline__ bool contig(int) const { return true; }
    __device__ __forceinline__ void operator()(int n, const float*& src, int& ld, float& sc) const { ld = N; sc = 1.f; src = W + n; } };
struct MapGU { const float* Wg; const float* Wu; int F;
    __device__ __forceinline__ bool contig(int) const { return true; }
    __device__ __forceinline__ void operator()(int n, const float*& src, int& ld, float& sc) const { ld = F; sc = 1.f; const int pn = n >> 8, j = n & 255; src = (j < 128) ? Wg + pn * 128 + j : Wu + pn * 128 + (j - 128); } };

__device__ __forceinline__ void cvt_moe(const Args& a, int ml, LAS float* scr, int gw, int NGW, int lane) {
    asm volatile("" : "+v"(lane));
    constexpr int I_GU = (DM / 64) * (2 * FFE / 32), I_D = (FFE / 64) * (DM / 32), I_E = I_GU + I_D;
    const float* wg = gfp(a.in[oi(19)]) + (size_t)ml * NEXP * DM * FFE; const float* wu = gfp(a.in[oi(20)]) + (size_t)ml * NEXP * DM * FFE; const float* wd = gfp(a.in[oi(21)]) + (size_t)ml * NEXP * FFE * DM;
    unsigned char* wsl = opq(a.ws); bf16_t* mgu = (bf16_t*)(wsl + WS_MGU); bf16_t* md = (bf16_t*)(wsl + WS_MD);
    for (int it = gw; it < NEXP * I_E; it += NGW) {
        const int e = it / I_E; int r = it % I_E;
        if (r < I_GU) { MapGU f{wg + (size_t)e * DM * FFE, wu + (size_t)e * DM * FFE, FFE}; cvt_item<MapGU, true>(f, nullptr, DM, (bf16_t*)((unsigned char*)mgu + (size_t)e * 2 * FFE * DM), scr, r, 2 * FFE / 32, lane, W8_GU); }
        else { r -= I_GU; MapPlain f{wd + (size_t)e * FFE * DM, DM}; cvt_item<MapPlain, true>(f, nullptr, FFE, (bf16_t*)((unsigned char*)md + (size_t)e * DM * FFE), scr, r, DM / 32, lane, W8_D); }
    }
}

template <int MODE, bool ROUTE, bool OUT8 = false, bool NOX = false, bool WRY = false>
__device__ __forceinline__ void ln_pass(const Args& a, const float* Ysrc, const float* Xres, const float* g, const float* b, float* Xout, bf16_t* XB,
                                        const float* router, unsigned* cnt, int gw, int NGW, int lane, LAS unsigned char* lds_, const float* g1 = nullptr, const float* b1 = nullptr, int stslot = 20) {
    asm volatile("" : "+v"(lane));
    unsigned char* wsl = opq(a.ws);
    const bf16_t* oslot = (const bf16_t*)(wsl + WS_OSLOT); const bf16_t* oslot2 = (const bf16_t*)(wsl + WS_OSLOT2);
    f32x4* route = (f32x4*)(wsl + WS_ROUTE);
    const int* slots = (const int*)(wsl + WS_ROUTE + 512 * 1024);
    float* st = (float*)(wsl + WS_SS);
    unsigned long long pk = 0ull;
#pragma unroll 4
    for (int m = gw; m < M; m += NGW) {
        f32x4 v[4];
        if constexpr (MODE == 0) {
#pragma unroll
            for (int j = 0; j < 4; ++j) v[j] = *((const f32x4*)(Ysrc + (size_t)m * DM) + lane + 64 * j);
        } else {
            const f32x4 rt = route[m]; const int s1 = slots[2 * m], s2 = slots[2 * m + 1];
            const float mu1 = st[(size_t)m * 32 + 20], rs1 = st[(size_t)m * 32 + 21];
#pragma unroll
            for (int j = 0; j < 4; ++j) { const f32x4 yv1 = *((const f32x4*)(Ysrc + (size_t)m * DM) + lane + 64 * j);
                const f32x4 xv = (yv1 - mu1) * rs1 * *((const f32x4*)g1 + lane + 64 * j) + *((const f32x4*)b1 + lane + 64 * j);
                const unsigned o1 = *((const unsigned*)((const unsigned char*)oslot + (size_t)s1 * DM) + lane + 64 * j), o2 = *((const unsigned*)((const unsigned char*)oslot + (size_t)s2 * DM) + lane + 64 * j);
                const unsigned p1 = *((const unsigned*)((const unsigned char*)oslot2 + (size_t)s1 * DM) + lane + 64 * j), p2 = *((const unsigned*)((const unsigned char*)oslot2 + (size_t)s2 * DM) + lane + 64 * j);
                const f32x2 a1l = __builtin_amdgcn_cvt_pk_f32_fp8((int)o1, false), a1h = __builtin_amdgcn_cvt_pk_f32_fp8((int)o1, true), b1l = __builtin_amdgcn_cvt_pk_f32_fp8((int)p1, false), b1h = __builtin_amdgcn_cvt_pk_f32_fp8((int)p1, true);
                const f32x2 a2l = __builtin_amdgcn_cvt_pk_f32_fp8((int)o2, false), a2h = __builtin_amdgcn_cvt_pk_f32_fp8((int)o2, true), b2l = __builtin_amdgcn_cvt_pk_f32_fp8((int)p2, false), b2h = __builtin_amdgcn_cvt_pk_f32_fp8((int)p2, true);
                const float g1s = rt[2] * (1.0f / O8), g2s = rt[3] * (1.0f / O8);
                f32x4 r;
                r[0] = xv[0] * DN_ALPHA + g1s * (a1l.x + b1l.x) + g2s * (a2l.x + b2l.x);
                r[1] = xv[1] * DN_ALPHA + g1s * (a1l.y + b1l.y) + g2s * (a2l.y + b2l.y);
                r[2] = xv[2] * DN_ALPHA + g1s * (a1h.x + b1h.x) + g2s * (a2h.x + b2h.x);
                r[3] = xv[3] * DN_ALPHA + g1s * (a1h.y + b1h.y) + g2s * (a2h.y + b2h.y);
                if constexpr (WRY) *((f32x4*)((float*)Ysrc + (size_t)m * DM) + lane + 64 * j) = r;
                v[j] = r; }
        }
        float s = 0.f;
#pragma unroll
        for (int j = 0; j < 4; ++j) s += (v[j][0] + v[j][1]) + (v[j][2] + v[j][3]);
        const float mean = wave_sum(s) * (1.f / DM); float s2 = 0.f;
#pragma unroll
        for (int j = 0; j < 4; ++j) { v[j] = v[j] - mean; s2 += (v[j][0] * v[j][0] + v[j][1] * v[j][1]) + (v[j][2] * v[j][2] + v[j][3] * v[j][3]); }
        const float rstd = __builtin_amdgcn_rsqf(wave_sum(s2) * (1.f / DM) + 1e-5f);
#pragma unroll
        for (int j = 0; j < 4; ++j) { const f32x4 gv = *((const f32x4*)g + lane + 64 * j), bv = *((const f32x4*)b + lane + 64 * j);
            v[j] = v[j] * rstd * gv + bv;
            if constexpr (!NOX) *((f32x4*)(Xout + (size_t)m * DM) + lane + 64 * j) = v[j];
            if constexpr (OUT8) { *((unsigned*)((unsigned char*)XB + (size_t)m * DM) + lane + 64 * j) = cvt4_fp8(v[j][0], v[j][1], v[j][2], v[j][3]); }
            else if (XB) { u32x2 w; w.x = cvt_pk_bf16(v[j][0], v[j][1]); w.y = cvt_pk_bf16(v[j][2], v[j][3]); *((u32x2*)(XB + (size_t)m * DM) + lane + 64 * j) = w; } }
        if constexpr (NOX) { if (lane == 0) { st[(size_t)m * 32 + stslot] = mean; st[(size_t)m * 32 + stslot + 1] = rstd; } }
        if constexpr (ROUTE) {
            float lg[8];
#pragma unroll
            for (int e = 0; e < 8; ++e) lg[e] = 0.f;
#pragma unroll
            for (int j = 0; j < 4; ++j)
#pragma unroll
                for (int q = 0; q < 4; ++q) { const int k = (lane + 64 * j) * 4 + q; const f32x4 r0 = *(const f32x4*)(router + (size_t)k * 8), r1 = *(const f32x4*)(router + (size_t)k * 8 + 4); const float xv = v[j][q];
                    lg[0] += xv * r0[0]; lg[1] += xv * r0[1]; lg[2] += xv * r0[2]; lg[3] += xv * r0[3]; lg[4] += xv * r1[0]; lg[5] += xv * r1[1]; lg[6] += xv * r1[2]; lg[7] += xv * r1[3]; }
#pragma unroll
            for (int e = 0; e < 8; ++e) lg[e] = wave_sum(lg[e]);
            int e1 = 0; float v1 = lg[0];
#pragma unroll
            for (int e = 1; e < 8; ++e) if (lg[e] > v1) { v1 = lg[e]; e1 = e; }
            int e2 = -1; float v2 = -__builtin_inff();
#pragma unroll
            for (int e = 0; e < 8; ++e) if (e != e1 && lg[e] > v2) { v2 = lg[e]; e2 = e; }
            const float g2 = 1.0f / (1.0f + __expf(v1 - v2)), g1 = 1.0f - g2;
            if (lane == 0) { f32x4 rt; rt[0] = __int_as_float(e1); rt[1] = __int_as_float(e2); rt[2] = g1; rt[3] = g2; route[m] = rt; }
            pk += (1ull << (8 * e1)) + (1ull << (8 * e2));
        }
    }
    if constexpr (ROUTE) {
        LAS unsigned* lc = (LAS unsigned*)(lds_ + 131072);
        const bool w0 = (gw & 7) == 0;
        if (w0 && lane < 8) lc[lane] = 0u;
        __syncthreads();
        if (lane < 8) atomicAdd((unsigned*)(lc + lane), (unsigned)((pk >> (8 * lane)) & 255ull));
        __syncthreads();
        if (w0 && lane < 8) atomicAdd(cnt + lane, lc[lane]);
    }
}

#define XB_TMO      128
#define XB_XCNT(j)  (256  + 64 * (j))
#define XB_XSUB(j)  (1280 + 64 * (j))
#define XB_XGEN(j)  (2304 + 64 * (j))
#define XB_TOP      3328
#define XB_TOPGEN   3392
#define XCD_BAR_WORDS 3456
#define XB_SPIN_CAP (1u << 22)
__device__ __forceinline__ unsigned xb_ld(unsigned* p)              { return __hip_atomic_load(p, __ATOMIC_RELAXED, __HIP_MEMORY_SCOPE_AGENT); }
__device__ __forceinline__ unsigned xb_add(unsigned* p, unsigned v) { return __hip_atomic_fetch_add(p, v, __ATOMIC_RELAXED, __HIP_MEMORY_SCOPE_AGENT); }
__device__ __forceinline__ unsigned xb_xcc_id() { return (unsigned)__builtin_amdgcn_s_getreg((3 << 11) | 20) & 0xFu; }
#define XB_SPIN(cond, bar) do { unsigned _sp = 0; while (cond) { __builtin_amdgcn_s_sleep(1); \
    if ((++_sp & 255u) == 0u) { if (xb_ld(&(bar)[XB_TMO])) break; if (_sp > XB_SPIN_CAP) { atomicAdd(&(bar)[XB_TMO], 1u); break; } } } } while (0)
struct XcdBarrier { unsigned* bar; unsigned x; volatile LAS unsigned* st; };
__device__ __forceinline__ XcdBarrier xcd_barrier_post(unsigned* bar, volatile LAS unsigned* st) {
    XcdBarrier b; b.bar = bar; b.x = xb_xcc_id(); b.st = st;
    if (threadIdx.x == 0) (void)xb_add(&bar[XB_XCNT(b.x)], 1u);
    return b;
}
__device__ __forceinline__ void xcd_barrier_complete(unsigned* bar, unsigned x, unsigned& nloc, unsigned& nx) {
    const unsigned G = gridDim.x * gridDim.y * gridDim.z;
    unsigned sum, cnt, mine, sp = 0u;
    for (;;) {
        sum = 0u; cnt = 0u; mine = 0u;
#pragma unroll
        for (unsigned j = 0; j < 16; ++j) { const unsigned c = xb_ld(&bar[XB_XCNT(j)]); sum += c; cnt += (c > 0u) ? 1u : 0u; mine = (j == x) ? c : mine; }
        if (sum == G) break;
        __builtin_amdgcn_s_sleep(1);
        if ((++sp & 255u) == 0u) { if (xb_ld(&bar[XB_TMO])) break; if (sp > XB_SPIN_CAP) { atomicAdd(&bar[XB_TMO], 1u); break; } }
    }
    nloc = mine > 0u ? mine : 1u; nx = cnt > 0u ? cnt : 1u;
}
__device__ __forceinline__ void xcd_barrier(const XcdBarrier& b) {
    asm volatile("s_waitcnt vmcnt(0)" ::: "memory");
    __syncthreads();
    if (threadIdx.x == 0) {
        unsigned* bar = b.bar;
        __builtin_amdgcn_s_waitcnt(0);
        unsigned nloc = b.st[0], nx = b.st[1];
        if (nloc == 0u) { xcd_barrier_complete(bar, b.x, nloc, nx); b.st[0] = nloc; b.st[1] = nx; }
        const unsigned old = xb_add(&bar[XB_XSUB(b.x)], 1u);
        const unsigned gen = old / nloc;
        if (old + 1u == (gen + 1u) * nloc) {
            __builtin_amdgcn_fence(__ATOMIC_RELEASE, "agent");
            asm volatile("s_waitcnt vmcnt(0)" ::: "memory");
            const unsigned og = xb_add(&bar[XB_TOP], 1u);
            const unsigned tg = og / nx;
            if (og + 1u == (tg + 1u) * nx) xb_add(&bar[XB_TOPGEN], 1u);
            else XB_SPIN(xb_ld(&bar[XB_TOPGEN]) == tg, bar);
            __builtin_amdgcn_fence(__ATOMIC_ACQUIRE, "agent");
            xb_add(&bar[XB_XGEN(b.x)], 1u);
            asm volatile("s_waitcnt vmcnt(0)" ::: "memory");
        } else {
            XB_SPIN(xb_ld(&bar[XB_XGEN(b.x)]) == gen, bar);
            __builtin_amdgcn_fence(__ATOMIC_ACQUIRE, "agent");
            asm volatile("s_waitcnt vmcnt(0)" ::: "memory");
        }
    }
    __syncthreads();
}
constexpr int CW_BAR = 16384;

__global__ void __launch_bounds__(512, 2) mega_fwd(Args a) {
    extern __shared__ __attribute__((aligned(16))) unsigned char lds_raw[];
    LAS unsigned char* lds = (LAS unsigned char*)lds_raw;
    cg::grid_group grid = cg::this_grid();
    const int tid = threadIdx.x, wave = __builtin_amdgcn_readfirstlane(tid >> 6);
#define FRESH_LANE(name) int name = threadIdx.x; asm volatile("" : "+v"(name)); name &= 63
    const int G = gridDim.x, bx = blockIdx.x;
    const int vcu = (G % 8 == 0) ? (bx % 8) * (G / 8) + bx / 8 : bx;
    const int gw = vcu * 8 + wave, NGW = G * 8;
#define ws opq(a.ws)
#define ctl ((unsigned*)(ws + WS_CTL))
#define tab ((float*)(ws + WS_TAB))
#define ssq ((float*)(ws + WS_SS))
#define sskv ((float*)(ws + WS_SS))
#define WinT ((bf16_t*)(ws + WS_WIN))
#define WuqT ((bf16_t*)(ws + WS_WUQ))
#define WukvT ((bf16_t*)(ws + WS_WUKV))
#define WoT ((bf16_t*)(ws + WS_WO))
#define WguT ((bf16_t*)(ws + WS_WGU))
#define WdT ((bf16_t*)(ws + WS_WD))
#define MguT ((bf16_t*)(ws + WS_MGU))
#define MdT ((bf16_t*)(ws + WS_MD))
#define Xf ((float*)(ws + WS_X))
#define XB ((bf16_t*)(ws + WS_XB))
#define Y ((float*)(ws + WS_Y))
#define Hb ((bf16_t*)(ws + WS_H))
#define QMb ((bf16_t*)(ws + WS_QM))
#define KVb ((bf16_t*)(ws + WS_KVB))
#define MRG ((bf16_t*)(ws + WS_MRG))
#define O0buf ((float*)(ws + WS_O0))
#define O1buf ((float*)(ws + WS_O0 + 32 * MiB))
#define ACT ((bf16_t*)(ws + WS_ACT))
#define XG ((bf16_t*)(ws + WS_XG))
#define MACT ((bf16_t*)(ws + WS_MACT))
#define OSLOT ((bf16_t*)(ws + WS_OSLOT))
    LAS float* scr = (LAS float*)(lds + wave * 16384);

    volatile LAS unsigned* bst = (volatile LAS unsigned*)(lds + LDS_BYTES - 64);
    if (tid < 2) bst[tid] = 0u;
    __syncthreads();
    XcdBarrier xbar = xcd_barrier_post((unsigned*)(ws + WS_CTL) + CW_BAR, bst);
    int ph = 0;
    const int lo = a.ph_lo, hi = a.ph_hi;
#ifndef EN
#define EN 0xFFFFF
#endif
#ifndef REP
#define REP 0
#endif
#define PH_BEGIN(k) if (lo <= ph && ph < hi) { if constexpr ((EN >> (k)) & 1) for (int rep_ = 0; rep_ < ((((REP) >> (k)) & 1) ? 2 : 1); ++rep_) {
#define PH_END() } if (ph + 1 < hi) { if (ph == 0) grid.sync(); else xcd_barrier(xbar); } } ++ph;

    PH_BEGIN(0)
    {
        FRESH_LANE(lane_);
#define lane lane_
        constexpr int I_IN = (DM / 64) * (HC / 32), I_UQ = (384 / 64) * (768 / 32), I_UKV = (256 / 64) * (1024 / 32), I_O = (DM / 64) * (DM / 32), I_L = I_IN + I_UQ + I_UKV + I_O;
        constexpr int I_GU = (DM / 64) * (2 * FFD / 32), I_D = (FFD / 64) * (DM / 32), I_F = I_GU + I_D;
        for (int it = gw; it < 4 * I_L + 2 * I_F; it += NGW) {
            if (it < 4 * I_L) { const int l = it / I_L; int r = it % I_L;
                if (r < I_IN) { MapWin f{gfp(a.in[oi(2)]) + (size_t)l * DM * 2240}; cvt_item(f, nullptr, DM, WinT + (size_t)l * HC * DM, scr, r, HC / 32, lane); continue; } r -= I_IN;
                if (r < I_UQ) { MapWuq f{gfp(a.in[oi(5)]) + (size_t)l * 384 * 768}; cvt_item(f, gfp(a.in[oi(3)]) + l * 384, 384, WuqT + (size_t)l * 768 * 384, scr, r, 768 / 32, lane); continue; } r -= I_UQ;
                if (r < I_UKV) { MapWukv f{gfp(a.in[oi(6)]) + (size_t)l * 256 * 512, gfp(a.in[oi(7)]) + (size_t)l * 256 * 512}; cvt_item(f, gfp(a.in[oi(4)]) + l * 256, 256, WukvT + (size_t)l * 1024 * 256, scr, r, 1024 / 32, lane); continue; } r -= I_UKV;
                { MapPlain f{gfp(a.in[oi(10)]) + (size_t)l * DM * DM, DM}; cvt_item(f, nullptr, DM, WoT + (size_t)l * DM * DM, scr, r, DM / 32, lane); }
            } else { const int q = it - 4 * I_L, d = q / I_F; int r = q % I_F;
                if (r < I_GU) { MapGU f{gfp(a.in[oi(15)]) + (size_t)d * DM * FFD, gfp(a.in[oi(16)]) + (size_t)d * DM * FFD, FFD}; cvt_item<MapGU, true>(f, nullptr, DM, (bf16_t*)((unsigned char*)WguT + (size_t)d * 2 * FFD * DM), scr, r, 2 * FFD / 32, lane, W8_GU); }
                else { r -= I_GU; MapPlain f{gfp(a.in[oi(17)]) + (size_t)d * FFD * DM, DM}; cvt_item<MapPlain, true>(f, nullptr, FFD, (bf16_t*)((unsigned char*)WdT + (size_t)d * DM * FFD), scr, r, DM / 32, lane, W8_D); }
            }
        }
        cvt_moe(a, 0, scr, gw, NGW, fresh_lane());
        for (int m = gw; m < M; m += NGW) {
#pragma unroll
            for (int j = 0; j < 4; ++j) { const f32x4 v = *((const f32x4*)(gfp(a.in[oi(0)]) + (size_t)m * DM) + lane + 64 * j); u32x2 w; w.x = cvt_pk_bf16(v[0], v[1]); w.y = cvt_pk_bf16(v[2], v[3]); *((u32x2*)(XB + (size_t)m * DM) + lane + 64 * j) = w; }
        }
        for (int i = bx * 512 + tid; i < SEQ * 32; i += G * 512) { const int pos = i >> 5, fi = i & 31; const float ang = (float)pos * a.inv[fi];
            const double rev = (double)ang * 0.15915494309189535; const float fr = (float)(rev - __builtin_rint(rev));
            tab[2 * i] = __builtin_amdgcn_cosf(fr); tab[2 * i + 1] = __builtin_amdgcn_sinf(fr); }
        if (bx == 0 && tid < 128) ctl[tid] = 0u;
#undef lane
    }
    PH_END()

    for (int l = 0; l < DEPTH; ++l) {
        const bool moe = (l & 1) != 0; const int li = l >> 1;
        const float* xres = (l == 0) ? gfp(a.in[oi(0)]) : Xf;
#define splitA (G == 256)
        PH_BEGIN(1)
        { pg8::StaticOrder S; S.init(M, splitA ? 2048 : HC, G, obx()); pg8::EpiH E{Hb, ssq, sskv, tab};
          pg8::gemm_phase(lds, XB, DM, WinT + (size_t)l * HC * DM, DM, DM, S, E); }
        PH_END()
        PH_BEGIN(2)
        {
#ifndef NOQ
          if (splitA && bx >= 192) { pg8::OneUnit S{obx() - 192, 8, true}; pg8::EpiH E{Hb, ssq, sskv, tab};
            pg8::gemm_phase(lds, XB, DM, WinT + (size_t)l * HC * DM, DM, DM, S, E); }
          else { pg8::StaticOrder S; S.init(M, QMC, splitA ? 192 : G, obx()); pg8::EpiQ E{QMb, ssq, tab};
            pg8::gemm_phase(lds, Hb + C_CQ, HC, WuqT + (size_t)l * 768 * 384, 384, 384, S, E); }
#endif
#ifndef NOKV
          { pg8::StaticOrder S; S.init(M, KVC, G, obx()); pg8::EpiKV E{KVb, sskv};
            pg8::gemm_phase(lds, Hb + C_CKV, HC, WukvT + (size_t)l * 1024 * 256, 256, 256, S, E); }
#endif
        }
        PH_END()
        PH_BEGIN(3)
        {
            unsigned* qc = ctl + 512 + l;
            volatile LAS int* qslot = (volatile LAS int*)(lds + LDS_BYTES - 32);
            for (;;) {
                if (tid == 0) *qslot = (int)atomicAdd(qc, 1u);
                __syncthreads();
                const int it = __builtin_amdgcn_readfirstlane(*qslot);
                __syncthreads();
                if (it >= 768) break;
                int acc = 0, ent = 0, r = 0;
                for (int e = 0; e < 32; ++e) { const int en = (int)a.aq[e]; const int n = (en >> 8) ? 32 : 16; if (it >= acc && it < acc + n) { ent = en; r = it - acc; } acc += n; }
                const int qb = ent & 255; const bool is_diff = (ent >> 8) != 0;
                const int bh = is_diff ? (r >> 1) : r, c = r & 1, b = bh >> 2, hh = bh & 3;
                const size_t rb = (size_t)b * SEQ;
                if (!is_diff) {
                    att::AttnArgs A; A.Q = QMb + rb * QMC + hh * 192; A.K = KVb + rb * KVC + hh * 128; A.K2 = Hb + rb * HC + C_KR;
                    A.V = KVb + rb * KVC + 512 + hh * 128; A.P0 = qb * 256; A.Out = MRG + rb * 1024 + hh * 128; A.O0 = nullptr;
                    att::attn_block<true, 0, PIPE_MLA>(A, (char*)lds_raw);
                } else {
                    if (tid < 128) { const float* rbias = gfp(a.in[oi(1)]); ((float*)(lds_raw + att::LDS_BIAS))[tid] = (rbias[a.bucket[tid] * 4 + hh] - rbias[31 * 4 + hh]) * LOG2E; }
                    __syncthreads();
                    att::AttnArgs A; A.K = nullptr; A.V = Hb + rb * HC + C_DV + hh * 128; A.P0 = qb * 256; A.Out = nullptr;
                    A.O0 = (float*)((bf16_t*)(c ? O1buf : O0buf) + rb * 512 + hh * 128);
                    A.Q = Hb + rb * HC + C_DQ + hh * 128 + c * 64; A.K2 = Hb + rb * HC + C_DK + hh * 128 + c * 64;
                    att::attn_block<false, 1, PIPE_DIFF>(A, (char*)lds_raw);
                }
            }
        }
        PH_END()
        PH_BEGIN(13)
        {
            FRESH_LANE(lane_);
#define lane lane_
            const float* lp = gfp(a.in[oi(8)]) + (size_t)l * 256;
            const float s1 = wave_sum(lp[lane] * lp[64 + lane]), s2 = wave_sum(lp[128 + lane] * lp[192 + lane]);
            const float lam = __expf(s1) - __expf(s2) + a.lam_init[oi(l)];
            const float osc = 1.0f - a.lam_init[oi(l)];
            const float* dn = gfp(a.in[oi(9)]) + l * 128 + (lane & 15) * 8;
            const f32x4 g0 = *(const f32x4*)dn * osc, g1 = *(const f32x4*)(dn + 4) * osc;
            for (int m = gw; m < M; m += NGW) {
                const u32x4 q0 = *(const u32x4*)((const bf16_t*)O0buf + (size_t)m * 512 + lane * 8), q1 = *(const u32x4*)((const bf16_t*)O1buf + (size_t)m * 512 + lane * 8);
#define BLO(w) __uint_as_float((w) << 16)
#define BHI(w) __uint_as_float((w) & 0xffff0000u)
                const f32x4 d0 = (f32x4){BLO(q0.x), BHI(q0.x), BLO(q0.y), BHI(q0.y)} - (f32x4){BLO(q1.x), BHI(q1.x), BLO(q1.y), BHI(q1.y)} * lam;
                const f32x4 d1 = (f32x4){BLO(q0.z), BHI(q0.z), BLO(q0.w), BHI(q0.w)} - (f32x4){BLO(q1.z), BHI(q1.z), BLO(q1.w), BHI(q1.w)} * lam;
#undef BLO
#undef BHI
                float ss = (d0[0] * d0[0] + d0[1] * d0[1]) + (d0[2] * d0[2] + d0[3] * d0[3]) + (d1[0] * d1[0] + d1[1] * d1[1]) + (d1[2] * d1[2] + d1[3] * d1[3]);
                ss += __shfl_xor(ss, 1); ss += __shfl_xor(ss, 2); ss += __shfl_xor(ss, 4); ss += __shfl_xor(ss, 8);
                const float rs = __builtin_amdgcn_rsqf(ss * (1.0f / 128.0f) + 1e-5f);
                pg8::store8(MRG + (size_t)m * 1024 + 512 + lane * 8, d0 * rs * g0, d1 * rs * g1);
            }
#undef lane
        }
        PH_END()
        PH_BEGIN(4)
        { pg8::StaticOrder S; S.init(M, DM, G, obx());
          if (l == 0) { pg8::EpiY E{xres, Y, 1.0f}; pg8::gemm_phase(lds, MRG, DM, WoT + (size_t)l * DM * DM, DM, DM, S, E); }
          else { pg8::EpiYLN E{Y, ssq, gfp(a.in[oi(13)]) + (l - 1) * DM, gfp(a.in[oi(14)]) + (l - 1) * DM, 1.0f, 22};
                 pg8::gemm_phase(lds, MRG, DM, WoT + (size_t)l * DM * DM, DM, DM, S, E); } }
        PH_END()
        PH_BEGIN(5)
        { if (moe) ln_pass<0, true, true, true>(a, Y, nullptr, gfp(a.in[oi(11)]) + l * DM, gfp(a.in[oi(12)]) + l * DM, Xf, (bf16_t*)(ws + WS_XB8), gfp(a.in[oi(18)]) + (size_t)li * DM * 8, ctl + CW_CNT + 8 * li, gw, NGW, fresh_lane(), lds);
          else ln_pass<0, false, true, true>(a, Y, nullptr, gfp(a.in[oi(11)]) + l * DM, gfp(a.in[oi(12)]) + l * DM, Xf, (bf16_t*)(ws + WS_XB8), nullptr, nullptr, gw, NGW, fresh_lane(), lds);
          if (l == 2) cvt_moe(a, 1, scr, gw, NGW, fresh_lane()); }
        PH_END()
        if (!moe) {
            PH_BEGIN(6)
            { pg8::StaticOrder S; S.init(M, 2 * FFD, G, obx()); pg8::EpiSwiGLU8 E{(unsigned char*)ACT, FFD};
              pg8::gemm_phase<pg8::EpiSwiGLU8, pg8::StaticOrder, true>(lds, (const bf16_t*)(ws + WS_XB8), DM / 2, (const bf16_t*)((unsigned char*)WguT + (size_t)li * 2 * FFD * DM), DM / 2, DM / 2, S, E); }
            PH_END()
            PH_BEGIN(7)
            { pg8::StaticOrder S; S.init(M, DM, G, obx()); pg8::EpiYLN E{Y, ssq, gfp(a.in[oi(11)]) + l * DM, gfp(a.in[oi(12)]) + l * DM, 1.0f / (W8_D * A8_ACT), 20};
              pg8::gemm_phase<pg8::EpiYLN, pg8::StaticOrder, true>(lds, ACT, FFD / 2, (const bf16_t*)((unsigned char*)WdT + (size_t)li * DM * FFD), FFD / 2, FFD / 2, S, E); }
            PH_END()
            PH_BEGIN(8)
            { ln_pass<0, false, false, true>(a, Y, nullptr, gfp(a.in[oi(13)]) + l * DM, gfp(a.in[oi(14)]) + l * DM, nullptr, XB, nullptr, nullptr, gw, NGW, fresh_lane(), lds, nullptr, nullptr, 22); }
            PH_END()
        } else {
            unsigned* cnt = ctl + CW_CNT + 8 * li; unsigned* cur = ctl + CW_CUR + 8 * li;
            PH_BEGIN(9)
            {
                FRESH_LANE(lane_);
#define lane lane_
                int rbase[8]; { int acc = 0;
#pragma unroll
                    for (int e = 0; e < 8; ++e) { rbase[e] = acc * 256; acc += (__builtin_amdgcn_readfirstlane((int)__hip_atomic_load(cnt + e, __ATOMIC_RELAXED, __HIP_MEMORY_SCOPE_AGENT)) + 255) >> 8; } }
                const f32x4* route = (const f32x4*)(ws + WS_ROUTE); int* slots = (int*)(ws + WS_ROUTE + 512 * 1024);
                LAS unsigned* lc = (LAS unsigned*)(lds + 131072);
                unsigned long long pk = 0ull;
                for (int m = gw; m < M; m += NGW) { const f32x4 rt = route[m]; pk += (1ull << (8 * __float_as_int(rt[0]))) + (1ull << (8 * __float_as_int(rt[1]))); }
                if (lane < 8) lc[wave * 8 + lane] = (unsigned)((pk >> (8 * lane)) & 255ull);
                __syncthreads();
                if (wave == 0 && lane < 8) {
                    unsigned tot = 0u, pre[8];
#pragma unroll
                    for (int w = 0; w < 8; ++w) { pre[w] = tot; tot += lc[w * 8 + lane]; }
                    int rb = 0;
#pragma unroll
                    for (int e = 0; e < 8; ++e) if (e == lane) rb = rbase[e];
                    const unsigned base = atomicAdd(cur + lane, tot) + (unsigned)rb;
#pragma unroll
                    for (int w = 0; w < 8; ++w) lc[64 + w * 8 + lane] = base + pre[w];
                }
                __syncthreads();
                unsigned nb[8];
#pragma unroll
                for (int e = 0; e < 8; ++e) nb[e] = lc[64 + wave * 8 + e];
                for (int m = gw; m < M; m += NGW) {
                    const f32x4 rt = route[m]; const int e1 = __float_as_int(rt[0]), e2 = __float_as_int(rt[1]);
                    int s1 = 0, s2 = 0;
#pragma unroll
                    for (int e = 0; e < 8; ++e) { if (e == e1) { s1 = (int)nb[e]; nb[e]++; } if (e == e2) { s2 = (int)nb[e]; nb[e]++; } }
                    const u32x4 q = *((const u32x4*)((const unsigned char*)(ws + WS_XB8) + (size_t)m * DM) + lane);
                    *((u32x4*)((unsigned char*)XG + (size_t)s1 * DM) + lane) = q; *((u32x4*)((unsigned char*)XG + (size_t)s2 * DM) + lane) = q;
                    if (lane == 0) { slots[2 * m] = s1; slots[2 * m + 1] = s2; }
                }
#undef lane
            }
            PH_END()
            pg8::MoeOrder MO; { int t[8], tot = 0;
#pragma unroll
                for (int e = 0; e < 8; ++e) { t[e] = (__builtin_amdgcn_readfirstlane((int)__hip_atomic_load(cnt + e, __ATOMIC_RELAXED, __HIP_MEMORY_SCOPE_AGENT)) + 255) >> 8; tot += t[e]; }
                MO.t0 = t[0]; MO.t1 = t[1]; MO.t2 = t[2]; MO.t3 = t[3]; MO.t4 = t[4]; MO.t5 = t[5]; MO.t6 = t[6]; MO.t7 = t[7]; MO.G = G; MO.c = bx; MO.NT = 0; MO.total = tot; MO.ks = 1; MO.kh = 0; }
            PH_BEGIN(10)
            { pg8::MoeOrder S = MO; S.NT = 2 * FFE / 256; S.total = MO.total * S.NT; pg8::EpiSwiGLU8 E{(unsigned char*)MACT, FFE};
              pg8::gemm_phase<pg8::EpiSwiGLU8, pg8::MoeOrder, true>(lds, XG, DM / 2, MguT, DM / 2, DM / 2, S, E); }
            PH_END()
            PH_BEGIN(11)
            { pg8::MoeOrder S = MO; S.NT = DM / 256; S.ks = 2; S.kh = FFE / 4; S.total = MO.total * S.NT * 2; pg8::EpiF8 E{(unsigned char*)OSLOT, DM, (size_t)(WS_OSLOT2 - WS_OSLOT), O8 / (W8_D * A8_ACT)};
              pg8::gemm_phase<pg8::EpiF8, pg8::MoeOrder, true>(lds, MACT, FFE / 2, MdT, FFE / 2, FFE / 4, S, E); }
            PH_END()
            PH_BEGIN(12)
            { if (l == DEPTH - 1) ln_pass<1, false>(a, Y, nullptr, gfp(a.in[oi(13)]) + l * DM, gfp(a.in[oi(14)]) + l * DM, a.out + oz(), nullptr, nullptr, nullptr, gw, NGW, fresh_lane(), lds, gfp(a.in[oi(11)]) + l * DM, gfp(a.in[oi(12)]) + l * DM);
              else ln_pass<1, false, false, true, true>(a, Y, nullptr, gfp(a.in[oi(13)]) + l * DM, gfp(a.in[oi(14)]) + l * DM, nullptr, XB, nullptr, nullptr, gw, NGW, fresh_lane(), lds, gfp(a.in[oi(11)]) + l * DM, gfp(a.in[oi(12)]) + l * DM, 22); }
            PH_END()
        }
    }
#undef PH_BEGIN
#undef PH_END
}
#undef ws
#undef ctl
#undef tab
#undef ssq
#undef sskv
#undef Y
#undef XB
#undef Xf
constexpr int N_PHASES = 1 + 2 * 9 + 2 * 10;

extern "C" void kernel_launch(void* const* d_in, const int* in_sizes, int n_in, void* d_out, int out_size, void* d_ws, size_t ws_size, hipStream_t stream) {
    static int grid = 0;
    if (grid == 0) {
        if (n_in != 22 || in_sizes[0] != M * DM || out_size != M * DM || ws_size < WS_END) { fprintf(stderr, "kernel_launch: unexpected shapes (n_in %d, ws %zu)\n", n_in, ws_size); grid = -1; return; }
        int dev = 0, cus = 0, per_cu = 0;
        (void)hipGetDevice(&dev); (void)hipDeviceGetAttribute(&cus, hipDeviceAttributeMultiprocessorCount, dev);
        if (hipFuncSetAttribute((const void*)mega_fwd, hipFuncAttributeMaxDynamicSharedMemorySize, LDS_BYTES) != hipSuccess) { fprintf(stderr, "kernel_launch: hipFuncSetAttribute failed\n"); grid = -1; return; }
        if (hipOccupancyMaxActiveBlocksPerMultiprocessor(&per_cu, (const void*)mega_fwd, 512, LDS_BYTES) != hipSuccess || per_cu < 1) { fprintf(stderr, "kernel_launch: occupancy query says %d\n", per_cu); per_cu = 1; }
        (void)hipGetLastError();
        grid = cus * 1;
        if (grid <= 0) grid = 256;
    }
    if (grid < 0) return;
    (void)hipMemsetAsync((char*)d_ws + WS_CTL, 0, 1 * MiB, stream);
    Args a{};
    for (int i = 0; i < 22; ++i) a.in[i] = (const float*)d_in[i];
    a.out = (float*)d_out; a.ws = (unsigned char*)d_ws;
    for (int i = 0; i < 32; ++i) a.inv[i] = 1.0f / powf(10000.0f, (float)(2 * i) / 64.0f);
    for (int l = 0; l < 4; ++l) a.lam_init[l] = (float)(0.8 - 0.6 * exp(-0.3 * (double)l));
    for (int n = 0; n < 128; ++n) { int bkt;
        if (n < 16) bkt = n; else { const float nf = (float)n; const float v = logf(nf / 16.0f) / (float)log(8.0) * 16.0f; bkt = 16 + (int)v; if (bkt > 31) bkt = 31; }
        a.bucket[n] = (unsigned char)bkt; }
    {
        int di = 15, mi = 15;
        for (int e = 0; e < 32; ++e) { const float dc = di >= 0 ? 4.0f * (di + 1) : -1.f, mc = mi >= 0 ? 2.8f * (mi + 1) : -1.f;
            if (dc >= mc) { a.aq[e] = (unsigned short)((1 << 8) | di); --di; } else { a.aq[e] = (unsigned short)mi; --mi; } }
    }
#if MK_SPLIT
    for (int p = 0; p < N_PHASES; ++p) { a.ph_lo = p; a.ph_hi = p + 1; hipLaunchKernelGGL(mega_fwd, dim3(grid), dim3(512), LDS_BYTES, stream, a); }
#else
    a.ph_lo = 0; a.ph_hi = N_PHASES;
    void* args[] = {&a};
    hipError_t e = hipLaunchCooperativeKernel((const void*)mega_fwd, dim3(grid), dim3(512), args, LDS_BYTES, stream);
    if (e != hipSuccess) fprintf(stderr, "cooperative launch failed: %s (grid %d)\n", hipGetErrorString(e), grid);
#endif
}
```

```cpp
#include <hip/hip_runtime.h>
#include <hip/hip_cooperative_groups.h>
#include <cstdint>
#include <cstdio>
#include <cmath>
namespace cg = cooperative_groups;

#ifndef PIPE_MLA
#define PIPE_MLA true
#endif
#ifndef PIPE_DIFF
#define PIPE_DIFF true
#endif
#ifndef MK_SPLIT
#define MK_SPLIT 0
#endif

#define LAS __attribute__((address_space(3)))
typedef unsigned short bf16_t;
typedef short bf16x8 __attribute__((ext_vector_type(8)));
typedef short s16x4 __attribute__((ext_vector_type(4)));
typedef float f32x2 __attribute__((ext_vector_type(2)));
typedef float f32x4 __attribute__((ext_vector_type(4)));
typedef float f32x16 __attribute__((ext_vector_type(16)));
typedef unsigned u32x2 __attribute__((ext_vector_type(2)));
typedef unsigned u32x4 __attribute__((ext_vector_type(4)));
typedef int i32x4 __attribute__((ext_vector_type(4)));
typedef int i32x8 __attribute__((ext_vector_type(8)));

constexpr int M = 16384, DM = 1024, SEQ = 4096, DEPTH = 4;
constexpr int HC = 2304;
constexpr int QMC = 768, KVC = 1024;
constexpr int FFD = 2816, FFE = 3584, NEXP = 8;
constexpr int SLOTS = 32768 + 8 * 256;
constexpr float LOG2E = 1.4426950408889634f;
constexpr float DN_ALPHA = 1.681792830507429f;
constexpr int C_CQ = 0, C_CKV = 384, C_KR = 640, C_DQ = 704, C_DK = 1216, C_DV = 1728;

constexpr size_t MiB = 1u << 20;
constexpr size_t WS_CTL = 0, WS_TAB = 1 * MiB, WS_SS = 2 * MiB;
constexpr size_t WS_WIN = 4 * MiB, WS_WUQ = 22 * MiB, WS_WUKV = 25 * MiB, WS_WO = 27 * MiB, WS_WGU = 35 * MiB, WS_WD = 57 * MiB;
constexpr size_t WS_MGU = 68 * MiB, WS_MD = 180 * MiB;
constexpr size_t WS_X = 236 * MiB, WS_XB = 300 * MiB, WS_Y = 332 * MiB, WS_OV = 396 * MiB;
constexpr size_t WS_H = WS_OV, WS_QM = WS_OV + 72 * MiB, WS_KVB = WS_OV + 96 * MiB, WS_MRG = WS_OV + 128 * MiB, WS_O0 = WS_OV + 160 * MiB;
constexpr size_t WS_ACT = WS_OV;
constexpr size_t WS_XG = WS_OV, WS_MACT = WS_OV + 68 * MiB, WS_OSLOT = WS_OV + 306 * MiB;
constexpr size_t WS_ROUTE = WS_OV + 374 * MiB;
constexpr size_t WS_OSLOT2 = WS_OV + 376 * MiB;
constexpr size_t WS_XB8 = WS_OV + 444 * MiB;
constexpr size_t WS_END = WS_OV + 460 * MiB;
constexpr int CW_CNT = 0, CW_CUR = 64;

constexpr int LDS_BYTES = 147456;
constexpr float W8_GU = 64.0f, W8_D = 128.0f, A8_ACT = 8.0f, O8 = 64.0f;

__device__ __forceinline__ unsigned cvt_pk_bf16(float lo, float hi) { unsigned r; asm volatile("v_cvt_pk_bf16_f32 %0, %1, %2" : "=v"(r) : "v"(lo), "v"(hi)); return r; }
__device__ __forceinline__ i32x8 cat8(bf16x8 a, bf16x8 b) { const i32x4 x = __builtin_bit_cast(i32x4, a), y = __builtin_bit_cast(i32x4, b); return __builtin_shufflevector(x, y, 0, 1, 2, 3, 4, 5, 6, 7); }
__device__ __forceinline__ bf16x8 lo8(i32x8 v) { return __builtin_bit_cast(bf16x8, __builtin_shufflevector(v, v, 0, 1, 2, 3)); }
__device__ __forceinline__ bf16x8 hi8(i32x8 v) { return __builtin_bit_cast(bf16x8, __builtin_shufflevector(v, v, 4, 5, 6, 7)); }
__device__ __forceinline__ unsigned cvt4_fp8(float a, float b, float c, float d) { unsigned w = __builtin_amdgcn_cvt_pk_fp8_f32(a, b, 0u, false); return (unsigned)__builtin_amdgcn_cvt_pk_fp8_f32(c, d, (int)w, true); }
typedef _Float16 ystream_t;
typedef _Float16 h16x4 __attribute__((ext_vector_type(4)));
__device__ __forceinline__ f32x4 ld4h(const ystream_t* p) { return __builtin_convertvector(*(const h16x4*)p, f32x4); }
__device__ __forceinline__ void st4h(ystream_t* p, f32x4 v) { *(h16x4*)p = __builtin_convertvector(v, h16x4); }
__device__ __forceinline__ float bf2f(unsigned short b) { return __uint_as_float(((unsigned)b) << 16); }
__device__ __forceinline__ float wave_sum(float v) {
#pragma unroll
    for (int o = 1; o < 64; o <<= 1) v += __shfl_xor(v, o);
    return v;
}
__device__ __forceinline__ int fresh_lane() { int t = threadIdx.x; asm volatile("" : "+v"(t)); return t & 63; }
__device__ __forceinline__ int obx() { int b = blockIdx.x; asm volatile("" : "+s"(b)); return b; }
__device__ __forceinline__ int oi(int k) { asm volatile("" : "+s"(k)); return k; }
typedef __attribute__((address_space(1))) unsigned char* gptr_t;
typedef __attribute__((address_space(1))) const float* gfptr_t;
#if defined(__HIP_DEVICE_COMPILE__)
#define ASSUME_GLOBAL(p) __builtin_assume(!__builtin_amdgcn_is_shared((const __attribute__((address_space(0))) void*)(p)) && !__builtin_amdgcn_is_private((const __attribute__((address_space(0))) void*)(p)))
#else
#define ASSUME_GLOBAL(p) ((void)0)
#endif
__device__ __forceinline__ size_t oz() { size_t z = 0; asm volatile("" : "+s"(z)); return z; }
#define opq(p) ((p) + oz())
__device__ __forceinline__ const float* gfp(const float* p) { ASSUME_GLOBAL(p); return p; }
#define LDS_WAIT() asm volatile("s_waitcnt lgkmcnt(0)" ::: "memory")
#define VM_WAIT() asm volatile("s_waitcnt vmcnt(0)" ::: "memory")

namespace pg8 {
constexpr int BM = 256, BK = 64, HALF = 128, HTB = HALF * BK * 2, NXCD = 8, WGM = 8;
__host__ __device__ __forceinline__ int lds_byte(int r, int c) { const int st = (r >> 4) * 2 + (c >> 5), rr = r & 15, cc = c & 31, ob = rr * 64 + cc * 2; return st * 1024 + (ob ^ (((ob >> 9) & 1) << 5)); }
__host__ __device__ __forceinline__ void stage_rc(int b, int& R, int& C) { const int st = b / 1024, sb = b % 1024, swz = sb ^ (((sb >> 9) & 1) << 5); R = (st >> 1) * 16 + swz / 64; C = (st & 1) * 32 + (swz % 64) / 2; }
__host__ __device__ __forceinline__ int perm32(int rho) { const int n = rho >> 4, i = rho & 15; return 8 * (i >> 2) + 4 * n + (i & 3); }

struct Unit { int pm, pn, bt, ko, os; };

struct StaticOrder {
    int nM, nN, nwg, G, c;
    __device__ __forceinline__ void init(int Mr, int N, int G_, int c_) { nM = Mr / BM; nN = N / BM; nwg = nM * nN; G = G_; c = c_; }
    __device__ __forceinline__ bool next(int i, Unit& u) const {
        const long L = (long)i * G + c; if (L >= nwg) return false;
        int wgid = (int)L; { const int q = nwg / NXCD, r = nwg % NXCD, xcd = wgid % NXCD, off = wgid / NXCD; wgid = (xcd < r ? xcd * (q + 1) : r * (q + 1) + (xcd - r) * q) + off; }
        const int nig = WGM * nN, gid = wgid / nig, fm = gid * WGM, gsz = (nM - fm) < WGM ? (nM - fm) : WGM;
        u.pm = fm + ((wgid % nig) % gsz); u.pn = (wgid % nig) / gsz; u.bt = u.pn; u.ko = 0; u.os = 0; return true;
    }
};
struct OneUnit {
    int pm, pn; bool valid;
    __device__ __forceinline__ bool next(int i, Unit& u) const { if (i != 0 || !valid) return false; u.pm = pm; u.pn = pn; u.bt = pn; u.ko = 0; u.os = 0; return true; }
};
struct MoeOrder {
    int t0, t1, t2, t3, t4, t5, t6, t7; int NT, G, c, total, ks, kh;
    __device__ __forceinline__ bool next(int i, Unit& u) const {
        const int cc = (G % 8 == 0) ? (c % 8) * (G / 8) + c / 8 : c;
        const long L = (long)i * G + cc; if (L >= total) return false;
        int acc = 0, e = 0, base = 0, te = 1;
#define MO_STEP(j, tj) { if (tj > 0 && L >= (long)acc * NT * ks) { e = j; base = acc; te = tj; } acc += tj; }
        MO_STEP(0, t0) MO_STEP(1, t1) MO_STEP(2, t2) MO_STEP(3, t3) MO_STEP(4, t4) MO_STEP(5, t5) MO_STEP(6, t6) MO_STEP(7, t7)
#undef MO_STEP
        const int loc = (int)(L - (long)base * NT * ks), sp = loc % ks, rest = loc / ks;
        u.pm = base + rest % te; u.pn = rest / te; u.bt = e * NT + u.pn; u.ko = sp * kh; u.os = sp; return true;
    }
};

template <class Epi, class Sched, bool F8 = false>
__device__ __forceinline__ void gemm_phase(LAS unsigned char* lds, const bf16_t* Ag, int lda, const bf16_t* Btg, int ldb, int K, const Sched& S, const Epi& E) {
    asm volatile("" : "+s"(K));
    int tid_ = threadIdx.x; asm volatile("" : "+v"(tid_));
    const int tid = tid_, wid = __builtin_amdgcn_readfirstlane(tid >> 6), lane = tid & 63, wr = wid >> 2, wc = wid & 3, fr = lane & 15, fq = lane >> 4;
    const int nt = K / BK;
    unsigned voffA[2], voffB[2];
#pragma unroll
    for (int i = 0; i < 2; ++i) { int R, C; stage_rc(tid * 16 + i * 8192, R, C); const int Rb = Epi::PERM ? ((R & ~31) + perm32(R & 31)) : R;
        voffA[i] = (unsigned)(R * lda + C) * 2u; voffB[i] = (unsigned)(Rb * ldb + C) * 2u; }
    const size_t kstep = (size_t)(BK * 2);
    const size_t hstepA = (size_t)HALF * lda * 2, hstepB = (size_t)HALF * ldb * 2;
    const size_t tstepA = 2 * hstepA, tstepB = 2 * hstepB;
    const unsigned ldsw = (unsigned)wid * 1024u;
    const int aoff = lds_byte(wr * 64 + fr, fq * 8), boff = lds_byte(wc * 32 + fr, fq * 8);
#define PG8_SA(b, h) (((b) * 2 + (h)) * HTB)
#define PG8_SB(b, h) ((4 + (b) * 2 + (h)) * HTB)
#define PG8_STAGE(bufoff, gbase, voff) do { _Pragma("unroll") for (int _i = 0; _i < 2; ++_i) \
        __builtin_amdgcn_global_load_lds((const unsigned*)((const char*)(gbase) + (voff)[_i]), (LAS unsigned*)(lds + (bufoff) + ldsw + _i * 8192), 16, 0, 0); } while (0)
#define PG8_LDA(dst, b, h) do { _Pragma("unroll") for (int m = 0; m < 4; ++m) dst[m] = cat8(*(const LAS bf16x8*)(lds + PG8_SA(b, h) + aoff + m * 2048), *(const LAS bf16x8*)(lds + PG8_SA(b, h) + aoff + m * 2048 + 1024)); } while (0)
#define PG8_LDB(dst, b, h) do { _Pragma("unroll") for (int n = 0; n < 2; ++n) dst[n] = cat8(*(const LAS bf16x8*)(lds + PG8_SB(b, h) + boff + n * 2048), *(const LAS bf16x8*)(lds + PG8_SB(b, h) + boff + n * 2048 + 1024)); } while (0)
#define PG8_MMA(ai, bj, At, Bt) do { __builtin_amdgcn_s_setprio(1); _Pragma("unroll") for (int m = 0; m < 4; ++m) _Pragma("unroll") for (int n = 0; n < 2; ++n) { \
        if constexpr (F8) asm volatile("v_mfma_f32_16x16x128_f8f6f4 %0, %1, %2, %0" : "+v"(acc[ai][bj][m][n]) : "v"(Bt[n]), "v"(At[m]));   \
        else { acc[ai][bj][m][n] = __builtin_amdgcn_mfma_f32_16x16x32_bf16(lo8(Bt[n]), lo8(At[m]), acc[ai][bj][m][n], 0, 0, 0); \
               acc[ai][bj][m][n] = __builtin_amdgcn_mfma_f32_16x16x32_bf16(hi8(Bt[n]), hi8(At[m]), acc[ai][bj][m][n], 0, 0, 0); } } \
        __builtin_amdgcn_s_setprio(0); } while (0)
#define PG8_WAIT_V(n) asm volatile("s_waitcnt vmcnt(" #n ")" ::: "memory")
#define PG8_WAIT_L(n) asm volatile("s_waitcnt lgkmcnt(" #n ")" ::: "memory")
#define PG8_BAR __builtin_amdgcn_s_barrier()
#define PG8_SCHED __builtin_amdgcn_sched_barrier(0)
    Unit cur, nxt; int ui = 0;
    if (!S.next(0, cur)) return;
    f32x4 acc[2][2][4][2];
#pragma unroll
    for (int a = 0; a < 2; ++a)
#pragma unroll
        for (int b = 0; b < 2; ++b)
#pragma unroll
            for (int m = 0; m < 4; ++m)
#pragma unroll
                for (int n = 0; n < 2; ++n) acc[a][b][m][n] = (f32x4){0.f, 0.f, 0.f, 0.f};
    i32x8 At[4], B0[2], B1[2];
    const char* cA = (const char*)Ag + (size_t)cur.pm * tstepA + (size_t)cur.ko * 2; const char* cB = (const char*)Btg + (size_t)cur.bt * tstepB + (size_t)cur.ko * 2;
    PG8_STAGE(PG8_SB(0, 0), cB, voffB); PG8_STAGE(PG8_SB(0, 1), cB + hstepB, voffB); PG8_STAGE(PG8_SA(0, 0), cA, voffA); PG8_STAGE(PG8_SA(0, 1), cA + hstepA, voffA);
    if (wr == 1) PG8_BAR;
    PG8_WAIT_V(2); PG8_BAR;
    PG8_STAGE(PG8_SB(1, 0), cB + kstep, voffB); PG8_STAGE(PG8_SA(1, 0), cA + kstep, voffA); PG8_STAGE(PG8_SB(1, 1), cB + hstepB + kstep, voffB);
    PG8_WAIT_V(6); PG8_BAR;
    for (;;) {
        const bool has_next = S.next(ui + 1, nxt);
        const char* nA = has_next ? (const char*)Ag + (size_t)nxt.pm * tstepA + (size_t)nxt.ko * 2 : cA; const char* nB = has_next ? (const char*)Btg + (size_t)nxt.bt * tstepB + (size_t)nxt.ko * 2 : cB;
        for (int t = 0; t < nt; t += 2) {
            const bool last = (t == nt - 2);
            const char* a1 = cA + (size_t)(t + 1) * kstep;
            const char* a2 = last ? nA : cA + (size_t)(t + 2) * kstep; const char* b2 = last ? nB : cB + (size_t)(t + 2) * kstep;
            const char* a3 = a2 + kstep; const char* b3 = b2 + kstep;
            PG8_LDB(B0, 0, 0); PG8_LDB(B1, 0, 1); PG8_SCHED; PG8_LDA(At, 0, 0); PG8_STAGE(PG8_SA(1, 1), a1 + hstepA, voffA);
            PG8_WAIT_V(8); PG8_WAIT_L(0); PG8_BAR; PG8_MMA(0, 0, At, B0); PG8_MMA(0, 1, At, B1); PG8_BAR; PG8_SCHED;
            PG8_LDA(At, 0, 1); PG8_STAGE(PG8_SB(0, 0), b2, voffB); PG8_STAGE(PG8_SB(0, 1), b2 + hstepB, voffB); PG8_STAGE(PG8_SA(0, 0), a2, voffA);
            PG8_WAIT_V(8); PG8_WAIT_L(0); PG8_BAR; PG8_MMA(1, 0, At, B0); PG8_MMA(1, 1, At, B1); PG8_BAR; PG8_SCHED;
            PG8_LDB(B0, 1, 0); PG8_LDB(B1, 1, 1); PG8_SCHED; PG8_LDA(At, 1, 0); PG8_STAGE(PG8_SA(0, 1), a2 + hstepA, voffA);
            PG8_WAIT_V(8); PG8_WAIT_L(0); PG8_BAR; PG8_MMA(0, 0, At, B0); PG8_MMA(0, 1, At, B1); PG8_BAR; PG8_SCHED;
            PG8_LDA(At, 1, 1); PG8_STAGE(PG8_SB(1, 0), b3, voffB); PG8_STAGE(PG8_SB(1, 1), b3 + hstepB, voffB); PG8_STAGE(PG8_SA(1, 0), a3, voffA);
            PG8_WAIT_V(8); PG8_WAIT_L(0); PG8_BAR; PG8_MMA(1, 0, At, B0); PG8_MMA(1, 1, At, B1); PG8_BAR; PG8_SCHED;
        }
        if (wr == 0) PG8_BAR;
        if constexpr (F8) asm volatile("s_nop 15\n\ts_nop 15\n\ts_nop 15" ::: "memory");
        E(acc, cur, wr, wc, fr, fq);
        if (!has_next) break;
#pragma unroll
        for (int a = 0; a < 2; ++a)
#pragma unroll
            for (int b = 0; b < 2; ++b)
#pragma unroll
                for (int m = 0; m < 4; ++m)
#pragma unroll
                    for (int n = 0; n < 2; ++n) acc[a][b][m][n] = (f32x4){0.f, 0.f, 0.f, 0.f};
        cur = nxt; cA = nA; cB = nB; ++ui;
        if (wr == 1) PG8_BAR;
    }
    PG8_WAIT_V(0);
    PG8_BAR;
#undef PG8_SA
#undef PG8_SB
#undef PG8_STAGE
#undef PG8_LDA
#undef PG8_LDB
#undef PG8_MMA
#undef PG8_WAIT_V
#undef PG8_WAIT_L
#undef PG8_BAR
#undef PG8_SCHED
}

__device__ __forceinline__ void store8(bf16_t* p, f32x4 v0, f32x4 v1) {
    u32x4 w; w.x = cvt_pk_bf16(v0[0], v0[1]); w.y = cvt_pk_bf16(v0[2], v0[3]); w.z = cvt_pk_bf16(v1[0], v1[1]); w.w = cvt_pk_bf16(v1[2], v1[3]);
    *(u32x4*)p = w;
}
__device__ __forceinline__ void rope8(f32x4& v0, f32x4& v1, const float* cs) {
    const f32x4 c0 = *(const f32x4*)cs, c1 = *(const f32x4*)(cs + 4);
    f32x4 o0, o1;
    o0[0] = v0[0] * c0[0] - v0[1] * c0[1]; o0[1] = v0[1] * c0[0] + v0[0] * c0[1];
    o0[2] = v0[2] * c0[2] - v0[3] * c0[3]; o0[3] = v0[3] * c0[2] + v0[2] * c0[3];
    o1[0] = v1[0] * c1[0] - v1[1] * c1[1]; o1[1] = v1[1] * c1[0] + v1[0] * c1[1];
    o1[2] = v1[2] * c1[2] - v1[3] * c1[3]; o1[3] = v1[3] * c1[2] + v1[2] * c1[3];
    v0 = o0; v1 = o1;
}
struct EpiH {
    static constexpr bool PERM = true;
    bf16_t* H; float* ssq; float* sskv; const float* tab;
    __device__ __forceinline__ void operator()(const f32x4 (&acc)[2][2][4][2], const Unit& u, int wr, int wc, int fr, int fq) const {
        const int row0 = u.pm * BM + wr * 64 + fr;
#pragma unroll
        for (int bj = 0; bj < 2; ++bj) {
            const int g32 = u.pn * BM + bj * HALF + wc * 32, col0 = g32 + 8 * fq;
            const int seg = g32 < C_CKV ? 0 : (g32 < C_KR ? 1 : (g32 < C_DQ ? 2 : 3));
#pragma unroll
            for (int ai = 0; ai < 2; ++ai)
#pragma unroll
                for (int m = 0; m < 4; ++m) {
                    const int row = row0 + ai * HALF + m * 16;
                    f32x4 v0 = acc[ai][bj][m][0], v1 = acc[ai][bj][m][1];
                    if (seg < 2) {
                        float s = (v0[0] * v0[0] + v0[1] * v0[1]) + (v0[2] * v0[2] + v0[3] * v0[3]) + (v1[0] * v1[0] + v1[1] * v1[1]) + (v1[2] * v1[2] + v1[3] * v1[3]);
                        s += __shfl_xor(s, 16); s += __shfl_xor(s, 32);
                        if (fq == 0) ssq[(size_t)row * 32 + (g32 >> 5)] = s;
                    } else if (seg == 2) {
                        rope8(v0, v1, tab + (size_t)(row & (SEQ - 1)) * 64 + (col0 - C_KR));
                    }
                    store8(H + (size_t)row * HC + col0, v0, v1);
                    asm volatile("" ::: "memory");
                }
        }
    }
};
struct EpiQ {
    static constexpr bool PERM = true;
    bf16_t* Q; const float* ssq; const float* tab;
    __device__ __forceinline__ void operator()(const f32x4 (&acc)[2][2][4][2], const Unit& u, int wr, int wc, int fr, int fq) const {
        const int row0 = u.pm * BM + wr * 64 + fr;
#pragma unroll
        for (int ai = 0; ai < 2; ++ai)
#pragma unroll
            for (int m = 0; m < 4; ++m) {
                const int row = row0 + ai * HALF + m * 16;
                const f32x4 q0 = *(const f32x4*)(ssq + (size_t)row * 32), q1 = *(const f32x4*)(ssq + (size_t)row * 32 + 4), q2 = *(const f32x4*)(ssq + (size_t)row * 32 + 8);
                const float rs = __builtin_amdgcn_rsqf((((q0[0] + q0[1]) + (q0[2] + q0[3])) + ((q1[0] + q1[1]) + (q1[2] + q1[3])) + ((q2[0] + q2[1]) + (q2[2] + q2[3]))) * (1.0f / 384.0f) + 1e-6f);
#pragma unroll
                for (int bj = 0; bj < 2; ++bj) {
                    const int g32 = u.pn * BM + bj * HALF + wc * 32, col0 = g32 + 8 * fq;
                    const int inh = g32 % 192;
                    f32x4 v0 = acc[ai][bj][m][0] * rs, v1 = acc[ai][bj][m][1] * rs;
                    if (inh >= 128) rope8(v0, v1, tab + (size_t)(row & (SEQ - 1)) * 64 + (inh - 128 + 8 * fq));
                    store8(Q + (size_t)row * QMC + col0, v0, v1);
                }
                asm volatile("" ::: "memory");
            }
    }
};
struct EpiKV {
    static constexpr bool PERM = true;
    bf16_t* O; const float* sskv;
    __device__ __forceinline__ void operator()(const f32x4 (&acc)[2][2][4][2], const Unit& u, int wr, int wc, int fr, int fq) const {
        const int row0 = u.pm * BM + wr * 64 + fr;
#pragma unroll
        for (int ai = 0; ai < 2; ++ai)
#pragma unroll
            for (int m = 0; m < 4; ++m) {
                const int row = row0 + ai * HALF + m * 16;
                const f32x4 q0 = *(const f32x4*)(sskv + (size_t)row * 32 + 12), q1 = *(const f32x4*)(sskv + (size_t)row * 32 + 16);
                const float rs = __builtin_amdgcn_rsqf((((q0[0] + q0[1]) + (q0[2] + q0[3])) + ((q1[0] + q1[1]) + (q1[2] + q1[3]))) * (1.0f / 256.0f) + 1e-6f);
#pragma unroll
                for (int bj = 0; bj < 2; ++bj) {
                    const int col0 = u.pn * BM + bj * HALF + wc * 32 + 8 * fq;
                    store8(O + (size_t)row * KVC + col0, acc[ai][bj][m][0] * rs, acc[ai][bj][m][1] * rs);
                }
            }
    }
};
struct EpiY {
    static constexpr bool PERM = false;
    const float* X; ystream_t* Y; float asc;
    __device__ __forceinline__ void operator()(const f32x4 (&acc)[2][2][4][2], const Unit& u, int wr, int wc, int fr, int fq) const {
        const int row0 = u.pm * BM + wr * 64 + fr, colb = u.pn * BM + wc * 32 + 4 * fq;
#pragma unroll
        for (int ai = 0; ai < 2; ++ai)
#pragma unroll
            for (int m = 0; m < 4; ++m) {
                const size_t off = (size_t)(row0 + ai * HALF + m * 16) * DM + colb;
#pragma unroll
                for (int bj = 0; bj < 2; ++bj)
#pragma unroll
                    for (int n = 0; n < 2; ++n) { const f32x4 xv = *(const f32x4*)(X + off + bj * HALF + n * 16); st4h(Y + off + bj * HALF + n * 16, xv * DN_ALPHA + acc[ai][bj][m][n] * asc); }
            }
    }
};
struct EpiYLN {
    static constexpr bool PERM = false;
    ystream_t* Y; const float* st; const float* g; const float* b; float asc; int so;
    __device__ __forceinline__ void operator()(const f32x4 (&acc)[2][2][4][2], const Unit& u, int wr, int wc, int fr, int fq) const {
        const int row0 = u.pm * BM + wr * 64 + fr, colb = u.pn * BM + wc * 32 + 4 * fq;
#pragma unroll
        for (int ai = 0; ai < 2; ++ai)
#pragma unroll
            for (int m = 0; m < 4; ++m) {
                const int row = row0 + ai * HALF + m * 16;
                const float mu = st[(size_t)row * 32 + so], rs = st[(size_t)row * 32 + so + 1];
                const size_t off = (size_t)row * DM + colb;
#pragma unroll
                for (int bj = 0; bj < 2; ++bj)
#pragma unroll
                    for (int n = 0; n < 2; ++n) { const int c = colb + bj * HALF + n * 16;
                        const f32x4 gv = *(const f32x4*)(g + c), bv = *(const f32x4*)(b + c), yv = ld4h(Y + off + bj * HALF + n * 16);
                        st4h(Y + off + bj * HALF + n * 16, ((yv - mu) * rs * gv + bv) * DN_ALPHA + acc[ai][bj][m][n] * asc); }
                asm volatile("" ::: "memory");
            }
    }
};
struct EpiSwiGLU {
    static constexpr bool PERM = true;
    bf16_t* O; int ldo;
    __device__ __forceinline__ void operator()(const f32x4 (&acc)[2][2][4][2], const Unit& u, int wr, int wc, int fr, int fq) const {
        const int row0 = u.pm * BM + wr * 64 + fr, col0 = u.pn * HALF + wc * 32 + 8 * fq;
#pragma unroll
        for (int ai = 0; ai < 2; ++ai)
#pragma unroll
            for (int m = 0; m < 4; ++m) {
                f32x4 r[2];
#pragma unroll
                for (int n = 0; n < 2; ++n) { const f32x4 g = acc[ai][0][m][n], up = acc[ai][1][m][n];
#pragma unroll
                    for (int j = 0; j < 4; ++j) { const float e = __builtin_amdgcn_exp2f(-g[j] * LOG2E); r[n][j] = g[j] * __builtin_amdgcn_rcpf(1.0f + e) * up[j]; } }
                store8(O + (size_t)(row0 + ai * HALF + m * 16) * ldo + col0, r[0], r[1]);
            }
    }
};
struct EpiSwiGLU8 {
    static constexpr bool PERM = true;
    unsigned char* O; int ldo;
    __device__ __forceinline__ void operator()(const f32x4 (&acc)[2][2][4][2], const Unit& u, int wr, int wc, int fr, int fq) const {
        const int row0 = u.pm * BM + wr * 64 + fr, col0 = u.pn * HALF + wc * 32 + 8 * fq;
#pragma unroll
        for (int ai = 0; ai < 2; ++ai)
#pragma unroll
            for (int m = 0; m < 4; ++m) {
                f32x4 r[2];
#pragma unroll
                for (int n = 0; n < 2; ++n) { const f32x4 g = acc[ai][0][m][n] * (1.0f / W8_GU), up = acc[ai][1][m][n] * (A8_ACT / W8_GU);
#pragma unroll
                    for (int j = 0; j < 4; ++j) { const float e = __builtin_amdgcn_exp2f(-g[j] * LOG2E); r[n][j] = g[j] * __builtin_amdgcn_rcpf(1.0f + e) * up[j]; } }
                u32x2 w; w.x = cvt4_fp8(r[0][0], r[0][1], r[0][2], r[0][3]); w.y = cvt4_fp8(r[1][0], r[1][1], r[1][2], r[1][3]);
                *(u32x2*)(O + (size_t)(row0 + ai * HALF + m * 16) * ldo + col0) = w;
            }
    }
};
struct EpiBf16 {
    static constexpr bool PERM = true;
    bf16_t* O; int ldo; size_t sstride; float osc;
    __device__ __forceinline__ void operator()(const f32x4 (&acc)[2][2][4][2], const Unit& u, int wr, int wc, int fr, int fq) const {
        const int row0 = u.pm * BM + wr * 64 + fr;
#pragma unroll
        for (int ai = 0; ai < 2; ++ai)
#pragma unroll
            for (int m = 0; m < 4; ++m)
#pragma unroll
                for (int bj = 0; bj < 2; ++bj)
                    store8(O + (size_t)u.os * sstride + (size_t)(row0 + ai * HALF + m * 16) * ldo + u.pn * BM + bj * HALF + wc * 32 + 8 * fq, acc[ai][bj][m][0] * osc, acc[ai][bj][m][1] * osc);
    }
};
struct EpiF8 {
    static constexpr bool PERM = true;
    unsigned char* O; int ldo; size_t sstride; float osc;
    __device__ __forceinline__ void operator()(const f32x4 (&acc)[2][2][4][2], const Unit& u, int wr, int wc, int fr, int fq) const {
        const int row0 = u.pm * BM + wr * 64 + fr;
#pragma unroll
        for (int ai = 0; ai < 2; ++ai)
#pragma unroll
            for (int m = 0; m < 4; ++m)
#pragma unroll
                for (int bj = 0; bj < 2; ++bj) { const f32x4 v0 = acc[ai][bj][m][0] * osc, v1 = acc[ai][bj][m][1] * osc;
                    u32x2 w; w.x = cvt4_fp8(v0[0], v0[1], v0[2], v0[3]); w.y = cvt4_fp8(v1[0], v1[1], v1[2], v1[3]);
                    *(u32x2*)(O + (size_t)u.os * sstride + (size_t)(row0 + ai * HALF + m * 16) * ldo + u.pn * BM + bj * HALF + wc * 32 + 8 * fq) = w; }
    }
};
}

namespace att {
constexpr int NW = 8, QBLK = 32, KVBLK = 64, QB = 256;
constexpr int SHM_V = KVBLK * 128 * 2;
constexpr int LDS_K = 2 * SHM_V, LDS_WS = LDS_K + 2 * 64 * 192 * 2, LDS_BIAS = LDS_WS + NW * 64 * 4, LDS_QR = LDS_BIAS + 512;
#define SBAR() __builtin_amdgcn_sched_barrier(0)
__device__ __forceinline__ int v_st(int k, int c) { const int kk = (k & ~0xC) | ((k & 4) << 1) | ((k & 8) >> 1); return ((kk >> 3) * 4 + (c >> 5)) * 512 + ((kk & 7) * 32 + (c & 31)) * 2; }
__device__ __forceinline__ int v_rd_base(int lane) { return ((lane & 3) << 3) | (((lane >> 2) & 3) << 6) | (((lane >> 4) & 1) << 5) | (((lane >> 5) & 1) << 8); }
constexpr int v_rd_off(int d0, int ks, int half) { return d0 * 512 + ks * 4096 + half * 2048; }
__device__ __forceinline__ int crow(int r, int hi) { return (r & 3) + 8 * (r >> 2) + 4 * hi; }
__device__ __forceinline__ unsigned cvtpk(float lo, float hi) { unsigned r; asm volatile("v_cvt_pk_bf16_f32 %0, %1, %2" : "=v"(r) : "v"(lo), "v"(hi)); return r; }

__device__ __forceinline__ void mask_tile(f32x16& p0, f32x16& p1, int dq) {
    const float NEG = -__builtin_inff();
#pragma unroll
    for (int r = 0; r < 16; ++r) {
        const int c = (r & 3) + 8 * (r >> 2);
        if (dq - c < 0) p0[r] = NEG;
        if (dq - c - 32 < 0) p1[r] = NEG;
    }
}
__device__ __forceinline__ void bias_tile(f32x16& p0, f32x16& p1, int dq, const float* tb) {
#pragma unroll
    for (int r = 0; r < 16; ++r) {
        const int c = (r & 3) + 8 * (r >> 2);
        int d0 = dq - c, d1 = dq - c - 32;
        d0 = d0 < 0 ? 0 : (d0 > 127 ? 127 : d0); d1 = d1 < 0 ? 0 : (d1 > 127 ? 127 : d1);
        p0[r] += tb[d0]; p1[r] += tb[d1];
    }
}
constexpr float THR = 8.f;
__device__ __forceinline__ void partialSM(f32x16& p0, f32x16& p1, float& m_reg, float& mn, float& alpha) {
    float pmax = p0[0];
#pragma unroll
    for (int r = 1; r < 16; ++r) pmax = fmaxf(pmax, p0[r]);
#pragma unroll
    for (int r = 0; r < 16; ++r) pmax = fmaxf(pmax, p1[r]);
    { auto rr = __builtin_amdgcn_permlane32_swap(__float_as_uint(pmax), __float_as_uint(pmax), false, false);
      pmax = fmaxf(__uint_as_float(rr[0]), __uint_as_float(rr[1])); }
    if (__builtin_expect(__all((pmax - m_reg) <= THR), 1)) { mn = m_reg; alpha = 1.f; }
    else { mn = fmaxf(m_reg, pmax); alpha = __builtin_amdgcn_exp2f(m_reg - mn); m_reg = mn; }
#pragma unroll
    for (int r = 0; r < 16; ++r) p0[r] = p0[r] - mn;
#pragma unroll
    for (int r = 0; r < 16; ++r) p1[r] = p1[r] - mn;
#pragma unroll
    for (int r = 0; r < 16; ++r) p0[r] = __builtin_amdgcn_exp2f(p0[r]);
}
__device__ __forceinline__ void finishSM(f32x16& p0, f32x16& p1, float alpha, float& l_reg, bf16x8& pa0, bf16x8& pa1, bf16x8& pa2, bf16x8& pa3) {
#pragma unroll
    for (int r = 0; r < 16; ++r) p1[r] = __builtin_amdgcn_exp2f(p1[r]);
    float ps = 0;
#pragma unroll
    for (int r = 0; r < 16; ++r) ps += p0[r];
#pragma unroll
    for (int r = 0; r < 16; ++r) ps += p1[r];
    { auto rr = __builtin_amdgcn_permlane32_swap(__float_as_uint(ps), __float_as_uint(ps), false, false);
      ps = __uint_as_float(rr[0]) + __uint_as_float(rr[1]); }
    l_reg = l_reg * alpha + ps;
#define PK4(P, B_, OUT) do { unsigned a0 = cvtpk(P[B_+0], P[B_+1]), a1 = cvtpk(P[B_+2], P[B_+3]);                          \
        unsigned b0 = cvtpk(P[B_+4], P[B_+5]), b1 = cvtpk(P[B_+6], P[B_+7]);                                             \
        auto r0 = __builtin_amdgcn_permlane32_swap(a0, b0, false, false); auto r1 = __builtin_amdgcn_permlane32_swap(a1, b1, false, false); \
        u32x4 w = {r0[0], r1[0], r0[1], r1[1]}; OUT = *reinterpret_cast<bf16x8*>(&w); } while (0)
    PK4(p0, 0, pa0); PK4(p0, 8, pa1); PK4(p1, 0, pa2); PK4(p1, 8, pa3);
#undef PK4
}
template <int DQK> __device__ __forceinline__ int kswz(int row, int colB) { return row * (DQK * 2) + (colB ^ ((row & 7) << 4)); }
template <int KB, int DQK>
__device__ __forceinline__ void qkt(f32x16& p0, f32x16& p1, const char* K_lds, int r32, int hi, const bf16x8* qr, const char* qrl) {
    constexpr int SHMK = 64 * DQK * 2, NF = DQK / 16, NFR = NF > 8 ? 8 : NF;
    p0 = f32x16{}; p1 = f32x16{};
    const char* kb[4];
#pragma unroll
    for (int dd = 0; dd < 4; ++dd) kb[dd] = K_lds + KB * SHMK + kswz<DQK>(r32, (dd * 16 + hi * 8) * 2);
#pragma unroll
    for (int d0 = 0; d0 < NF; ++d0) { const char* a = kb[d0 & 3] + (d0 >> 2) * 128;
        bf16x8 b0 = *reinterpret_cast<const bf16x8*>(a);
        bf16x8 b1 = *reinterpret_cast<const bf16x8*>(a + 32 * DQK * 2);
        bf16x8 q; if (d0 < NFR) q = qr[d0]; else q = *reinterpret_cast<const bf16x8*>(qrl + (d0 - NFR) * 1024);
        p0 = __builtin_amdgcn_mfma_f32_32x32x16_bf16(b0, q, p0, 0, 0, 0);
        p1 = __builtin_amdgcn_mfma_f32_32x32x16_bf16(b1, q, p1, 0, 0, 0); }
}
template <int VB>
__device__ __forceinline__ void pv_tile(f32x16* o, int vb0, bf16x8 pa0, bf16x8 pa1, bf16x8 pa2, bf16x8 pa3) {
#define TRRD(dst, off) asm volatile("ds_read_b64_tr_b16 %0, %1 offset:%2" : "=&v"(dst) : "v"(vb0), "i"(off) : "memory")
#define PV_D0(d0) do { s16x4 l0, l1, l2, l3, h0, h1, h2, h3; constexpr int b_ = VB * SHM_V + v_rd_off(d0, 0, 0); \
        TRRD(l0, b_); TRRD(h0, b_ + 2048); TRRD(l1, b_ + 4096); TRRD(h1, b_ + 6144); TRRD(l2, b_ + 8192); TRRD(h2, b_ + 10240); TRRD(l3, b_ + 12288); TRRD(h3, b_ + 14336); \
        asm volatile("s_waitcnt lgkmcnt(0)" ::: "memory"); SBAR();   \
        o[d0] = __builtin_amdgcn_mfma_f32_32x32x16_bf16(pa0, (bf16x8){l0[0], l0[1], l0[2], l0[3], h0[0], h0[1], h0[2], h0[3]}, o[d0], 0, 0, 0);   \
        o[d0] = __builtin_amdgcn_mfma_f32_32x32x16_bf16(pa1, (bf16x8){l1[0], l1[1], l1[2], l1[3], h1[0], h1[1], h1[2], h1[3]}, o[d0], 0, 0, 0);   \
        o[d0] = __builtin_amdgcn_mfma_f32_32x32x16_bf16(pa2, (bf16x8){l2[0], l2[1], l2[2], l2[3], h2[0], h2[1], h2[2], h2[3]}, o[d0], 0, 0, 0);   \
        o[d0] = __builtin_amdgcn_mfma_f32_32x32x16_bf16(pa3, (bf16x8){l3[0], l3[1], l3[2], l3[3], h3[0], h3[1], h3[2], h3[3]}, o[d0], 0, 0, 0); } while (0)
    PV_D0(0); PV_D0(1); PV_D0(2); PV_D0(3);
#undef PV_D0
#undef TRRD
}

struct AttnArgs {
    const bf16_t* Q; const bf16_t* K; const bf16_t* K2; const bf16_t* V; int P0;
    bf16_t* Out; float* O0; float lam; const float* dnorm; float oscale;
};
template <bool MLA, int MODE, bool PIPE>
__device__ __forceinline__ void attn_block(const AttnArgs& a, char* lds) {
    constexpr int DQK = MLA ? 192 : 64, NF = DQK / 16, KROW = DQK * 2, SHMK = 64 * KROW;
    constexpr bool BIAS = !MLA;
    int tid_ = threadIdx.x; asm volatile("" : "+v"(tid_));
    const int tid = tid_, wid = __builtin_amdgcn_readfirstlane(tid >> 6), lane = tid & 63, r32 = lane & 31, hi = lane >> 5;
    constexpr int ldq = MLA ? QMC : HC, ldk = KVC, ldk2 = HC, ldv = MLA ? KVC : HC;
    const int P0 = a.P0, NT = (P0 + QB) / KVBLK;
    const int qlo = P0 + wid * QBLK, qm = qlo + r32 - 4 * hi;
    char* V_lds = lds; char* K_lds = lds + LDS_K;
    float* ws = (float*)(lds + LDS_WS) + wid * 64; float* li_l = ws; float* al_l = ws + 32;
    const float* tb = (const float*)(lds + LDS_BIAS);
    float m_reg = -1e30f, l_reg = 0; f32x16 o[4] = {};
    const int sr = tid >> 4, sc = (tid & 15) * 8, vst0 = v_st(sr, sc), vst1 = v_st(32 + sr, sc);
    const int kws = kswz<DQK>(sr, sc * 2);
    const int kr_row = tid >> 3, kr_c = (tid & 7) * 8;
    const int kws2 = kswz<DQK>(kr_row, ((MLA ? 128 : 0) + kr_c) * 2);
    const int vb0 = (int)(uintptr_t)V_lds + v_rd_base(lane);
    bf16x8 st_v0, st_v1, st_k0, st_k1, st_k2;
    constexpr int NFR = NF > 8 ? 8 : NF;
    bf16x8 qr[NFR];
    char* qrl = lds + LDS_QR + wid * 4096 + lane * 16;
#pragma unroll
    for (int d0 = 0; d0 < NFR; ++d0) qr[d0] = *reinterpret_cast<const bf16x8*>(a.Q + (size_t)(qlo + r32) * ldq + d0 * 16 + hi * 8);
#pragma unroll
    for (int d0 = NFR; d0 < NF; ++d0) *reinterpret_cast<bf16x8*>(qrl + (d0 - NFR) * 1024) = *reinterpret_cast<const bf16x8*>(a.Q + (size_t)(qlo + r32) * ldq + d0 * 16 + hi * 8);
    const unsigned voV = (unsigned)(sr * ldv + sc) * 2u, voK = (unsigned)(sr * ldk + sc) * 2u, voK2 = (unsigned)(kr_row * ldk2 + kr_c) * 2u;
    constexpr size_t v32 = (size_t)32 * ldv * 2, k32 = (size_t)32 * ldk * 2;
#define VMW() asm volatile("s_waitcnt vmcnt(0)" ::: "memory")
#define SLOAD(k0) do { const char* vb_ = (const char*)a.V + (size_t)(k0) * ldv * 2; const char* k2b_ = (const char*)a.K2 + (size_t)(k0) * ldk2 * 2; \
        st_v0 = *reinterpret_cast<const bf16x8*>(vb_ + voV); st_v1 = *reinterpret_cast<const bf16x8*>(vb_ + v32 + voV); \
        if constexpr (MLA) { const char* kb_ = (const char*)a.K + (size_t)(k0) * ldk * 2; st_k0 = *reinterpret_cast<const bf16x8*>(kb_ + voK); st_k1 = *reinterpret_cast<const bf16x8*>(kb_ + k32 + voK); } \
        st_k2 = *reinterpret_cast<const bf16x8*>(k2b_ + voK2); } while (0)
#define SWRITE(bf) do { *(bf16x8*)(V_lds + (bf) * SHM_V + vst0) = st_v0; *(bf16x8*)(V_lds + (bf) * SHM_V + vst1) = st_v1; \
        if constexpr (MLA) { *(bf16x8*)(K_lds + (bf) * SHMK + kws) = st_k0; *(bf16x8*)(K_lds + (bf) * SHMK + kws + 32 * KROW) = st_k1; } \
        *(bf16x8*)(K_lds + (bf) * SHMK + kws2) = st_k2; } while (0)
#define RESC(al) do { if (__any((al) < 1.f)) { if (hi == 0) al_l[r32] = (al); asm volatile("s_waitcnt lgkmcnt(0)" ::: "memory");              \
                     for (int d_ = 0; d_ < 4; ++d_) for (int r = 0; r < 16; ++r) o[d_][r] *= al_l[crow(r, hi)]; } } while (0)
#define KBASE(t) ((t) * KVBLK)
#define MASKT(P0_, P1_, t) do { const int kb_ = KBASE(t); \
        if (BIAS && kb_ + 176 > qlo) bias_tile(P0_, P1_, qm - kb_, tb); \
        if (kb_ + KVBLK - 1 > qlo) mask_tile(P0_, P1_, qm - kb_); } while (0)
    bf16x8 pa0, pa1, pa2, pa3;
    if constexpr (!PIPE) {
    f32x16 p0, p1; float mn, al;
    SLOAD(0); VMW(); SWRITE(0);
    __syncthreads();
#define STEP(t, BF) do { \
        if ((t) + 1 < NT) { SLOAD(KBASE((t) + 1)); } SBAR(); \
        qkt<BF, DQK>(p0, p1, K_lds, r32, hi, qr, qrl); \
        MASKT(p0, p1, (t)); partialSM(p0, p1, m_reg, mn, al); RESC(al); \
        finishSM(p0, p1, al, l_reg, pa0, pa1, pa2, pa3); SBAR(); \
        pv_tile<BF>(o, vb0, pa0, pa1, pa2, pa3); SBAR(); \
        if ((t) + 1 < NT) { VMW(); SWRITE(1 - (BF)); } \
        __syncthreads(); } while (0)
    for (int t = 0; t < NT; t += 2) { STEP(t, 0); STEP(t + 1, 1); }
#undef STEP
    } else {
    f32x16 pA0, pA1, pB0, pB1; float mnA, mnB, alA, alB;
    SLOAD(0); VMW(); SWRITE(0); SBAR();
    SLOAD(KBASE(1));
    __syncthreads();
    SBAR(); qkt<0, DQK>(pA0, pA1, K_lds, r32, hi, qr, qrl);
    MASKT(pA0, pA1, 0); partialSM(pA0, pA1, m_reg, mnA, alA);
    VMW(); SWRITE(1);
    __syncthreads();
#define HALF_STEP(PX0, PX1, mnX, alX, PY0, PY1, alY, t, KB, VB, SB) do {                                                      \
        SBAR(); qkt<KB, DQK>(PX0, PX1, K_lds, r32, hi, qr, qrl);                                                              \
        finishSM(PY0, PY1, alY, l_reg, pa0, pa1, pa2, pa3); SBAR();                                                           \
        if ((t) + 1 < NT) { SLOAD(KBASE((t) + 1)); SBAR(); }                                                                  \
        pv_tile<VB>(o, vb0, pa0, pa1, pa2, pa3); MASKT(PX0, PX1, (t)); partialSM(PX0, PX1, m_reg, mnX, alX);                  \
        __syncthreads();                                                                                                      \
        if ((t) + 1 < NT) { VMW(); SWRITE(SB); }                                                                              \
        RESC(alX); __syncthreads(); } while (0)
    for (int t = 1; t + 1 < NT; t += 2) {
        HALF_STEP(pB0, pB1, mnB, alB, pA0, pA1, alA, t, 1, 0, 0);
        HALF_STEP(pA0, pA1, mnA, alA, pB0, pB1, alB, t + 1, 0, 1, 1);
    }
#undef HALF_STEP
    SBAR(); qkt<1, DQK>(pB0, pB1, K_lds, r32, hi, qr, qrl); SBAR();
    finishSM(pA0, pA1, alA, l_reg, pa0, pa1, pa2, pa3); SBAR();
    pv_tile<0>(o, vb0, pa0, pa1, pa2, pa3);
    MASKT(pB0, pB1, NT - 1); partialSM(pB0, pB1, m_reg, mnB, alB); RESC(alB);
    finishSM(pB0, pB1, alB, l_reg, pa0, pa1, pa2, pa3); SBAR(); pv_tile<1>(o, vb0, pa0, pa1, pa2, pa3);
    SBAR();
    __syncthreads();
    }
    if (hi == 0) li_l[r32] = l_reg; asm volatile("s_waitcnt lgkmcnt(0)" ::: "memory");
    float rli[16];
#pragma unroll
    for (int r = 0; r < 16; ++r) rli[r] = __builtin_amdgcn_rcpf(li_l[crow(r, hi)]);
    if constexpr (MODE == 0) {
        bf16_t* Ow = a.Out + (size_t)qlo * 1024;
#pragma unroll
        for (int r = 0; r < 16; ++r) { const int orow = crow(r, hi);
#pragma unroll
            for (int d0 = 0; d0 < 4; ++d0) { const float v = o[d0][r] * rli[r]; const float vn = __shfl_xor(v, 1);
                if ((r32 & 1) == 0) *(unsigned*)(Ow + (size_t)orow * 1024 + d0 * 32 + r32) = cvtpk(v, vn); } }
    } else if constexpr (MODE == 1) {
        bf16_t* Ow = (bf16_t*)a.O0 + (size_t)qlo * 512;
#pragma unroll
        for (int r = 0; r < 16; ++r) { const int orow = crow(r, hi);
#pragma unroll
            for (int d0 = 0; d0 < 4; ++d0) { const float v = o[d0][r] * rli[r]; const float vn = __shfl_xor(v, 1);
                if ((r32 & 1) == 0) *(unsigned*)(Ow + (size_t)orow * 512 + d0 * 32 + r32) = cvtpk(v, vn); } }
    } else {
        const float* O0w = a.O0 + (size_t)qlo * 512;
        bf16_t* Ow = a.Out + (size_t)qlo * 1024;
        float gn[4];
#pragma unroll
        for (int d0 = 0; d0 < 4; ++d0) gn[d0] = a.dnorm[d0 * 32 + r32] * a.oscale;
#pragma unroll
        for (int r = 0; r < 16; ++r) { const int orow = crow(r, hi);
            float d[4]; float ss = 0.f;
#pragma unroll
            for (int d0 = 0; d0 < 4; ++d0) { d[d0] = O0w[(size_t)orow * 512 + d0 * 32 + r32] - a.lam * (o[d0][r] * rli[r]); ss += d[d0] * d[d0]; }
#pragma unroll
            for (int s = 1; s < 32; s <<= 1) ss += __shfl_xor(ss, s);
            const float rs = __builtin_amdgcn_rsqf(ss * (1.0f / 128.0f) + 1e-5f);
#pragma unroll
            for (int d0 = 0; d0 < 4; ++d0) { const float v = d[d0] * rs * gn[d0]; const float vn = __shfl_xor(v, 1);
                if ((r32 & 1) == 0) *(unsigned*)(Ow + (size_t)orow * 1024 + d0 * 32 + r32) = cvtpk(v, vn); } }
    }
    __syncthreads();
#undef VMW
#undef SLOAD
#undef SWRITE
#undef RESC
#undef KBASE
#undef MASKT
#undef HALF_STEP
}
#undef SBAR
}

struct Args {
    const float* in[22]; float* out; unsigned char* ws;
    float inv[32];
    float lam_init[4];
    unsigned char bucket[128];
    unsigned short aq[32];
    int ph_lo, ph_hi;
};

template <class F, bool F8OUT = false>
__device__ __forceinline__ void cvt_item(const F& f, const float* kscale, int K, bf16_t* WT, LAS float* scr, int item, int nblk, int lane, float mul = 1.0f) {
    const int kb = item / nblk, nb = item % nblk, k0 = 64 * kb, n0 = 32 * nb;
    if (f.contig(n0)) {
        const float* base; int ld; float sc; f(n0, base, ld, sc); sc *= mul;
        const int r8 = lane >> 3, c4 = (lane & 7) * 4;
        f32x4 v[8];
#pragma unroll
        for (int i = 0; i < 8; ++i) v[i] = __builtin_nontemporal_load((const f32x4*)(base + (size_t)(k0 + 8 * i + r8) * ld + c4));
#pragma unroll
        for (int i = 0; i < 8; ++i) { const int kk = 8 * i + r8; const float m = kscale ? sc * kscale[k0 + kk] : sc;
            scr[kk * 33 + c4 + 0] = v[i][0] * m; scr[kk * 33 + c4 + 1] = v[i][1] * m; scr[kk * 33 + c4 + 2] = v[i][2] * m; scr[kk * 33 + c4 + 3] = v[i][3] * m; }
    } else {
        const float* src; int ld; float sc; f(n0 + (lane & 31), src, ld, sc); sc *= mul;
#pragma unroll 8
        for (int i = 0; i < 32; ++i) { const int kk = 2 * i + (lane >> 5); float v = src[(size_t)(k0 + kk) * ld] * sc; if (kscale) v *= kscale[k0 + kk]; scr[kk * 33 + (lane & 31)] = v; }
    }
    LDS_WAIT(); asm volatile("" ::: "memory");
    const int c = lane & 7;
#pragma unroll
    for (int j = 0; j < 4; ++j) { const int n = (lane >> 3) + 8 * j; const LAS float* s = scr + (8 * c) * 33 + n;
        if constexpr (F8OUT) {
            u32x2 o; o.x = cvt4_fp8(s[0 * 33], s[1 * 33], s[2 * 33], s[3 * 33]); o.y = cvt4_fp8(s[4 * 33], s[5 * 33], s[6 * 33], s[7 * 33]);
            *(u32x2*)((unsigned char*)WT + (size_t)(n0 + n) * K + k0 + 8 * c) = o;
        } else {
            u32x4 o; o.x = cvt_pk_bf16(s[0 * 33], s[1 * 33]); o.y = cvt_pk_bf16(s[2 * 33], s[3 * 33]); o.z = cvt_pk_bf16(s[4 * 33], s[5 * 33]); o.w = cvt_pk_bf16(s[6 * 33], s[7 * 33]);
            *(u32x4*)(WT + (size_t)(n0 + n) * K + k0 + 8 * c) = o; } }
    LDS_WAIT(); asm volatile("" ::: "memory");
}
struct MapWin { const float* W;
    __device__ __forceinline__ bool contig(int n0) const { return !(n0 >= C_KR && n0 < C_DQ); }
    __device__ __forceinline__ void operator()(int n, const float*& src, int& ld, float& sc) const {
        ld = 2240; sc = 1.f; int c = n;
        if (n >= 2240) { c = 0; sc = 0.f; }
        else if (n >= C_KR && n < C_DQ) { const int j = n - C_KR, i = j >> 1; c = C_KR + ((j & 1) ? 32 + i : i); }
        else if (n >= C_DQ && n < C_DK) sc = 0.125f * LOG2E;
        src = W + c; } };
struct MapWuq { const float* W;
    __device__ __forceinline__ bool contig(int n0) const { return (n0 % 192) < 128; }
    __device__ __forceinline__ void operator()(int n, const float*& src, int& ld, float& sc) const {
        ld = 768; sc = 0.07216878364870323f * LOG2E;
        const int hh = n / 192, j = n % 192; int c = j;
        if (j >= 128) { const int jj = j - 128, i = jj >> 1; c = 128 + ((jj & 1) ? 32 + i : i); }
        src = W + hh * 192 + c; } };
struct MapWukv { const float* Wk; const float* Wv;
    __device__ __forceinline__ bool contig(int) const { return true; }
    __device__ __forceinline__ void operator()(int n, const float*& src, int& ld, float& sc) const { ld = 512; sc = 1.f; src = n < 512 ? Wk + n : Wv + (n - 512); } };
struct MapPlain { const float* W; int N;
    __device__ __forceinline__ bool contig(int) const { return true; }
    __device__ __forceinline__ void operator()(int n, const float*& src, int& ld, float& sc) const { ld = N; sc = 1.f; src = W + n; } };
struct MapGU { const float* Wg; const float* Wu; int F;
    __device__ __forceinline__ bool contig(int) const { return true; }
    __device__ __forceinline__ void operator()(int n, const float*& src, int& ld, float& sc) const { ld = F; sc = 1.f; const int pn = n >> 8, j = n & 255; src = (j < 128) ? Wg + pn * 128 + j : Wu + pn * 128 + (j - 128); } };

__device__ __forceinline__ void cvt_moe(const Args& a, int ml, LAS float* scr, int gw, int NGW, int lane) {
    asm volatile("" : "+v"(lane));
    constexpr int I_GU = (DM / 64) * (2 * FFE / 32), I_D = (FFE / 64) * (DM / 32), I_E = I_GU + I_D;
    const float* wg = gfp(a.in[oi(19)]) + (size_t)ml * NEXP * DM * FFE; const float* wu = gfp(a.in[oi(20)]) + (size_t)ml * NEXP * DM * FFE; const float* wd = gfp(a.in[oi(21)]) + (size_t)ml * NEXP * FFE * DM;
    unsigned char* wsl = opq(a.ws); bf16_t* mgu = (bf16_t*)(wsl + WS_MGU); bf16_t* md = (bf16_t*)(wsl + WS_MD);
    for (int it = gw; it < NEXP * I_E; it += NGW) {
        const int e = it / I_E; int r = it % I_E;
        if (r < I_GU) { MapGU f{wg + (size_t)e * DM * FFE, wu + (size_t)e * DM * FFE, FFE}; cvt_item<MapGU, true>(f, nullptr, DM, (bf16_t*)((unsigned char*)mgu + (size_t)e * 2 * FFE * DM), scr, r, 2 * FFE / 32, lane, W8_GU); }
        else { r -= I_GU; MapPlain f{wd + (size_t)e * FFE * DM, DM}; cvt_item<MapPlain, true>(f, nullptr, FFE, (bf16_t*)((unsigned char*)md + (size_t)e * DM * FFE), scr, r, DM / 32, lane, W8_D); }
    }
}

template <int MODE, bool ROUTE, bool OUT8 = false, bool NOX = false, bool WRY = false>
__device__ __forceinline__ void ln_pass(const Args& a, const ystream_t* Ysrc, const float* Xres, const float* g, const float* b, float* Xout, bf16_t* XB,
                                        const float* router, unsigned* cnt, int gw, int NGW, int lane, LAS unsigned char* lds_, const float* g1 = nullptr, const float* b1 = nullptr, int stslot = 20) {
    asm volatile("" : "+v"(lane));
    unsigned char* wsl = opq(a.ws);
    const bf16_t* oslot = (const bf16_t*)(wsl + WS_OSLOT); const bf16_t* oslot2 = (const bf16_t*)(wsl + WS_OSLOT2);
    f32x4* route = (f32x4*)(wsl + WS_ROUTE);
    const int* slots = (const int*)(wsl + WS_ROUTE + 512 * 1024);
    float* st = (float*)(wsl + WS_SS);
    unsigned long long pk = 0ull;
#pragma unroll 2
    for (int m = gw; m < M; m += NGW) {
        f32x4 v[4];
        if constexpr (MODE == 0) {
#pragma unroll
            for (int j = 0; j < 4; ++j) v[j] = ld4h(Ysrc + (size_t)m * DM + (lane + 64 * j) * 4);
        } else {
            const f32x4 rt = route[m]; const int s1 = slots[2 * m], s2 = slots[2 * m + 1];
            const float mu1 = st[(size_t)m * 32 + 20], rs1 = st[(size_t)m * 32 + 21];
#pragma unroll
            for (int j = 0; j < 4; ++j) { const f32x4 yv1 = ld4h(Ysrc + (size_t)m * DM + (lane + 64 * j) * 4);
                const f32x4 xv = (yv1 - mu1) * rs1 * *((const f32x4*)g1 + lane + 64 * j) + *((const f32x4*)b1 + lane + 64 * j);
                const unsigned o1 = *((const unsigned*)((const unsigned char*)oslot + (size_t)s1 * DM) + lane + 64 * j), o2 = *((const unsigned*)((const unsigned char*)oslot + (size_t)s2 * DM) + lane + 64 * j);
                const unsigned p1 = *((const unsigned*)((const unsigned char*)oslot2 + (size_t)s1 * DM) + lane + 64 * j), p2 = *((const unsigned*)((const unsigned char*)oslot2 + (size_t)s2 * DM) + lane + 64 * j);
                const f32x2 a1l = __builtin_amdgcn_cvt_pk_f32_fp8((int)o1, false), a1h = __builtin_amdgcn_cvt_pk_f32_fp8((int)o1, true), b1l = __builtin_amdgcn_cvt_pk_f32_fp8((int)p1, false), b1h = __builtin_amdgcn_cvt_pk_f32_fp8((int)p1, true);
                const f32x2 a2l = __builtin_amdgcn_cvt_pk_f32_fp8((int)o2, false), a2h = __builtin_amdgcn_cvt_pk_f32_fp8((int)o2, true), b2l = __builtin_amdgcn_cvt_pk_f32_fp8((int)p2, false), b2h = __builtin_amdgcn_cvt_pk_f32_fp8((int)p2, true);
                const float g1s = rt[2] * (1.0f / O8), g2s = rt[3] * (1.0f / O8);
                f32x4 r;
                r[0] = xv[0] * DN_ALPHA + g1s * (a1l.x + b1l.x) + g2s * (a2l.x + b2l.x);
                r[1] = xv[1] * DN_ALPHA + g1s * (a1l.y + b1l.y) + g2s * (a2l.y + b2l.y);
                r[2] = xv[2] * DN_ALPHA + g1s * (a1h.x + b1h.x) + g2s * (a2h.x + b2h.x);
                r[3] = xv[3] * DN_ALPHA + g1s * (a1h.y + b1h.y) + g2s * (a2h.y + b2h.y);
                if constexpr (WRY) st4h((ystream_t*)Ysrc + (size_t)m * DM + (lane + 64 * j) * 4, r);
                v[j] = r; }
        }
        float s = 0.f;
#pragma unroll
        for (int j = 0; j < 4; ++j) s += (v[j][0] + v[j][1]) + (v[j][2] + v[j][3]);
        const float mean = wave_sum(s) * (1.f / DM); float s2 = 0.f;
#pragma unroll
        for (int j = 0; j < 4; ++j) { v[j] = v[j] - mean; s2 += (v[j][0] * v[j][0] + v[j][1] * v[j][1]) + (v[j][2] * v[j][2] + v[j][3] * v[j][3]); }
        const float rstd = __builtin_amdgcn_rsqf(wave_sum(s2) * (1.f / DM) + 1e-5f);
#pragma unroll
        for (int j = 0; j < 4; ++j) { const f32x4 gv = *((const f32x4*)g + lane + 64 * j), bv = *((const f32x4*)b + lane + 64 * j);
            v[j] = v[j] * rstd * gv + bv;
            if constexpr (!NOX) *((f32x4*)(Xout + (size_t)m * DM) + lane + 64 * j) = v[j];
            if constexpr (OUT8) { *((unsigned*)((unsigned char*)XB + (size_t)m * DM) + lane + 64 * j) = cvt4_fp8(v[j][0], v[j][1], v[j][2], v[j][3]); }
            else if (XB) { u32x2 w; w.x = cvt_pk_bf16(v[j][0], v[j][1]); w.y = cvt_pk_bf16(v[j][2], v[j][3]); *((u32x2*)(XB + (size_t)m * DM) + lane + 64 * j) = w; } }
        if constexpr (NOX) { if (lane == 0) { st[(size_t)m * 32 + stslot] = mean; st[(size_t)m * 32 + stslot + 1] = rstd; } }
        if constexpr (ROUTE) {
            float lg[8];
#pragma unroll
            for (int e = 0; e < 8; ++e) lg[e] = 0.f;
#pragma unroll
            for (int j = 0; j < 4; ++j)
#pragma unroll
                for (int q = 0; q < 4; ++q) { const int k = (lane + 64 * j) * 4 + q; const f32x4 r0 = *(const f32x4*)(router + (size_t)k * 8), r1 = *(const f32x4*)(router + (size_t)k * 8 + 4); const float xv = v[j][q];
                    lg[0] += xv * r0[0]; lg[1] += xv * r0[1]; lg[2] += xv * r0[2]; lg[3] += xv * r0[3]; lg[4] += xv * r1[0]; lg[5] += xv * r1[1]; lg[6] += xv * r1[2]; lg[7] += xv * r1[3]; }
#pragma unroll
            for (int e = 0; e < 8; ++e) lg[e] = wave_sum(lg[e]);
            int e1 = 0; float v1 = lg[0];
#pragma unroll
            for (int e = 1; e < 8; ++e) if (lg[e] > v1) { v1 = lg[e]; e1 = e; }
            int e2 = -1; float v2 = -__builtin_inff();
#pragma unroll
            for (int e = 0; e < 8; ++e) if (e != e1 && lg[e] > v2) { v2 = lg[e]; e2 = e; }
            const float g2 = 1.0f / (1.0f + __expf(v1 - v2)), g1 = 1.0f - g2;
            if (lane == 0) { f32x4 rt; rt[0] = __int_as_float(e1); rt[1] = __int_as_float(e2); rt[2] = g1; rt[3] = g2; route[m] = rt; }
            pk += (1ull << (8 * e1)) + (1ull << (8 * e2));
        }
    }
    if constexpr (ROUTE) {
        LAS unsigned* lc = (LAS unsigned*)(lds_ + 131072);
        const bool w0 = (gw & 7) == 0;
        if (w0 && lane < 8) lc[lane] = 0u;
        __syncthreads();
        if (lane < 8) atomicAdd((unsigned*)(lc + lane), (unsigned)((pk >> (8 * lane)) & 255ull));
        __syncthreads();
        if (w0 && lane < 8) atomicAdd(cnt + lane, lc[lane]);
    }
}

#define XB_TMO      128
#define XB_XCNT(j)  (256  + 64 * (j))
#define XB_XSUB(j)  (1280 + 64 * (j))
#define XB_XGEN(j)  (2304 + 64 * (j))
#define XB_TOP      3328
#define XB_TOPGEN   3392
#define XCD_BAR_WORDS 3456
#define XB_SPIN_CAP (1u << 22)
__device__ __forceinline__ unsigned xb_ld(unsigned* p)              { return __hip_atomic_load(p, __ATOMIC_RELAXED, __HIP_MEMORY_SCOPE_AGENT); }
__device__ __forceinline__ unsigned xb_add(unsigned* p, unsigned v) { return __hip_atomic_fetch_add(p, v, __ATOMIC_RELAXED, __HIP_MEMORY_SCOPE_AGENT); }
__device__ __forceinline__ unsigned xb_xcc_id() { return (unsigned)__builtin_amdgcn_s_getreg((3 << 11) | 20) & 0xFu; }
#define XB_SPIN(cond, bar) do { unsigned _sp = 0; while (cond) { __builtin_amdgcn_s_sleep(1); \
    if ((++_sp & 255u) == 0u) { if (xb_ld(&(bar)[XB_TMO])) break; if (_sp > XB_SPIN_CAP) { atomicAdd(&(bar)[XB_TMO], 1u); break; } } } } while (0)
struct XcdBarrier { unsigned* bar; unsigned x; volatile LAS unsigned* st; };
__device__ __forceinline__ XcdBarrier xcd_barrier_post(unsigned* bar, volatile LAS unsigned* st) {
    XcdBarrier b; b.bar = bar; b.x = xb_xcc_id(); b.st = st;
    if (threadIdx.x == 0) (void)xb_add(&bar[XB_XCNT(b.x)], 1u);
    return b;
}
__device__ __forceinline__ void xcd_barrier_complete(unsigned* bar, unsigned x, unsigned& nloc, unsigned& nx) {
    const unsigned G = gridDim.x * gridDim.y * gridDim.z;
    unsigned sum, cnt, mine, sp = 0u;
    for (;;) {
        sum = 0u; cnt = 0u; mine = 0u;
#pragma unroll
        for (unsigned j = 0; j < 16; ++j) { const unsigned c = xb_ld(&bar[XB_XCNT(j)]); sum += c; cnt += (c > 0u) ? 1u : 0u; mine = (j == x) ? c : mine; }
        if (sum == G) break;
        __builtin_amdgcn_s_sleep(1);
        if ((++sp & 255u) == 0u) { if (xb_ld(&bar[XB_TMO])) break; if (sp > XB_SPIN_CAP) { atomicAdd(&bar[XB_TMO], 1u); break; } }
    }
    nloc = mine > 0u ? mine : 1u; nx = cnt > 0u ? cnt : 1u;
}
__device__ __forceinline__ void xcd_barrier(const XcdBarrier& b) {
    asm volatile("s_waitcnt vmcnt(0)" ::: "memory");
    __syncthreads();
    if (threadIdx.x == 0) {
        unsigned* bar = b.bar;
        __builtin_amdgcn_s_waitcnt(0);
        unsigned nloc = b.st[0], nx = b.st[1];
        if (nloc == 0u) { xcd_barrier_complete(bar, b.x, nloc, nx); b.st[0] = nloc; b.st[1] = nx; }
        const unsigned old = xb_add(&bar[XB_XSUB(b.x)], 1u);
        const unsigned gen = old / nloc;
        if (old + 1u == (gen + 1u) * nloc) {
            __builtin_amdgcn_fence(__ATOMIC_RELEASE, "agent");
            asm volatile("s_waitcnt vmcnt(0)" ::: "memory");
            const unsigned og = xb_add(&bar[XB_TOP], 1u);
            const unsigned tg = og / nx;
            if (og + 1u == (tg + 1u) * nx) xb_add(&bar[XB_TOPGEN], 1u);
            else XB_SPIN(xb_ld(&bar[XB_TOPGEN]) == tg, bar);
            __builtin_amdgcn_fence(__ATOMIC_ACQUIRE, "agent");
            xb_add(&bar[XB_XGEN(b.x)], 1u);
            asm volatile("s_waitcnt vmcnt(0)" ::: "memory");
        } else {
            XB_SPIN(xb_ld(&bar[XB_XGEN(b.x)]) == gen, bar);
            __builtin_amdgcn_fence(__ATOMIC_ACQUIRE, "agent");
            asm volatile("s_waitcnt vmcnt(0)" ::: "memory");
        }
    }
    __syncthreads();
}
constexpr int CW_BAR = 16384;

__global__ void __launch_bounds__(512, 2) mega_fwd(Args a) {
    extern __shared__ __attribute__((aligned(16))) unsigned char lds_raw[];
    LAS unsigned char* lds = (LAS unsigned char*)lds_raw;
    cg::grid_group grid = cg::this_grid();
    const int tid = threadIdx.x, wave = __builtin_amdgcn_readfirstlane(tid >> 6);
#define FRESH_LANE(name) int name = threadIdx.x; asm volatile("" : "+v"(name)); name &= 63
    const int G = gridDim.x, bx = blockIdx.x;
    const int vcu = (G % 8 == 0) ? (bx % 8) * (G / 8) + bx / 8 : bx;
    const int gw = vcu * 8 + wave, NGW = G * 8;
#define ws opq(a.ws)
#define ctl ((unsigned*)(ws + WS_CTL))
#define tab ((float*)(ws + WS_TAB))
#define ssq ((float*)(ws + WS_SS))
#define sskv ((float*)(ws + WS_SS))
#define WinT ((bf16_t*)(ws + WS_WIN))
#define WuqT ((bf16_t*)(ws + WS_WUQ))
#define WukvT ((bf16_t*)(ws + WS_WUKV))
#define WoT ((bf16_t*)(ws + WS_WO))
#define WguT ((bf16_t*)(ws + WS_WGU))
#define WdT ((bf16_t*)(ws + WS_WD))
#define MguT ((bf16_t*)(ws + WS_MGU))
#define MdT ((bf16_t*)(ws + WS_MD))
#define Xf ((float*)(ws + WS_X))
#define XB ((bf16_t*)(ws + WS_XB))
#define Y ((ystream_t*)(ws + WS_Y))
#define Hb ((bf16_t*)(ws + WS_H))
#define QMb ((bf16_t*)(ws + WS_QM))
#define KVb ((bf16_t*)(ws + WS_KVB))
#define MRG ((bf16_t*)(ws + WS_MRG))
#define O0buf ((float*)(ws + WS_O0))
#define O1buf ((float*)(ws + WS_O0 + 32 * MiB))
#define ACT ((bf16_t*)(ws + WS_ACT))
#define XG ((bf16_t*)(ws + WS_XG))
#define MACT ((bf16_t*)(ws + WS_MACT))
#define OSLOT ((bf16_t*)(ws + WS_OSLOT))
    LAS float* scr = (LAS float*)(lds + wave * 16384);

    volatile LAS unsigned* bst = (volatile LAS unsigned*)(lds + LDS_BYTES - 64);
    if (tid < 2) bst[tid] = 0u;
    __syncthreads();
    XcdBarrier xbar = xcd_barrier_post((unsigned*)(ws + WS_CTL) + CW_BAR, bst);
    int ph = 0;
    const int lo = a.ph_lo, hi = a.ph_hi;
#ifndef EN
#define EN 0xFFFFF
#endif
#ifndef REP
#define REP 0
#endif
#define PH_BEGIN(k) if (lo <= ph && ph < hi) { if constexpr ((EN >> (k)) & 1) for (int rep_ = 0; rep_ < ((((REP) >> (k)) & 1) ? 2 : 1); ++rep_) {
#define PH_END() } if (ph + 1 < hi) { if (ph == 0) grid.sync(); else xcd_barrier(xbar); } } ++ph;

    PH_BEGIN(0)
    {
        FRESH_LANE(lane_);
#define lane lane_
        constexpr int I_IN = (DM / 64) * (HC / 32), I_UQ = (384 / 64) * (768 / 32), I_UKV = (256 / 64) * (1024 / 32), I_O = (DM / 64) * (DM / 32), I_L = I_IN + I_UQ + I_UKV + I_O;
        constexpr int I_GU = (DM / 64) * (2 * FFD / 32), I_D = (FFD / 64) * (DM / 32), I_F = I_GU + I_D;
        for (int it = gw; it < 4 * I_L + 2 * I_F; it += NGW) {
            if (it < 4 * I_L) { const int l = it / I_L; int r = it % I_L;
                if (r < I_IN) { MapWin f{gfp(a.in[oi(2)]) + (size_t)l * DM * 2240}; cvt_item(f, nullptr, DM, WinT + (size_t)l * HC * DM, scr, r, HC / 32, lane); continue; } r -= I_IN;
                if (r < I_UQ) { MapWuq f{gfp(a.in[oi(5)]) + (size_t)l * 384 * 768}; cvt_item(f, gfp(a.in[oi(3)]) + l * 384, 384, WuqT + (size_t)l * 768 * 384, scr, r, 768 / 32, lane); continue; } r -= I_UQ;
                if (r < I_UKV) { MapWukv f{gfp(a.in[oi(6)]) + (size_t)l * 256 * 512, gfp(a.in[oi(7)]) + (size_t)l * 256 * 512}; cvt_item(f, gfp(a.in[oi(4)]) + l * 256, 256, WukvT + (size_t)l * 1024 * 256, scr, r, 1024 / 32, lane); continue; } r -= I_UKV;
                { MapPlain f{gfp(a.in[oi(10)]) + (size_t)l * DM * DM, DM}; cvt_item(f, nullptr, DM, WoT + (size_t)l * DM * DM, scr, r, DM / 32, lane); }
            } else { const int q = it - 4 * I_L, d = q / I_F; int r = q % I_F;
                if (r < I_GU) { MapGU f{gfp(a.in[oi(15)]) + (size_t)d * DM * FFD, gfp(a.in[oi(16)]) + (size_t)d * DM * FFD, FFD}; cvt_item<MapGU, true>(f, nullptr, DM, (bf16_t*)((unsigned char*)WguT + (size_t)d * 2 * FFD * DM), scr, r, 2 * FFD / 32, lane, W8_GU); }
                else { r -= I_GU; MapPlain f{gfp(a.in[oi(17)]) + (size_t)d * FFD * DM, DM}; cvt_item<MapPlain, true>(f, nullptr, FFD, (bf16_t*)((unsigned char*)WdT + (size_t)d * DM * FFD), scr, r, DM / 32, lane, W8_D); }
            }
        }
        cvt_moe(a, 0, scr, gw, NGW, fresh_lane());
        for (int m = gw; m < M; m += NGW) {
#pragma unroll
            for (int j = 0; j < 4; ++j) { const f32x4 v = *((const f32x4*)(gfp(a.in[oi(0)]) + (size_t)m * DM) + lane + 64 * j); u32x2 w; w.x = cvt_pk_bf16(v[0], v[1]); w.y = cvt_pk_bf16(v[2], v[3]); *((u32x2*)(XB + (size_t)m * DM) + lane + 64 * j) = w; }
        }
        for (int i = bx * 512 + tid; i < SEQ * 32; i += G * 512) { const int pos = i >> 5, fi = i & 31; const float ang = (float)pos * a.inv[fi];
            const double rev = (double)ang * 0.15915494309189535; const float fr = (float)(rev - __builtin_rint(rev));
            tab[2 * i] = __builtin_amdgcn_cosf(fr); tab[2 * i + 1] = __builtin_amdgcn_sinf(fr); }
        if (bx == 0 && tid < 128) ctl[tid] = 0u;
#undef lane
    }
    PH_END()

    for (int l = 0; l < DEPTH; ++l) {
        const bool moe = (l & 1) != 0; const int li = l >> 1;
        const float* xres = (l == 0) ? gfp(a.in[oi(0)]) : Xf;
#define splitA (G == 256)
        PH_BEGIN(1)
        { pg8::StaticOrder S; S.init(M, splitA ? 2048 : HC, G, obx()); pg8::EpiH E{Hb, ssq, sskv, tab};
          pg8::gemm_phase(lds, XB, DM, WinT + (size_t)l * HC * DM, DM, DM, S, E); }
        PH_END()
        PH_BEGIN(2)
        {
#ifndef NOQ
          if (splitA && bx >= 192) { pg8::OneUnit S{obx() - 192, 8, true}; pg8::EpiH E{Hb, ssq, sskv, tab};
            pg8::gemm_phase(lds, XB, DM, WinT + (size_t)l * HC * DM, DM, DM, S, E); }
          else { pg8::StaticOrder S; S.init(M, QMC, splitA ? 192 : G, obx()); pg8::EpiQ E{QMb, ssq, tab};
            pg8::gemm_phase(lds, Hb + C_CQ, HC, WuqT + (size_t)l * 768 * 384, 384, 384, S, E); }
#endif
#ifndef NOKV
          { pg8::StaticOrder S; S.init(M, KVC, G, obx()); pg8::EpiKV E{KVb, sskv};
            pg8::gemm_phase(lds, Hb + C_CKV, HC, WukvT + (size_t)l * 1024 * 256, 256, 256, S, E); }
#endif
        }
        PH_END()
        PH_BEGIN(3)
        {
            unsigned* qc = ctl + 512 + l;
            volatile LAS int* qslot = (volatile LAS int*)(lds + LDS_BYTES - 32);
            for (;;) {
                if (tid == 0) *qslot = (int)atomicAdd(qc, 1u);
                __syncthreads();
                const int it = __builtin_amdgcn_readfirstlane(*qslot);
                __syncthreads();
                if (it >= 768) break;
                int acc = 0, ent = 0, r = 0;
                for (int e = 0; e < 32; ++e) { const int en = (int)a.aq[e]; const int n = (en >> 8) ? 32 : 16; if (it >= acc && it < acc + n) { ent = en; r = it - acc; } acc += n; }
                const int qb = ent & 255; const bool is_diff = (ent >> 8) != 0;
                const int bh = is_diff ? (r >> 1) : r, c = r & 1, b = bh >> 2, hh = bh & 3;
                const size_t rb = (size_t)b * SEQ;
                if (!is_diff) {
                    att::AttnArgs A; A.Q = QMb + rb * QMC + hh * 192; A.K = KVb + rb * KVC + hh * 128; A.K2 = Hb + rb * HC + C_KR;
                    A.V = KVb + rb * KVC + 512 + hh * 128; A.P0 = qb * 256; A.Out = MRG + rb * 1024 + hh * 128; A.O0 = nullptr;
                    att::attn_block<true, 0, PIPE_MLA>(A, (char*)lds_raw);
                } else {
                    if (tid < 128) { const float* rbias = gfp(a.in[oi(1)]); ((float*)(lds_raw + att::LDS_BIAS))[tid] = (rbias[a.bucket[tid] * 4 + hh] - rbias[31 * 4 + hh]) * LOG2E; }
                    __syncthreads();
                    att::AttnArgs A; A.K = nullptr; A.V = Hb + rb * HC + C_DV + hh * 128; A.P0 = qb * 256; A.Out = nullptr;
                    A.O0 = (float*)((bf16_t*)(c ? O1buf : O0buf) + rb * 512 + hh * 128);
                    A.Q = Hb + rb * HC + C_DQ + hh * 128 + c * 64; A.K2 = Hb + rb * HC + C_DK + hh * 128 + c * 64;
                    att::attn_block<false, 1, PIPE_DIFF>(A, (char*)lds_raw);
                }
            }
        }
        PH_END()
        PH_BEGIN(13)
        {
            FRESH_LANE(lane_);
#define lane lane_
            const float* lp = gfp(a.in[oi(8)]) + (size_t)l * 256;
            const float s1 = wave_sum(lp[lane] * lp[64 + lane]), s2 = wave_sum(lp[128 + lane] * lp[192 + lane]);
            const float lam = __expf(s1) - __expf(s2) + a.lam_init[oi(l)];
            const float osc = 1.0f - a.lam_init[oi(l)];
            const float* dn = gfp(a.in[oi(9)]) + l * 128 + (lane & 15) * 8;
            const f32x4 g0 = *(const f32x4*)dn * osc, g1 = *(const f32x4*)(dn + 4) * osc;
            for (int m = gw; m < M; m += NGW) {
                const u32x4 q0 = *(const u32x4*)((const bf16_t*)O0buf + (size_t)m * 512 + lane * 8), q1 = *(const u32x4*)((const bf16_t*)O1buf + (size_t)m * 512 + lane * 8);
#define BLO(w) __uint_as_float((w) << 16)
#define BHI(w) __uint_as_float((w) & 0xffff0000u)
                const f32x4 d0 = (f32x4){BLO(q0.x), BHI(q0.x), BLO(q0.y), BHI(q0.y)} - (f32x4){BLO(q1.x), BHI(q1.x), BLO(q1.y), BHI(q1.y)} * lam;
                const f32x4 d1 = (f32x4){BLO(q0.z), BHI(q0.z), BLO(q0.w), BHI(q0.w)} - (f32x4){BLO(q1.z), BHI(q1.z), BLO(q1.w), BHI(q1.w)} * lam;
#undef BLO
#undef BHI
                float ss = (d0[0] * d0[0] + d0[1] * d0[1]) + (d0[2] * d0[2] + d0[3] * d0[3]) + (d1[0] * d1[0] + d1[1] * d1[1]) + (d1[2] * d1[2] + d1[3] * d1[3]);
                ss += __shfl_xor(ss, 1); ss += __shfl_xor(ss, 2); ss += __shfl_xor(ss, 4); ss += __shfl_xor(ss, 8);
                const float rs = __builtin_amdgcn_rsqf(ss * (1.0f / 128.0f) + 1e-5f);
                pg8::store8(MRG + (size_t)m * 1024 + 512 + lane * 8, d0 * rs * g0, d1 * rs * g1);
            }
#undef lane
        }
        PH_END()
        PH_BEGIN(4)
        { pg8::StaticOrder S; S.init(M, DM, G, obx());
          if (l == 0) { pg8::EpiY E{xres, Y, 1.0f}; pg8::gemm_phase(lds, MRG, DM, WoT + (size_t)l * DM * DM, DM, DM, S, E); }
          else { pg8::EpiYLN E{Y, ssq, gfp(a.in[oi(13)]) + (l - 1) * DM, gfp(a.in[oi(14)]) + (l - 1) * DM, 1.0f, 22};
                 pg8::gemm_phase(lds, MRG, DM, WoT + (size_t)l * DM * DM, DM, DM, S, E); } }
        PH_END()
        PH_BEGIN(5)
        { if (moe) ln_pass<0, true, true, true>(a, Y, nullptr, gfp(a.in[oi(11)]) + l * DM, gfp(a.in[oi(12)]) + l * DM, Xf, (bf16_t*)(ws + WS_XB8), gfp(a.in[oi(18)]) + (size_t)li * DM * 8, ctl + CW_CNT + 8 * li, gw, NGW, fresh_lane(), lds);
          else ln_pass<0, false, true, true>(a, Y, nullptr, gfp(a.in[oi(11)]) + l * DM, gfp(a.in[oi(12)]) + l * DM, Xf, (bf16_t*)(ws + WS_XB8), nullptr, nullptr, gw, NGW, fresh_lane(), lds);
          if (l == 2) cvt_moe(a, 1, scr, gw, NGW, fresh_lane()); }
        PH_END()
        if (!moe) {
            PH_BEGIN(6)
            { pg8::StaticOrder S; S.init(M, 2 * FFD, G, obx()); pg8::EpiSwiGLU8 E{(unsigned char*)ACT, FFD};
              pg8::gemm_phase<pg8::EpiSwiGLU8, pg8::StaticOrder, true>(lds, (const bf16_t*)(ws + WS_XB8), DM / 2, (const bf16_t*)((unsigned char*)WguT + (size_t)li * 2 * FFD * DM), DM / 2, DM / 2, S, E); }
            PH_END()
            PH_BEGIN(7)
            { pg8::StaticOrder S; S.init(M, DM, G, obx()); pg8::EpiYLN E{Y, ssq, gfp(a.in[oi(11)]) + l * DM, gfp(a.in[oi(12)]) + l * DM, 1.0f / (W8_D * A8_ACT), 20};
              pg8::gemm_phase<pg8::EpiYLN, pg8::StaticOrder, true>(lds, ACT, FFD / 2, (const bf16_t*)((unsigned char*)WdT + (size_t)li * DM * FFD), FFD / 2, FFD / 2, S, E); }
            PH_END()
            PH_BEGIN(8)
            { ln_pass<0, false, false, true>(a, Y, nullptr, gfp(a.in[oi(13)]) + l * DM, gfp(a.in[oi(14)]) + l * DM, nullptr, XB, nullptr, nullptr, gw, NGW, fresh_lane(), lds, nullptr, nullptr, 22); }
            PH_END()
        } else {
            unsigned* cnt = ctl + CW_CNT + 8 * li; unsigned* cur = ctl + CW_CUR + 8 * li;
            PH_BEGIN(9)
            {
                FRESH_LANE(lane_);
#define lane lane_
                int rbase[8]; { int acc = 0;
#pragma unroll
                    for (int e = 0; e < 8; ++e) { rbase[e] = acc * 256; acc += (__builtin_amdgcn_readfirstlane((int)__hip_atomic_load(cnt + e, __ATOMIC_RELAXED, __HIP_MEMORY_SCOPE_AGENT)) + 255) >> 8; } }
                const f32x4* route = (const f32x4*)(ws + WS_ROUTE); int* slots = (int*)(ws + WS_ROUTE + 512 * 1024);
                LAS unsigned* lc = (LAS unsigned*)(lds + 131072);
                unsigned long long pk = 0ull;
                for (int m = gw; m < M; m += NGW) { const f32x4 rt = route[m]; pk += (1ull << (8 * __float_as_int(rt[0]))) + (1ull << (8 * __float_as_int(rt[1]))); }
                if (lane < 8) lc[wave * 8 + lane] = (unsigned)((pk >> (8 * lane)) & 255ull);
                __syncthreads();
                if (wave == 0 && lane < 8) {
                    unsigned tot = 0u, pre[8];
#pragma unroll
                    for (int w = 0; w < 8; ++w) { pre[w] = tot; tot += lc[w * 8 + lane]; }
                    int rb = 0;
#pragma unroll
                    for (int e = 0; e < 8; ++e) if (e == lane) rb = rbase[e];
                    const unsigned base = atomicAdd(cur + lane, tot) + (unsigned)rb;
#pragma unroll
                    for (int w = 0; w < 8; ++w) lc[64 + w * 8 + lane] = base + pre[w];
                }
                __syncthreads();
                unsigned nb[8];
#pragma unroll
                for (int e = 0; e < 8; ++e) nb[e] = lc[64 + wave * 8 + e];
                for (int m = gw; m < M; m += NGW) {
                    const f32x4 rt = route[m]; const int e1 = __float_as_int(rt[0]), e2 = __float_as_int(rt[1]);
                    int s1 = 0, s2 = 0;
#pragma unroll
                    for (int e = 0; e < 8; ++e) { if (e == e1) { s1 = (int)nb[e]; nb[e]++; } if (e == e2) { s2 = (int)nb[e]; nb[e]++; } }
                    const u32x4 q = *((const u32x4*)((const unsigned char*)(ws + WS_XB8) + (size_t)m * DM) + lane);
                    *((u32x4*)((unsigned char*)XG + (size_t)s1 * DM) + lane) = q; *((u32x4*)((unsigned char*)XG + (size_t)s2 * DM) + lane) = q;
                    if (lane == 0) { slots[2 * m] = s1; slots[2 * m + 1] = s2; }
                }
#undef lane
            }
            PH_END()
            pg8::MoeOrder MO; { int t[8], tot = 0;
#pragma unroll
                for (int e = 0; e < 8; ++e) { t[e] = (__builtin_amdgcn_readfirstlane((int)__hip_atomic_load(cnt + e, __ATOMIC_RELAXED, __HIP_MEMORY_SCOPE_AGENT)) + 255) >> 8; tot += t[e]; }
                MO.t0 = t[0]; MO.t1 = t[1]; MO.t2 = t[2]; MO.t3 = t[3]; MO.t4 = t[4]; MO.t5 = t[5]; MO.t6 = t[6]; MO.t7 = t[7]; MO.G = G; MO.c = bx; MO.NT = 0; MO.total = tot; MO.ks = 1; MO.kh = 0; }
            PH_BEGIN(10)
            { pg8::MoeOrder S = MO; S.NT = 2 * FFE / 256; S.total = MO.total * S.NT; pg8::EpiSwiGLU8 E{(unsigned char*)MACT, FFE};
              pg8::gemm_phase<pg8::EpiSwiGLU8, pg8::MoeOrder, true>(lds, XG, DM / 2, MguT, DM / 2, DM / 2, S, E); }
            PH_END()
            PH_BEGIN(11)
            { pg8::MoeOrder S = MO; S.NT = DM / 256; S.ks = 2; S.kh = FFE / 4; S.total = MO.total * S.NT * 2; pg8::EpiF8 E{(unsigned char*)OSLOT, DM, (size_t)(WS_OSLOT2 - WS_OSLOT), O8 / (W8_D * A8_ACT)};
              pg8::gemm_phase<pg8::EpiF8, pg8::MoeOrder, true>(lds, MACT, FFE / 2, MdT, FFE / 2, FFE / 4, S, E); }
            PH_END()
            PH_BEGIN(12)
            { if (l == DEPTH - 1) ln_pass<1, false>(a, Y, nullptr, gfp(a.in[oi(13)]) + l * DM, gfp(a.in[oi(14)]) + l * DM, a.out + oz(), nullptr, nullptr, nullptr, gw, NGW, fresh_lane(), lds, gfp(a.in[oi(11)]) + l * DM, gfp(a.in[oi(12)]) + l * DM);
              else ln_pass<1, false, false, true, true>(a, Y, nullptr, gfp(a.in[oi(13)]) + l * DM, gfp(a.in[oi(14)]) + l * DM, nullptr, XB, nullptr, nullptr, gw, NGW, fresh_lane(), lds, gfp(a.in[oi(11)]) + l * DM, gfp(a.in[oi(12)]) + l * DM, 22); }
            PH_END()
        }
    }
#undef PH_BEGIN
#undef PH_END
}
#undef ws
#undef ctl
#undef tab
#undef ssq
#undef sskv
#undef Y
#undef XB
#undef Xf
constexpr int N_PHASES = 1 + 2 * 9 + 2 * 10;

extern "C" void kernel_launch(void* const* d_in, const int* in_sizes, int n_in, void* d_out, int out_size, void* d_ws, size_t ws_size, hipStream_t stream) {
    static int grid = 0;
    if (grid == 0) {
        if (n_in != 22 || in_sizes[0] != M * DM || out_size != M * DM || ws_size < WS_END) { fprintf(stderr, "kernel_launch: unexpected shapes (n_in %d, ws %zu)\n", n_in, ws_size); grid = -1; return; }
        int dev = 0, cus = 0, per_cu = 0;
        (void)hipGetDevice(&dev); (void)hipDeviceGetAttribute(&cus, hipDeviceAttributeMultiprocessorCount, dev);
        if (hipFuncSetAttribute((const void*)mega_fwd, hipFuncAttributeMaxDynamicSharedMemorySize, LDS_BYTES) != hipSuccess) { fprintf(stderr, "kernel_launch: hipFuncSetAttribute failed\n"); grid = -1; return; }
        if (hipOccupancyMaxActiveBlocksPerMultiprocessor(&per_cu, (const void*)mega_fwd, 512, LDS_BYTES) != hipSuccess || per_cu < 1) { fprintf(stderr, "kernel_launch: occupancy query says %d\n", per_cu); per_cu = 1; }
        (void)hipGetLastError();
        grid = cus * 1;
        if (grid <= 0) grid = 256;
    }
    if (grid < 0) return;
    (void)hipMemsetAsync((char*)d_ws + WS_CTL, 0, 1 * MiB, stream);
    Args a{};
    for (int i = 0; i < 22; ++i) a.in[i] = (const float*)d_in[i];
    a.out = (float*)d_out; a.ws = (unsigned char*)d_ws;
    for (int i = 0; i < 32; ++i) a.inv[i] = 1.0f / powf(10000.0f, (float)(2 * i) / 64.0f);
    for (int l = 0; l < 4; ++l) a.lam_init[l] = (float)(0.8 - 0.6 * exp(-0.3 * (double)l));
    for (int n = 0; n < 128; ++n) { int bkt;
        if (n < 16) bkt = n; else { const float nf = (float)n; const float v = logf(nf / 16.0f) / (float)log(8.0) * 16.0f; bkt = 16 + (int)v; if (bkt > 31) bkt = 31; }
        a.bucket[n] = (unsigned char)bkt; }
    {
        int di = 15, mi = 15;
        for (int e = 0; e < 32; ++e) { const float dc = di >= 0 ? 4.0f * (di + 1) : -1.f, mc = mi >= 0 ? 2.8f * (mi + 1) : -1.f;
            if (dc >= mc) { a.aq[e] = (unsigned short)((1 << 8) | di); --di; } else { a.aq[e] = (unsigned short)mi; --mi; } }
    }
#if MK_SPLIT
    for (int p = 0; p < N_PHASES; ++p) { a.ph_lo = p; a.ph_hi = p + 1; hipLaunchKernelGGL(mega_fwd, dim3(grid), dim3(512), LDS_BYTES, stream, a); }
#else
    a.ph_lo = 0; a.ph_hi = N_PHASES;
    void* args[] = {&a};
    hipError_t e = hipLaunchCooperativeKernel((const void*)mega_fwd, dim3(grid), dim3(512), args, LDS_BYTES, stream);
    if (e != hipSuccess) fprintf(stderr, "cooperative launch failed: %s (grid %d)\n", hipGetErrorString(e), grid);
#endif
}
```

```cpp
#include <hip/hip_runtime.h>
#include <hip/hip_cooperative_groups.h>
#include <cstdint>
#include <cstdio>
#include <cmath>
namespace cg = cooperative_groups;

#ifndef PIPE_MLA
#define PIPE_MLA true
#endif
#ifndef PIPE_DIFF
#define PIPE_DIFF true
#endif
#ifndef MK_SPLIT
#define MK_SPLIT 0
#endif

#define LAS __attribute__((address_space(3)))
typedef unsigned short bf16_t;
typedef short bf16x8 __attribute__((ext_vector_type(8)));
typedef short s16x4 __attribute__((ext_vector_type(4)));
typedef float f32x2 __attribute__((ext_vector_type(2)));
typedef float f32x4 __attribute__((ext_vector_type(4)));
typedef float f32x16 __attribute__((ext_vector_type(16)));
typedef unsigned u32x2 __attribute__((ext_vector_type(2)));
typedef unsigned u32x4 __attribute__((ext_vector_type(4)));
typedef int i32x4 __attribute__((ext_vector_type(4)));
typedef int i32x8 __attribute__((ext_vector_type(8)));

constexpr int M = 16384, DM = 1024, SEQ = 4096, DEPTH = 4;
constexpr int HC = 2304;
constexpr int QMC = 768, KVC = 1024;
constexpr int FFD = 2816, FFE = 3584, NEXP = 8;
constexpr int SLOTS = 32768 + 8 * 256;
constexpr float LOG2E = 1.4426950408889634f;
constexpr float DN_ALPHA = 1.681792830507429f;
constexpr int C_CQ = 0, C_CKV = 384, C_KR = 640, C_DQ = 704, C_DK = 1216, C_DV = 1728;

constexpr size_t MiB = 1u << 20;
constexpr size_t WS_CTL = 0, WS_TAB = 1 * MiB, WS_SS = 2 * MiB;
constexpr size_t WS_WIN = 4 * MiB, WS_WUQ = 22 * MiB, WS_WUKV = 25 * MiB, WS_WO = 27 * MiB, WS_WGU = 35 * MiB, WS_WD = 57 * MiB;
constexpr size_t WS_MGU = 68 * MiB, WS_MD = 180 * MiB;
constexpr size_t WS_X = 236 * MiB, WS_XB = 300 * MiB, WS_Y = 332 * MiB, WS_OV = 396 * MiB;
constexpr size_t WS_H = WS_OV, WS_QM = WS_OV + 72 * MiB, WS_KVB = WS_OV + 96 * MiB, WS_MRG = WS_OV + 128 * MiB, WS_O0 = WS_OV + 160 * MiB;
constexpr size_t WS_ACT = WS_OV;
constexpr size_t WS_XG = WS_OV, WS_MACT = WS_OV + 68 * MiB, WS_OSLOT = WS_OV + 306 * MiB;
constexpr size_t WS_ROUTE = WS_OV + 374 * MiB;
constexpr size_t WS_OSLOT2 = WS_OV + 376 * MiB;
constexpr size_t WS_XB8 = WS_OV + 444 * MiB;
constexpr size_t WS_END = WS_OV + 460 * MiB;
constexpr int CW_CNT = 0, CW_CUR = 64;

constexpr int LDS_BYTES = 147456;
constexpr float W8_GU = 64.0f, W8_D = 128.0f, A8_ACT = 8.0f, O8 = 64.0f;

__device__ __forceinline__ unsigned cvt_pk_bf16(float lo, float hi) { unsigned r; asm volatile("v_cvt_pk_bf16_f32 %0, %1, %2" : "=v"(r) : "v"(lo), "v"(hi)); return r; }
__device__ __forceinline__ i32x8 cat8(bf16x8 a, bf16x8 b) { const i32x4 x = __builtin_bit_cast(i32x4, a), y = __builtin_bit_cast(i32x4, b); return __builtin_shufflevector(x, y, 0, 1, 2, 3, 4, 5, 6, 7); }
__device__ __forceinline__ bf16x8 lo8(i32x8 v) { return __builtin_bit_cast(bf16x8, __builtin_shufflevector(v, v, 0, 1, 2, 3)); }
__device__ __forceinline__ bf16x8 hi8(i32x8 v) { return __builtin_bit_cast(bf16x8, __builtin_shufflevector(v, v, 4, 5, 6, 7)); }
__device__ __forceinline__ unsigned cvt4_fp8(float a, float b, float c, float d) { unsigned w = __builtin_amdgcn_cvt_pk_fp8_f32(a, b, 0u, false); return (unsigned)__builtin_amdgcn_cvt_pk_fp8_f32(c, d, (int)w, true); }
typedef _Float16 ystream_t;
typedef _Float16 h16x4 __attribute__((ext_vector_type(4)));
__device__ __forceinline__ f32x4 ld4h(const ystream_t* p) { return __builtin_convertvector(*(const h16x4*)p, f32x4); }
__device__ __forceinline__ void st4h(ystream_t* p, f32x4 v) { *(h16x4*)p = __builtin_convertvector(v, h16x4); }
__device__ __forceinline__ float bf2f(unsigned short b) { return __uint_as_float(((unsigned)b) << 16); }
__device__ __forceinline__ float wave_sum(float v) {
#pragma unroll
    for (int o = 1; o < 64; o <<= 1) v += __shfl_xor(v, o);
    return v;
}
__device__ __forceinline__ int fresh_lane() { int t = threadIdx.x; asm volatile("" : "+v"(t)); return t & 63; }
__device__ __forceinline__ int obx() { int b = blockIdx.x; asm volatile("" : "+s"(b)); return b; }
__device__ __forceinline__ int oi(int k) { asm volatile("" : "+s"(k)); return k; }
typedef __attribute__((address_space(1))) unsigned char* gptr_t;
typedef __attribute__((address_space(1))) const float* gfptr_t;
#if defined(__HIP_DEVICE_COMPILE__)
#define ASSUME_GLOBAL(p) __builtin_assume(!__builtin_amdgcn_is_shared((const __attribute__((address_space(0))) void*)(p)) && !__builtin_amdgcn_is_private((const __attribute__((address_space(0))) void*)(p)))
#else
#define ASSUME_GLOBAL(p) ((void)0)
#endif
__device__ __forceinline__ size_t oz() { size_t z = 0; asm volatile("" : "+s"(z)); return z; }
#define opq(p) ((p) + oz())
__device__ __forceinline__ const float* gfp(const float* p) { ASSUME_GLOBAL(p); return p; }
#define LDS_WAIT() asm volatile("s_waitcnt lgkmcnt(0)" ::: "memory")
#define VM_WAIT() asm volatile("s_waitcnt vmcnt(0)" ::: "memory")

namespace pg8 {
constexpr int BM = 256, BK = 64, HALF = 128, HTB = HALF * BK * 2, NXCD = 8, WGM = 8;
__host__ __device__ __forceinline__ int lds_byte(int r, int c) { const int st = (r >> 4) * 2 + (c >> 5), rr = r & 15, cc = c & 31, ob = rr * 64 + cc * 2; return st * 1024 + (ob ^ (((ob >> 9) & 1) << 5)); }
__host__ __device__ __forceinline__ void stage_rc(int b, int& R, int& C) { const int st = b / 1024, sb = b % 1024, swz = sb ^ (((sb >> 9) & 1) << 5); R = (st >> 1) * 16 + swz / 64; C = (st & 1) * 32 + (swz % 64) / 2; }
__host__ __device__ __forceinline__ int perm32(int rho) { const int n = rho >> 4, i = rho & 15; return 8 * (i >> 2) + 4 * n + (i & 3); }

struct Unit { int pm, pn, bt, ko, os; };

struct StaticOrder {
    int nM, nN, nwg, G, c;
    __device__ __forceinline__ void init(int Mr, int N, int G_, int c_) { nM = Mr / BM; nN = N / BM; nwg = nM * nN; G = G_; c = c_; }
    __device__ __forceinline__ bool next(int i, Unit& u) const {
        const long L = (long)i * G + c; if (L >= nwg) return false;
        int wgid = (int)L; { const int q = nwg / NXCD, r = nwg % NXCD, xcd = wgid % NXCD, off = wgid / NXCD; wgid = (xcd < r ? xcd * (q + 1) : r * (q + 1) + (xcd - r) * q) + off; }
        const int nig = WGM * nN, gid = wgid / nig, fm = gid * WGM, gsz = (nM - fm) < WGM ? (nM - fm) : WGM;
        u.pm = fm + ((wgid % nig) % gsz); u.pn = (wgid % nig) / gsz; u.bt = u.pn; u.ko = 0; u.os = 0; return true;
    }
};
struct OneUnit {
    int pm, pn; bool valid;
    __device__ __forceinline__ bool next(int i, Unit& u) const { if (i != 0 || !valid) return false; u.pm = pm; u.pn = pn; u.bt = pn; u.ko = 0; u.os = 0; return true; }
};
struct MoeOrder {
    int t0, t1, t2, t3, t4, t5, t6, t7; int NT, G, c, total, ks, kh;
    __device__ __forceinline__ bool next(int i, Unit& u) const {
        const int cc = (G % 8 == 0) ? (c % 8) * (G / 8) + c / 8 : c;
        const long L = (long)i * G + cc; if (L >= total) return false;
        int acc = 0, e = 0, base = 0, te = 1;
#define MO_STEP(j, tj) { if (tj > 0 && L >= (long)acc * NT * ks) { e = j; base = acc; te = tj; } acc += tj; }
        MO_STEP(0, t0) MO_STEP(1, t1) MO_STEP(2, t2) MO_STEP(3, t3) MO_STEP(4, t4) MO_STEP(5, t5) MO_STEP(6, t6) MO_STEP(7, t7)
#undef MO_STEP
        const int loc = (int)(L - (long)base * NT * ks), sp = loc % ks, rest = loc / ks;
        u.pm = base + rest % te; u.pn = rest / te; u.bt = e * NT + u.pn; u.ko = sp * kh; u.os = sp; return true;
    }
};

template <class Epi, class Sched, bool F8 = false>
__device__ __forceinline__ void gemm_phase(LAS unsigned char* lds, const bf16_t* Ag, int lda, const bf16_t* Btg, int ldb, int K, const Sched& S, const Epi& E) {
    asm volatile("" : "+s"(K));
    int tid_ = threadIdx.x; asm volatile("" : "+v"(tid_));
    const int tid = tid_, wid = __builtin_amdgcn_readfirstlane(tid >> 6), lane = tid & 63, wr = wid >> 2, wc = wid & 3, fr = lane & 15, fq = lane >> 4;
    const int nt = K / BK;
    unsigned voffA[2], voffB[2];
#pragma unroll
    for (int i = 0; i < 2; ++i) { int R, C; stage_rc(tid * 16 + i * 8192, R, C); const int Rb = Epi::PERM ? ((R & ~31) + perm32(R & 31)) : R;
        voffA[i] = (unsigned)(R * lda + C) * 2u; voffB[i] = (unsigned)(Rb * ldb + C) * 2u; }
    const size_t kstep = (size_t)(BK * 2);
    const size_t hstepA = (size_t)HALF * lda * 2, hstepB = (size_t)HALF * ldb * 2;
    const size_t tstepA = 2 * hstepA, tstepB = 2 * hstepB;
    const unsigned ldsw = (unsigned)wid * 1024u;
    const int aoff = lds_byte(wr * 64 + fr, fq * 8), boff = lds_byte(wc * 32 + fr, fq * 8);
#define PG8_SA(b, h) (((b) * 2 + (h)) * HTB)
#define PG8_SB(b, h) ((4 + (b) * 2 + (h)) * HTB)
#define PG8_STAGE(bufoff, gbase, voff) do { _Pragma("unroll") for (int _i = 0; _i < 2; ++_i) \
        __builtin_amdgcn_global_load_lds((const unsigned*)((const char*)(gbase) + (voff)[_i]), (LAS unsigned*)(lds + (bufoff) + ldsw + _i * 8192), 16, 0, 0); } while (0)
#define PG8_LDA(dst, b, h) do { _Pragma("unroll") for (int m = 0; m < 4; ++m) dst[m] = cat8(*(const LAS bf16x8*)(lds + PG8_SA(b, h) + aoff + m * 2048), *(const LAS bf16x8*)(lds + PG8_SA(b, h) + aoff + m * 2048 + 1024)); } while (0)
#define PG8_LDB(dst, b, h) do { _Pragma("unroll") for (int n = 0; n < 2; ++n) dst[n] = cat8(*(const LAS bf16x8*)(lds + PG8_SB(b, h) + boff + n * 2048), *(const LAS bf16x8*)(lds + PG8_SB(b, h) + boff + n * 2048 + 1024)); } while (0)
#define PG8_MMA(ai, bj, At, Bt) do { __builtin_amdgcn_s_setprio(1); _Pragma("unroll") for (int m = 0; m < 4; ++m) _Pragma("unroll") for (int n = 0; n < 2; ++n) { \
        if constexpr (F8) asm volatile("v_mfma_f32_16x16x128_f8f6f4 %0, %1, %2, %0" : "+v"(acc[ai][bj][m][n]) : "v"(Bt[n]), "v"(At[m]));   \
        else { acc[ai][bj][m][n] = __builtin_amdgcn_mfma_f32_16x16x32_bf16(lo8(Bt[n]), lo8(At[m]), acc[ai][bj][m][n], 0, 0, 0); \
               acc[ai][bj][m][n] = __builtin_amdgcn_mfma_f32_16x16x32_bf16(hi8(Bt[n]), hi8(At[m]), acc[ai][bj][m][n], 0, 0, 0); } } \
        __builtin_amdgcn_s_setprio(0); } while (0)
#define PG8_WAIT_V(n) asm volatile("s_waitcnt vmcnt(" #n ")" ::: "memory")
#define PG8_WAIT_L(n) asm volatile("s_waitcnt lgkmcnt(" #n ")" ::: "memory")
#define PG8_BAR __builtin_amdgcn_s_barrier()
#define PG8_SCHED __builtin_amdgcn_sched_barrier(0)
    Unit cur, nxt; int ui = 0;
    if (!S.next(0, cur)) return;
    f32x4 acc[2][2][4][2];
#pragma unroll
    for (int a = 0; a < 2; ++a)
#pragma unroll
        for (int b = 0; b < 2; ++b)
#pragma unroll
            for (int m = 0; m < 4; ++m)
#pragma unroll
                for (int n = 0; n < 2; ++n) acc[a][b][m][n] = (f32x4){0.f, 0.f, 0.f, 0.f};
    i32x8 At[4], B0[2], B1[2];
    const char* cA = (const char*)Ag + (size_t)cur.pm * tstepA + (size_t)cur.ko * 2; const char* cB = (const char*)Btg + (size_t)cur.bt * tstepB + (size_t)cur.ko * 2;
    PG8_STAGE(PG8_SB(0, 0), cB, voffB); PG8_STAGE(PG8_SB(0, 1), cB + hstepB, voffB); PG8_STAGE(PG8_SA(0, 0), cA, voffA); PG8_STAGE(PG8_SA(0, 1), cA + hstepA, voffA);
    if (wr == 1) PG8_BAR;
    PG8_WAIT_V(2); PG8_BAR;
    PG8_STAGE(PG8_SB(1, 0), cB + kstep, voffB); PG8_STAGE(PG8_SA(1, 0), cA + kstep, voffA); PG8_STAGE(PG8_SB(1, 1), cB + hstepB + kstep, voffB);
    PG8_WAIT_V(6); PG8_BAR;
    for (;;) {
        const bool has_next = S.next(ui + 1, nxt);
        const char* nA = has_next ? (const char*)Ag + (size_t)nxt.pm * tstepA + (size_t)nxt.ko * 2 : cA; const char* nB = has_next ? (const char*)Btg + (size_t)nxt.bt * tstepB + (size_t)nxt.ko * 2 : cB;
        for (int t = 0; t < nt; t += 2) {
            const bool last = (t == nt - 2);
            const char* a1 = cA + (size_t)(t + 1) * kstep;
            const char* a2 = last ? nA : cA + (size_t)(t + 2) * kstep; const char* b2 = last ? nB : cB + (size_t)(t + 2) * kstep;
            const char* a3 = a2 + kstep; const char* b3 = b2 + kstep;
            PG8_LDB(B0, 0, 0); PG8_LDB(B1, 0, 1); PG8_SCHED; PG8_LDA(At, 0, 0); PG8_STAGE(PG8_SA(1, 1), a1 + hstepA, voffA);
            PG8_WAIT_V(8); PG8_WAIT_L(0); PG8_BAR; PG8_MMA(0, 0, At, B0); PG8_MMA(0, 1, At, B1); PG8_BAR; PG8_SCHED;
            PG8_LDA(At, 0, 1); PG8_STAGE(PG8_SB(0, 0), b2, voffB); PG8_STAGE(PG8_SB(0, 1), b2 + hstepB, voffB); PG8_STAGE(PG8_SA(0, 0), a2, voffA);
            PG8_WAIT_V(8); PG8_WAIT_L(0); PG8_BAR; PG8_MMA(1, 0, At, B0); PG8_MMA(1, 1, At, B1); PG8_BAR; PG8_SCHED;
            PG8_LDB(B0, 1, 0); PG8_LDB(B1, 1, 1); PG8_SCHED; PG8_LDA(At, 1, 0); PG8_STAGE(PG8_SA(0, 1), a2 + hstepA, voffA);
            PG8_WAIT_V(8); PG8_WAIT_L(0); PG8_BAR; PG8_MMA(0, 0, At, B0); PG8_MMA(0, 1, At, B1); PG8_BAR; PG8_SCHED;
            PG8_LDA(At, 1, 1); PG8_STAGE(PG8_SB(1, 0), b3, voffB); PG8_STAGE(PG8_SB(1, 1), b3 + hstepB, voffB); PG8_STAGE(PG8_SA(1, 0), a3, voffA);
            PG8_WAIT_V(8); PG8_WAIT_L(0); PG8_BAR; PG8_MMA(1, 0, At, B0); PG8_MMA(1, 1, At, B1); PG8_BAR; PG8_SCHED;
        }
        if (wr == 0) PG8_BAR;
        if constexpr (F8) asm volatile("s_nop 15\n\ts_nop 15\n\ts_nop 15" ::: "memory");
        E(acc, cur, wr, wc, fr, fq);
        if (!has_next) break;
#pragma unroll
        for (int a = 0; a < 2; ++a)
#pragma unroll
            for (int b = 0; b < 2; ++b)
#pragma unroll
                for (int m = 0; m < 4; ++m)
#pragma unroll
                    for (int n = 0; n < 2; ++n) acc[a][b][m][n] = (f32x4){0.f, 0.f, 0.f, 0.f};
        cur = nxt; cA = nA; cB = nB; ++ui;
        if (wr == 1) PG8_BAR;
    }
    PG8_WAIT_V(0);
    PG8_BAR;
#undef PG8_SA
#undef PG8_SB
#undef PG8_STAGE
#undef PG8_LDA
#undef PG8_LDB
#undef PG8_MMA
#undef PG8_WAIT_V
#undef PG8_WAIT_L
#undef PG8_BAR
#undef PG8_SCHED
}

__device__ __forceinline__ void store8(bf16_t* p, f32x4 v0, f32x4 v1) {
    u32x4 w; w.x = cvt_pk_bf16(v0[0], v0[1]); w.y = cvt_pk_bf16(v0[2], v0[3]); w.z = cvt_pk_bf16(v1[0], v1[1]); w.w = cvt_pk_bf16(v1[2], v1[3]);
    *(u32x4*)p = w;
}
__device__ __forceinline__ void rope8(f32x4& v0, f32x4& v1, const float* cs) {
    const f32x4 c0 = *(const f32x4*)cs, c1 = *(const f32x4*)(cs + 4);
    f32x4 o0, o1;
    o0[0] = v0[0] * c0[0] - v0[1] * c0[1]; o0[1] = v0[1] * c0[0] + v0[0] * c0[1];
    o0[2] = v0[2] * c0[2] - v0[3] * c0[3]; o0[3] = v0[3] * c0[2] + v0[2] * c0[3];
    o1[0] = v1[0] * c1[0] - v1[1] * c1[1]; o1[1] = v1[1] * c1[0] + v1[0] * c1[1];
    o1[2] = v1[2] * c1[2] - v1[3] * c1[3]; o1[3] = v1[3] * c1[2] + v1[2] * c1[3];
    v0 = o0; v1 = o1;
}
struct EpiH {
    static constexpr bool PERM = true;
    bf16_t* H; float* ssq; float* sskv; const float* tab;
    __device__ __forceinline__ void operator()(const f32x4 (&acc)[2][2][4][2], const Unit& u, int wr, int wc, int fr, int fq) const {
        const int row0 = u.pm * BM + wr * 64 + fr;
#pragma unroll
        for (int bj = 0; bj < 2; ++bj) {
            const int g32 = u.pn * BM + bj * HALF + wc * 32, col0 = g32 + 8 * fq;
            const int seg = g32 < C_CKV ? 0 : (g32 < C_KR ? 1 : (g32 < C_DQ ? 2 : 3));
#pragma unroll
            for (int ai = 0; ai < 2; ++ai)
#pragma unroll
                for (int m = 0; m < 4; ++m) {
                    const int row = row0 + ai * HALF + m * 16;
                    f32x4 v0 = acc[ai][bj][m][0], v1 = acc[ai][bj][m][1];
                    if (seg < 2) {
                        float s = (v0[0] * v0[0] + v0[1] * v0[1]) + (v0[2] * v0[2] + v0[3] * v0[3]) + (v1[0] * v1[0] + v1[1] * v1[1]) + (v1[2] * v1[2] + v1[3] * v1[3]);
                        s += __shfl_xor(s, 16); s += __shfl_xor(s, 32);
                        if (fq == 0) ssq[(size_t)row * 32 + (g32 >> 5)] = s;
                    } else if (seg == 2) {
                        rope8(v0, v1, tab + (size_t)(row & (SEQ - 1)) * 64 + (col0 - C_KR));
                    }
                    store8(H + (size_t)row * HC + col0, v0, v1);
                    asm volatile("" ::: "memory");
                }
        }
    }
};
struct EpiQ {
    static constexpr bool PERM = true;
    bf16_t* Q; const float* ssq; const float* tab;
    __device__ __forceinline__ void operator()(const f32x4 (&acc)[2][2][4][2], const Unit& u, int wr, int wc, int fr, int fq) const {
        const int row0 = u.pm * BM + wr * 64 + fr;
#pragma unroll
        for (int ai = 0; ai < 2; ++ai)
#pragma unroll
            for (int m = 0; m < 4; ++m) {
                const int row = row0 + ai * HALF + m * 16;
                const f32x4 q0 = *(const f32x4*)(ssq + (size_t)row * 32), q1 = *(const f32x4*)(ssq + (size_t)row * 32 + 4), q2 = *(const f32x4*)(ssq + (size_t)row * 32 + 8);
                const float rs = __builtin_amdgcn_rsqf((((q0[0] + q0[1]) + (q0[2] + q0[3])) + ((q1[0] + q1[1]) + (q1[2] + q1[3])) + ((q2[0] + q2[1]) + (q2[2] + q2[3]))) * (1.0f / 384.0f) + 1e-6f);
#pragma unroll
                for (int bj = 0; bj < 2; ++bj) {
                    const int g32 = u.pn * BM + bj * HALF + wc * 32, col0 = g32 + 8 * fq;
                    const int inh = g32 % 192;
                    f32x4 v0 = acc[ai][bj][m][0] * rs, v1 = acc[ai][bj][m][1] * rs;
                    if (inh >= 128) rope8(v0, v1, tab + (size_t)(row & (SEQ - 1)) * 64 + (inh - 128 + 8 * fq));
                    store8(Q + (size_t)row * QMC + col0, v0, v1);
                }
                asm volatile("" ::: "memory");
            }
    }
};
struct EpiKV {
    static constexpr bool PERM = true;
    bf16_t* O; const float* sskv;
    __device__ __forceinline__ void operator()(const f32x4 (&acc)[2][2][4][2], const Unit& u, int wr, int wc, int fr, int fq) const {
        const int row0 = u.pm * BM + wr * 64 + fr;
#pragma unroll
        for (int ai = 0; ai < 2; ++ai)
#pragma unroll
            for (int m = 0; m < 4; ++m) {
                const int row = row0 + ai * HALF + m * 16;
                const f32x4 q0 = *(const f32x4*)(sskv + (size_t)row * 32 + 12), q1 = *(const f32x4*)(sskv + (size_t)row * 32 + 16);
                const float rs = __builtin_amdgcn_rsqf((((q0[0] + q0[1]) + (q0[2] + q0[3])) + ((q1[0] + q1[1]) + (q1[2] + q1[3]))) * (1.0f / 256.0f) + 1e-6f);
#pragma unroll
                for (int bj = 0; bj < 2; ++bj) {
                    const int col0 = u.pn * BM + bj * HALF + wc * 32 + 8 * fq;
                    store8(O + (size_t)row * KVC + col0, acc[ai][bj][m][0] * rs, acc[ai][bj][m][1] * rs);
                }
            }
    }
};
struct EpiY {
    static constexpr bool PERM = false;
    const float* X; ystream_t* Y; float asc;
    __device__ __forceinline__ void operator()(const f32x4 (&acc)[2][2][4][2], const Unit& u, int wr, int wc, int fr, int fq) const {
        const int row0 = u.pm * BM + wr * 64 + fr, colb = u.pn * BM + wc * 32 + 4 * fq;
#pragma unroll
        for (int ai = 0; ai < 2; ++ai)
#pragma unroll
            for (int m = 0; m < 4; ++m) {
                const size_t off = (size_t)(row0 + ai * HALF + m * 16) * DM + colb;
#pragma unroll
                for (int bj = 0; bj < 2; ++bj)
#pragma unroll
                    for (int n = 0; n < 2; ++n) { const f32x4 xv = *(const f32x4*)(X + off + bj * HALF + n * 16); st4h(Y + off + bj * HALF + n * 16, xv * DN_ALPHA + acc[ai][bj][m][n] * asc); }
            }
    }
};
struct EpiYLN {
    static constexpr bool PERM = false;
    ystream_t* Y; const float* st; const float* g; const float* b; float asc; int so;
    __device__ __forceinline__ void operator()(const f32x4 (&acc)[2][2][4][2], const Unit& u, int wr, int wc, int fr, int fq) const {
        const int row0 = u.pm * BM + wr * 64 + fr, colb = u.pn * BM + wc * 32 + 4 * fq;
#pragma unroll
        for (int ai = 0; ai < 2; ++ai)
#pragma unroll
            for (int m = 0; m < 4; ++m) {
                const int row = row0 + ai * HALF + m * 16;
                const float mu = st[(size_t)row * 32 + so], rs = st[(size_t)row * 32 + so + 1];
                const size_t off = (size_t)row * DM + colb;
#pragma unroll
                for (int bj = 0; bj < 2; ++bj)
#pragma unroll
                    for (int n = 0; n < 2; ++n) { const int c = colb + bj * HALF + n * 16;
                        const f32x4 gv = *(const f32x4*)(g + c), bv = *(const f32x4*)(b + c), yv = ld4h(Y + off + bj * HALF + n * 16);
                        st4h(Y + off + bj * HALF + n * 16, ((yv - mu) * rs * gv + bv) * DN_ALPHA + acc[ai][bj][m][n] * asc); }
                asm volatile("" ::: "memory");
            }
    }
};
struct EpiSwiGLU {
    static constexpr bool PERM = true;
    bf16_t* O; int ldo;
    __device__ __forceinline__ void operator()(const f32x4 (&acc)[2][2][4][2], const Unit& u, int wr, int wc, int fr, int fq) const {
        const int row0 = u.pm * BM + wr * 64 + fr, col0 = u.pn * HALF + wc * 32 + 8 * fq;
#pragma unroll
        for (int ai = 0; ai < 2; ++ai)
#pragma unroll
            for (int m = 0; m < 4; ++m) {
                f32x4 r[2];
#pragma unroll
                for (int n = 0; n < 2; ++n) { const f32x4 g = acc[ai][0][m][n], up = acc[ai][1][m][n];
#pragma unroll
                    for (int j = 0; j < 4; ++j) { const float e = __builtin_amdgcn_exp2f(-g[j] * LOG2E); r[n][j] = g[j] * __builtin_amdgcn_rcpf(1.0f + e) * up[j]; } }
                store8(O + (size_t)(row0 + ai * HALF + m * 16) * ldo + col0, r[0], r[1]);
            }
    }
};
struct EpiSwiGLU8 {
    static constexpr bool PERM = true;
    unsigned char* O; int ldo;
    __device__ __forceinline__ void operator()(const f32x4 (&acc)[2][2][4][2], const Unit& u, int wr, int wc, int fr, int fq) const {
        const int row0 = u.pm * BM + wr * 64 + fr, col0 = u.pn * HALF + wc * 32 + 8 * fq;
#pragma unroll
        for (int ai = 0; ai < 2; ++ai)
#pragma unroll
            for (int m = 0; m < 4; ++m) {
                f32x4 r[2];
#pragma unroll
                for (int n = 0; n < 2; ++n) { const f32x4 g = acc[ai][0][m][n] * (1.0f / W8_GU), up = acc[ai][1][m][n] * (A8_ACT / W8_GU);
#pragma unroll
                    for (int j = 0; j < 4; ++j) { const float e = __builtin_amdgcn_exp2f(-g[j] * LOG2E); r[n][j] = g[j] * __builtin_amdgcn_rcpf(1.0f + e) * up[j]; } }
                u32x2 w; w.x = cvt4_fp8(r[0][0], r[0][1], r[0][2], r[0][3]); w.y = cvt4_fp8(r[1][0], r[1][1], r[1][2], r[1][3]);
                *(u32x2*)(O + (size_t)(row0 + ai * HALF + m * 16) * ldo + col0) = w;
            }
    }
};
struct EpiBf16 {
    static constexpr bool PERM = true;
    bf16_t* O; int ldo; size_t sstride; float osc;
    __device__ __forceinline__ void operator()(const f32x4 (&acc)[2][2][4][2], const Unit& u, int wr, int wc, int fr, int fq) const {
        const int row0 = u.pm * BM + wr * 64 + fr;
#pragma unroll
        for (int ai = 0; ai < 2; ++ai)
#pragma unroll
            for (int m = 0; m < 4; ++m)
#pragma unroll
                for (int bj = 0; bj < 2; ++bj)
                    store8(O + (size_t)u.os * sstride + (size_t)(row0 + ai * HALF + m * 16) * ldo + u.pn * BM + bj * HALF + wc * 32 + 8 * fq, acc[ai][bj][m][0] * osc, acc[ai][bj][m][1] * osc);
    }
};
struct EpiF8 {
    static constexpr bool PERM = true;
    unsigned char* O; int ldo; size_t sstride; float osc;
    __device__ __forceinline__ void operator()(const f32x4 (&acc)[2][2][4][2], const Unit& u, int wr, int wc, int fr, int fq) const {
        const int row0 = u.pm * BM + wr * 64 + fr;
#pragma unroll
        for (int ai = 0; ai < 2; ++ai)
#pragma unroll
            for (int m = 0; m < 4; ++m)
#pragma unroll
                for (int bj = 0; bj < 2; ++bj) { const f32x4 v0 = acc[ai][bj][m][0] * osc, v1 = acc[ai][bj][m][1] * osc;
                    u32x2 w; w.x = cvt4_fp8(v0[0], v0[1], v0[2], v0[3]); w.y = cvt4_fp8(v1[0], v1[1], v1[2], v1[3]);
                    *(u32x2*)(O + (size_t)u.os * sstride + (size_t)(row0 + ai * HALF + m * 16) * ldo + u.pn * BM + bj * HALF + wc * 32 + 8 * fq) = w; }
    }
};
}

namespace att {
constexpr int NW = 8, QBLK = 32, KVBLK = 64, QB = 256;
constexpr int SHM_V = KVBLK * 128 * 2;
constexpr int LDS_K = 2 * SHM_V, LDS_WS = LDS_K + 2 * 64 * 192 * 2, LDS_BIAS = LDS_WS + NW * 64 * 4, LDS_QR = LDS_BIAS + 512;
#define SBAR() __builtin_amdgcn_sched_barrier(0)
__device__ __forceinline__ int v_st(int k, int c) { const int kk = (k & ~0xC) | ((k & 4) << 1) | ((k & 8) >> 1); return ((kk >> 3) * 4 + (c >> 5)) * 512 + ((kk & 7) * 32 + (c & 31)) * 2; }
__device__ __forceinline__ int v_rd_base(int lane) { return ((lane & 3) << 3) | (((lane >> 2) & 3) << 6) | (((lane >> 4) & 1) << 5) | (((lane >> 5) & 1) << 8); }
constexpr int v_rd_off(int d0, int ks, int half) { return d0 * 512 + ks * 4096 + half * 2048; }
__device__ __forceinline__ int crow(int r, int hi) { return (r & 3) + 8 * (r >> 2) + 4 * hi; }
__device__ __forceinline__ unsigned cvtpk(float lo, float hi) { unsigned r; asm volatile("v_cvt_pk_bf16_f32 %0, %1, %2" : "=v"(r) : "v"(lo), "v"(hi)); return r; }

__device__ __forceinline__ void mask_tile(f32x16& p0, f32x16& p1, int dq) {
    const float NEG = -__builtin_inff();
#pragma unroll
    for (int r = 0; r < 16; ++r) {
        const int c = (r & 3) + 8 * (r >> 2);
        if (dq - c < 0) p0[r] = NEG;
        if (dq - c - 32 < 0) p1[r] = NEG;
    }
}
__device__ __forceinline__ void bias_tile(f32x16& p0, f32x16& p1, int dq, const float* tb) {
#pragma unroll
    for (int r = 0; r < 16; ++r) {
        const int c = (r & 3) + 8 * (r >> 2);
        int d0 = dq - c, d1 = dq - c - 32;
        d0 = d0 < 0 ? 0 : (d0 > 127 ? 127 : d0); d1 = d1 < 0 ? 0 : (d1 > 127 ? 127 : d1);
        p0[r] += tb[d0]; p1[r] += tb[d1];
    }
}
constexpr float THR = 8.f;
__device__ __forceinline__ void partialSM(f32x16& p0, f32x16& p1, float& m_reg, float& mn, float& alpha) {
    float pmax = p0[0];
#pragma unroll
    for (int r = 1; r < 16; ++r) pmax = fmaxf(pmax, p0[r]);
#pragma unroll
    for (int r = 0; r < 16; ++r) pmax = fmaxf(pmax, p1[r]);
    { auto rr = __builtin_amdgcn_permlane32_swap(__float_as_uint(pmax), __float_as_uint(pmax), false, false);
      pmax = fmaxf(__uint_as_float(rr[0]), __uint_as_float(rr[1])); }
    if (__builtin_expect(__all((pmax - m_reg) <= THR), 1)) { mn = m_reg; alpha = 1.f; }
    else { mn = fmaxf(m_reg, pmax); alpha = __builtin_amdgcn_exp2f(m_reg - mn); m_reg = mn; }
#pragma unroll
    for (int r = 0; r < 16; ++r) p0[r] = p0[r] - mn;
#pragma unroll
    for (int r = 0; r < 16; ++r) p1[r] = p1[r] - mn;
#pragma unroll
    for (int r = 0; r < 16; ++r) p0[r] = __builtin_amdgcn_exp2f(p0[r]);
}
__device__ __forceinline__ void finishSM(f32x16& p0, f32x16& p1, float alpha, float& l_reg, bf16x8& pa0, bf16x8& pa1, bf16x8& pa2, bf16x8& pa3) {
#pragma unroll
    for (int r = 0; r < 16; ++r) p1[r] = __builtin_amdgcn_exp2f(p1[r]);
    float ps = 0;
#pragma unroll
    for (int r = 0; r < 16; ++r) ps += p0[r];
#pragma unroll
    for (int r = 0; r < 16; ++r) ps += p1[r];
    { auto rr = __builtin_amdgcn_permlane32_swap(__float_as_uint(ps), __float_as_uint(ps), false, false);
      ps = __uint_as_float(rr[0]) + __uint_as_float(rr[1]); }
    l_reg = l_reg * alpha + ps;
#define PK4(P, B_, OUT) do { unsigned a0 = cvtpk(P[B_+0], P[B_+1]), a1 = cvtpk(P[B_+2], P[B_+3]);                          \
        unsigned b0 = cvtpk(P[B_+4], P[B_+5]), b1 = cvtpk(P[B_+6], P[B_+7]);                                             \
        auto r0 = __builtin_amdgcn_permlane32_swap(a0, b0, false, false); auto r1 = __builtin_amdgcn_permlane32_swap(a1, b1, false, false); \
        u32x4 w = {r0[0], r1[0], r0[1], r1[1]}; OUT = *reinterpret_cast<bf16x8*>(&w); } while (0)
    PK4(p0, 0, pa0); PK4(p0, 8, pa1); PK4(p1, 0, pa2); PK4(p1, 8, pa3);
#undef PK4
}
template <int DQK> __device__ __forceinline__ int kswz(int row, int colB) { return row * (DQK * 2) + (colB ^ ((row & 7) << 4)); }
template <int KB, int DQK>
__device__ __forceinline__ void qkt(f32x16& p0, f32x16& p1, const char* K_lds, int r32, int hi, const bf16x8* qr, const char* qrl) {
    constexpr int SHMK = 64 * DQK * 2, NF = DQK / 16, NFR = NF > 8 ? 8 : NF;
    p0 = f32x16{}; p1 = f32x16{};
    const char* kb[4];
#pragma unroll
    for (int dd = 0; dd < 4; ++dd) kb[dd] = K_lds + KB * SHMK + kswz<DQK>(r32, (dd * 16 + hi * 8) * 2);
#pragma unroll
    for (int d0 = 0; d0 < NF; ++d0) { const char* a = kb[d0 & 3] + (d0 >> 2) * 128;
        bf16x8 b0 = *reinterpret_cast<const bf16x8*>(a);
        bf16x8 b1 = *reinterpret_cast<const bf16x8*>(a + 32 * DQK * 2);
        bf16x8 q; if (d0 < NFR) q = qr[d0]; else q = *reinterpret_cast<const bf16x8*>(qrl + (d0 - NFR) * 1024);
        p0 = __builtin_amdgcn_mfma_f32_32x32x16_bf16(b0, q, p0, 0, 0, 0);
        p1 = __builtin_amdgcn_mfma_f32_32x32x16_bf16(b1, q, p1, 0, 0, 0); }
}
template <int VB>
__device__ __forceinline__ void pv_tile(f32x16* o, int vb0, bf16x8 pa0, bf16x8 pa1, bf16x8 pa2, bf16x8 pa3) {
#define TRRD(dst, off) asm volatile("ds_read_b64_tr_b16 %0, %1 offset:%2" : "=&v"(dst) : "v"(vb0), "i"(off) : "memory")
#define PV_D0(d0) do { s16x4 l0, l1, l2, l3, h0, h1, h2, h3; constexpr int b_ = VB * SHM_V + v_rd_off(d0, 0, 0); \
        TRRD(l0, b_); TRRD(h0, b_ + 2048); TRRD(l1, b_ + 4096); TRRD(h1, b_ + 6144); TRRD(l2, b_ + 8192); TRRD(h2, b_ + 10240); TRRD(l3, b_ + 12288); TRRD(h3, b_ + 14336); \
        asm volatile("s_waitcnt lgkmcnt(0)" ::: "memory"); SBAR();   \
        o[d0] = __builtin_amdgcn_mfma_f32_32x32x16_bf16(pa0, (bf16x8){l0[0], l0[1], l0[2], l0[3], h0[0], h0[1], h0[2], h0[3]}, o[d0], 0, 0, 0);   \
        o[d0] = __builtin_amdgcn_mfma_f32_32x32x16_bf16(pa1, (bf16x8){l1[0], l1[1], l1[2], l1[3], h1[0], h1[1], h1[2], h1[3]}, o[d0], 0, 0, 0);   \
        o[d0] = __builtin_amdgcn_mfma_f32_32x32x16_bf16(pa2, (bf16x8){l2[0], l2[1], l2[2], l2[3], h2[0], h2[1], h2[2], h2[3]}, o[d0], 0, 0, 0);   \
        o[d0] = __builtin_amdgcn_mfma_f32_32x32x16_bf16(pa3, (bf16x8){l3[0], l3[1], l3[2], l3[3], h3[0], h3[1], h3[2], h3[3]}, o[d0], 0, 0, 0); } while (0)
    PV_D0(0); PV_D0(1); PV_D0(2); PV_D0(3);
#undef PV_D0
#undef TRRD
}

struct AttnArgs {
    const bf16_t* Q; const bf16_t* K; const bf16_t* K2; const bf16_t* V; int P0;
    bf16_t* Out; float* O0; float lam; const float* dnorm; float oscale;
};
template <bool MLA, int MODE, bool PIPE>
__device__ __forceinline__ void attn_block(const AttnArgs& a, char* lds) {
    constexpr int DQK = MLA ? 192 : 64, NF = DQK / 16, KROW = DQK * 2, SHMK = 64 * KROW;
    constexpr bool BIAS = !MLA;
    int tid_ = threadIdx.x; asm volatile("" : "+v"(tid_));
    const int tid = tid_, wid = __builtin_amdgcn_readfirstlane(tid >> 6), lane = tid & 63, r32 = lane & 31, hi = lane >> 5;
    constexpr int ldq = MLA ? QMC : HC, ldk = KVC, ldk2 = HC, ldv = MLA ? KVC : HC;
    const int P0 = a.P0, NT = (P0 + QB) / KVBLK;
    const int qlo = P0 + wid * QBLK, qm = qlo + r32 - 4 * hi;
    char* V_lds = lds; char* K_lds = lds + LDS_K;
    float* ws = (float*)(lds + LDS_WS) + wid * 64; float* li_l = ws; float* al_l = ws + 32;
    const float* tb = (const float*)(lds + LDS_BIAS);
    float m_reg = -1e30f, l_reg = 0; f32x16 o[4] = {};
    const int sr = tid >> 4, sc = (tid & 15) * 8, vst0 = v_st(sr, sc), vst1 = v_st(32 + sr, sc);
    const int kws = kswz<DQK>(sr, sc * 2);
    const int kr_row = tid >> 3, kr_c = (tid & 7) * 8;
    const int kws2 = kswz<DQK>(kr_row, ((MLA ? 128 : 0) + kr_c) * 2);
    const int vb0 = (int)(uintptr_t)V_lds + v_rd_base(lane);
    bf16x8 st_v0, st_v1, st_k0, st_k1, st_k2;
    constexpr int NFR = NF > 8 ? 8 : NF;
    bf16x8 qr[NFR];
    char* qrl = lds + LDS_QR + wid * 4096 + lane * 16;
#pragma unroll
    for (int d0 = 0; d0 < NFR; ++d0) qr[d0] = *reinterpret_cast<const bf16x8*>(a.Q + (size_t)(qlo + r32) * ldq + d0 * 16 + hi * 8);
#pragma unroll
    for (int d0 = NFR; d0 < NF; ++d0) *reinterpret_cast<bf16x8*>(qrl + (d0 - NFR) * 1024) = *reinterpret_cast<const bf16x8*>(a.Q + (size_t)(qlo + r32) * ldq + d0 * 16 + hi * 8);
    const unsigned voV = (unsigned)(sr * ldv + sc) * 2u, voK = (unsigned)(sr * ldk + sc) * 2u, voK2 = (unsigned)(kr_row * ldk2 + kr_c) * 2u;
    constexpr size_t v32 = (size_t)32 * ldv * 2, k32 = (size_t)32 * ldk * 2;
#define VMW() asm volatile("s_waitcnt vmcnt(0)" ::: "memory")
#define SLOAD(k0) do { const char* vb_ = (const char*)a.V + (size_t)(k0) * ldv * 2; const char* k2b_ = (const char*)a.K2 + (size_t)(k0) * ldk2 * 2; \
        st_v0 = *reinterpret_cast<const bf16x8*>(vb_ + voV); st_v1 = *reinterpret_cast<const bf16x8*>(vb_ + v32 + voV); \
        if constexpr (MLA) { const char* kb_ = (const char*)a.K + (size_t)(k0) * ldk * 2; st_k0 = *reinterpret_cast<const bf16x8*>(kb_ + voK); st_k1 = *reinterpret_cast<const bf16x8*>(kb_ + k32 + voK); } \
        st_k2 = *reinterpret_cast<const bf16x8*>(k2b_ + voK2); } while (0)
#define SWRITE(bf) do { *(bf16x8*)(V_lds + (bf) * SHM_V + vst0) = st_v0; *(bf16x8*)(V_lds + (bf) * SHM_V + vst1) = st_v1; \
        if constexpr (MLA) { *(bf16x8*)(K_lds + (bf) * SHMK + kws) = st_k0; *(bf16x8*)(K_lds + (bf) * SHMK + kws + 32 * KROW) = st_k1; } \
        *(bf16x8*)(K_lds + (bf) * SHMK + kws2) = st_k2; } while (0)
#define RESC(al) do { if (__any((al) < 1.f)) { if (hi == 0) al_l[r32] = (al); asm volatile("s_waitcnt lgkmcnt(0)" ::: "memory");              \
                     for (int d_ = 0; d_ < 4; ++d_) for (int r = 0; r < 16; ++r) o[d_][r] *= al_l[crow(r, hi)]; } } while (0)
#define KBASE(t) ((t) * KVBLK)
#define MASKT(P0_, P1_, t) do { const int kb_ = KBASE(t); \
        if (BIAS && kb_ + 176 > qlo) bias_tile(P0_, P1_, qm - kb_, tb); \
        if (kb_ + KVBLK - 1 > qlo) mask_tile(P0_, P1_, qm - kb_); } while (0)
    bf16x8 pa0, pa1, pa2, pa3;
    if constexpr (!PIPE) {
    f32x16 p0, p1; float mn, al;
    SLOAD(0); VMW(); SWRITE(0);
    __syncthreads();
#define STEP(t, BF) do { \
        if ((t) + 1 < NT) { SLOAD(KBASE((t) + 1)); } SBAR(); \
        qkt<BF, DQK>(p0, p1, K_lds, r32, hi, qr, qrl); \
        MASKT(p0, p1, (t)); partialSM(p0, p1, m_reg, mn, al); RESC(al); \
        finishSM(p0, p1, al, l_reg, pa0, pa1, pa2, pa3); SBAR(); \
        pv_tile<BF>(o, vb0, pa0, pa1, pa2, pa3); SBAR(); \
        if ((t) + 1 < NT) { VMW(); SWRITE(1 - (BF)); } \
        __syncthreads(); } while (0)
    for (int t = 0; t < NT; t += 2) { STEP(t, 0); STEP(t + 1, 1); }
#undef STEP
    } else {
    f32x16 pA0, pA1, pB0, pB1; float mnA, mnB, alA, alB;
    SLOAD(0); VMW(); SWRITE(0); SBAR();
    SLOAD(KBASE(1));
    __syncthreads();
    SBAR(); qkt<0, DQK>(pA0, pA1, K_lds, r32, hi, qr, qrl);
    MASKT(pA0, pA1, 0); partialSM(pA0, pA1, m_reg, mnA, alA);
    VMW(); SWRITE(1);
    __syncthreads();
#define HALF_STEP(PX0, PX1, mnX, alX, PY0, PY1, alY, t, KB, VB, SB) do {                                                      \
        SBAR(); qkt<KB, DQK>(PX0, PX1, K_lds, r32, hi, qr, qrl);                                                              \
        finishSM(PY0, PY1, alY, l_reg, pa0, pa1, pa2, pa3); SBAR();                                                           \
        if ((t) + 1 < NT) { SLOAD(KBASE((t) + 1)); SBAR(); }                                                                  \
        pv_tile<VB>(o, vb0, pa0, pa1, pa2, pa3); MASKT(PX0, PX1, (t)); partialSM(PX0, PX1, m_reg, mnX, alX);                  \
        __syncthreads();                                                                                                      \
        if ((t) + 1 < NT) { VMW(); SWRITE(SB); }                                                                              \
        RESC(alX); __syncthreads(); } while (0)
    for (int t = 1; t + 1 < NT; t += 2) {
        HALF_STEP(pB0, pB1, mnB, alB, pA0, pA1, alA, t, 1, 0, 0);
        HALF_STEP(pA0, pA1, mnA, alA, pB0, pB1, alB, t + 1, 0, 1, 1);
    }
#undef HALF_STEP
    SBAR(); qkt<1, DQK>(pB0, pB1, K_lds, r32, hi, qr, qrl); SBAR();
    finishSM(pA0, pA1, alA, l_reg, pa0, pa1, pa2, pa3); SBAR();
    pv_tile<0>(o, vb0, pa0, pa1, pa2, pa3);
    MASKT(pB0, pB1, NT - 1); partialSM(pB0, pB1, m_reg, mnB, alB); RESC(alB);
    finishSM(pB0, pB1, alB, l_reg, pa0, pa1, pa2, pa3); SBAR(); pv_tile<1>(o, vb0, pa0, pa1, pa2, pa3);
    SBAR();
    __syncthreads();
    }
    if (hi == 0) li_l[r32] = l_reg; asm volatile("s_waitcnt lgkmcnt(0)" ::: "memory");
    float rli[16];
#pragma unroll
    for (int r = 0; r < 16; ++r) rli[r] = __builtin_amdgcn_rcpf(li_l[crow(r, hi)]);
    if constexpr (MODE == 0) {
        bf16_t* Ow = a.Out + (size_t)qlo * 1024;
#pragma unroll
        for (int r = 0; r < 16; ++r) { const int orow = crow(r, hi);
#pragma unroll
            for (int d0 = 0; d0 < 4; ++d0) { const float v = o[d0][r] * rli[r]; const float vn = __shfl_xor(v, 1);
                if ((r32 & 1) == 0) *(unsigned*)(Ow + (size_t)orow * 1024 + d0 * 32 + r32) = cvtpk(v, vn); } }
    } else if constexpr (MODE == 1) {
        bf16_t* Ow = (bf16_t*)a.O0 + (size_t)qlo * 512;
#pragma unroll
        for (int r = 0; r < 16; ++r) { const int orow = crow(r, hi);
#pragma unroll
            for (int d0 = 0; d0 < 4; ++d0) { const float v = o[d0][r] * rli[r]; const float vn = __shfl_xor(v, 1);
                if ((r32 & 1) == 0) *(unsigned*)(Ow + (size_t)orow * 512 + d0 * 32 + r32) = cvtpk(v, vn); } }
    } else {
        const float* O0w = a.O0 + (size_t)qlo * 512;
        bf16_t* Ow = a.Out + (size_t)qlo * 1024;
        float gn[4];
#pragma unroll
        for (int d0 = 0; d0 < 4; ++d0) gn[d0] = a.dnorm[d0 * 32 + r32] * a.oscale;
#pragma unroll
        for (int r = 0; r < 16; ++r) { const int orow = crow(r, hi);
            float d[4]; float ss = 0.f;
#pragma unroll
            for (int d0 = 0; d0 < 4; ++d0) { d[d0] = O0w[(size_t)orow * 512 + d0 * 32 + r32] - a.lam * (o[d0][r] * rli[r]); ss += d[d0] * d[d0]; }
#pragma unroll
            for (int s = 1; s < 32; s <<= 1) ss += __shfl_xor(ss, s);
            const float rs = __builtin_amdgcn_rsqf(ss * (1.0f / 128.0f) + 1e-5f);
#pragma unroll
            for (int d0 = 0; d0 < 4; ++d0) { const float v = d[d0] * rs * gn[d0]; const float vn = __shfl_xor(v, 1);
                if ((r32 & 1) == 0) *(unsigned*)(Ow + (size_t)orow * 1024 + d0 * 32 + r32) = cvtpk(v, vn); } }
    }
    __syncthreads();
#undef VMW
#undef SLOAD
#undef SWRITE
#undef RESC
#undef KBASE
#undef MASKT
#undef HALF_STEP
}
#undef SBAR
}

struct Args {
    const float* in[22]; float* out; unsigned char* ws;
    float inv[32];
    float lam_init[4];
    unsigned char bucket[128];
    unsigned short aq[32];
    int ph_lo, ph_hi;
};

template <class F, bool F8OUT = false>
__device__ __forceinline__ void cvt_item(const F& f, const float* kscale, int K, bf16_t* WT, LAS float* scr, int item, int nblk, int lane, float mul = 1.0f) {
    const int kb = item / nblk, nb = item % nblk, k0 = 64 * kb, n0 = 32 * nb;
    if (f.contig(n0)) {
        const float* base; int ld; float sc; f(n0, base, ld, sc); sc *= mul;
        const int r8 = lane >> 3, c4 = (lane & 7) * 4;
        f32x4 v[8];
#pragma unroll
        for (int i = 0; i < 8; ++i) v[i] = __builtin_nontemporal_load((const f32x4*)(base + (size_t)(k0 + 8 * i + r8) * ld + c4));
#pragma unroll
        for (int i = 0; i < 8; ++i) { const int kk = 8 * i + r8; const float m = kscale ? sc * kscale[k0 + kk] : sc;
            scr[kk * 33 + c4 + 0] = v[i][0] * m; scr[kk * 33 + c4 + 1] = v[i][1] * m; scr[kk * 33 + c4 + 2] = v[i][2] * m; scr[kk * 33 + c4 + 3] = v[i][3] * m; }
    } else {
        const float* src; int ld; float sc; f(n0 + (lane & 31), src, ld, sc); sc *= mul;
#pragma unroll 8
        for (int i = 0; i < 32; ++i) { const int kk = 2 * i + (lane >> 5); float v = src[(size_t)(k0 + kk) * ld] * sc; if (kscale) v *= kscale[k0 + kk]; scr[kk * 33 + (lane & 31)] = v; }
    }
    LDS_WAIT(); asm volatile("" ::: "memory");
    const int c = lane & 7;
#pragma unroll
    for (int j = 0; j < 4; ++j) { const int n = (lane >> 3) + 8 * j; const LAS float* s = scr + (8 * c) * 33 + n;
        if constexpr (F8OUT) {
            u32x2 o; o.x = cvt4_fp8(s[0 * 33], s[1 * 33], s[2 * 33], s[3 * 33]); o.y = cvt4_fp8(s[4 * 33], s[5 * 33], s[6 * 33], s[7 * 33]);
            *(u32x2*)((unsigned char*)WT + (size_t)(n0 + n) * K + k0 + 8 * c) = o;
        } else {
            u32x4 o; o.x = cvt_pk_bf16(s[0 * 33], s[1 * 33]); o.y = cvt_pk_bf16(s[2 * 33], s[3 * 33]); o.z = cvt_pk_bf16(s[4 * 33], s[5 * 33]); o.w = cvt_pk_bf16(s[6 * 33], s[7 * 33]);
            *(u32x4*)(WT + (size_t)(n0 + n) * K + k0 + 8 * c) = o; } }
    LDS_WAIT(); asm volatile("" ::: "memory");
}
struct MapWin { const float* W;
    __device__ __forceinline__ bool contig(int n0) const { return !(n0 >= C_KR && n0 < C_DQ); }
    __device__ __forceinline__ void operator()(int n, const float*& src, int& ld, float& sc) const {
        ld = 2240; sc = 1.f; int c = n;
        if (n >= 2240) { c = 0; sc = 0.f; }
        else if (n >= C_KR && n < C_DQ) { const int j = n - C_KR, i = j >> 1; c = C_KR + ((j & 1) ? 32 + i : i); }
        else if (n >= C_DQ && n < C_DK) sc = 0.125f * LOG2E;
        src = W + c; } };
struct MapWuq { const float* W;
    __device__ __forceinline__ bool contig(int n0) const { return (n0 % 192) < 128; }
    __device__ __forceinline__ void operator()(int n, const float*& src, int& ld, float& sc) const {
        ld = 768; sc = 0.07216878364870323f * LOG2E;
        const int hh = n / 192, j = n % 192; int c = j;
        if (j >= 128) { const int jj = j - 128, i = jj >> 1; c = 128 + ((jj & 1) ? 32 + i : i); }
        src = W + hh * 192 + c; } };
struct MapWukv { const float* Wk; const float* Wv;
    __device__ __forceinline__ bool contig(int) const { return true; }
    __device__ __forceinline__ void operator()(int n, const float*& src, int& ld, float& sc) const { ld = 512; sc = 1.f; src = n < 512 ? Wk + n : Wv + (n - 512); } };
struct MapPlain { const float* W; int N;
    __device__ __forceinline__ bool contig(int) const { return true; }
    __device__ __forceinline__ void operator()(int n, const float*& src, int& ld, float& sc) const { ld = N; sc = 1.f; src = W + n; } };
struct MapGU { const float* Wg; const float* Wu; int F;
    __device__ __forceinline__ bool contig(int) const { return true; }
    __device__ __forceinline__ void operator()(int n, const float*& src, int& ld, float& sc) const { ld = F; sc = 1.f; const int pn = n >> 8, j = n & 255; src = (j < 128) ? Wg + pn * 128 + j : Wu + pn * 128 + (j - 128); } };

__device__ __forceinline__ void cvt_moe(const Args& a, int ml, LAS float* scr, int gw, int NGW, int lane) {
    asm volatile("" : "+v"(lane));
    constexpr int I_GU = (DM / 64) * (2 * FFE / 32), I_D = (FFE / 64) * (DM / 32), I_E = I_GU + I_D;
    const float* wg = gfp(a.in[oi(19)]) + (size_t)ml * NEXP * DM * FFE; const float* wu = gfp(a.in[oi(20)]) + (size_t)ml * NEXP * DM * FFE; const float* wd = gfp(a.in[oi(21)]) + (size_t)ml * NEXP * FFE * DM;
    unsigned char* wsl = opq(a.ws); bf16_t* mgu = (bf16_t*)(wsl + WS_MGU); bf16_t* md = (bf16_t*)(wsl + WS_MD);
    for (int it = gw; it < NEXP * I_E; it += NGW) {
        const int e = it / I_E; int r = it % I_E;
        if (r < I_GU) { MapGU f{wg + (size_t)e * DM * FFE, wu + (size_t)e * DM * FFE, FFE}; cvt_item<MapGU, true>(f, nullptr, DM, (bf16_t*)((unsigned char*)mgu + (size_t)e * 2 * FFE * DM), scr, r, 2 * FFE / 32, lane, W8_GU); }
        else { r -= I_GU; MapPlain f{wd + (size_t)e * FFE * DM, DM}; cvt_item<MapPlain, true>(f, nullptr, FFE, (bf16_t*)((unsigned char*)md + (size_t)e * DM * FFE), scr, r, DM / 32, lane, W8_D); }
    }
}

template <int MODE, bool ROUTE, bool OUT8 = false, bool NOX = false, bool WRY = false>
__device__ __forceinline__ void ln_pass(const Args& a, const ystream_t* Ysrc, const float* Xres, const float* g, const float* b, float* Xout, bf16_t* XB,
                                        const float* router, unsigned* cnt, int gw, int NGW, int lane, LAS unsigned char* lds_, const float* g1 = nullptr, const float* b1 = nullptr, int stslot = 20) {
    asm volatile("" : "+v"(lane));
    unsigned char* wsl = opq(a.ws);
    const bf16_t* oslot = (const bf16_t*)(wsl + WS_OSLOT); const bf16_t* oslot2 = (const bf16_t*)(wsl + WS_OSLOT2);
    f32x4* route = (f32x4*)(wsl + WS_ROUTE);
    const int* slots = (const int*)(wsl + WS_ROUTE + 512 * 1024);
    float* st = (float*)(wsl + WS_SS);
    unsigned long long pk = 0ull;
#pragma unroll 2
    for (int m = gw; m < M; m += NGW) {
        f32x4 v[4];
        if constexpr (MODE == 0) {
#pragma unroll
            for (int j = 0; j < 4; ++j) v[j] = ld4h(Ysrc + (size_t)m * DM + (lane + 64 * j) * 4);
        } else {
            const f32x4 rt = route[m]; const int s1 = slots[2 * m], s2 = slots[2 * m + 1];
            const float mu1 = st[(size_t)m * 32 + 20], rs1 = st[(size_t)m * 32 + 21];
#pragma unroll
            for (int j = 0; j < 4; ++j) { const f32x4 yv1 = ld4h(Ysrc + (size_t)m * DM + (lane + 64 * j) * 4);
                const f32x4 xv = (yv1 - mu1) * rs1 * *((const f32x4*)g1 + lane + 64 * j) + *((const f32x4*)b1 + lane + 64 * j);
                const unsigned o1 = *((const unsigned*)((const unsigned char*)oslot + (size_t)s1 * DM) + lane + 64 * j), o2 = *((const unsigned*)((const unsigned char*)oslot + (size_t)s2 * DM) + lane + 64 * j);
                const unsigned p1 = *((const unsigned*)((const unsigned char*)oslot2 + (size_t)s1 * DM) + lane + 64 * j), p2 = *((const unsigned*)((const unsigned char*)oslot2 + (size_t)s2 * DM) + lane + 64 * j);
                const f32x2 a1l = __builtin_amdgcn_cvt_pk_f32_fp8((int)o1, false), a1h = __builtin_amdgcn_cvt_pk_f32_fp8((int)o1, true), b1l = __builtin_amdgcn_cvt_pk_f32_fp8((int)p1, false), b1h = __builtin_amdgcn_cvt_pk_f32_fp8((int)p1, true);
                const f32x2 a2l = __builtin_amdgcn_cvt_pk_f32_fp8((int)o2, false), a2h = __builtin_amdgcn_cvt_pk_f32_fp8((int)o2, true), b2l = __builtin_amdgcn_cvt_pk_f32_fp8((int)p2, false), b2h = __builtin_amdgcn_cvt_pk_f32_fp8((int)p2, true);
                const float g1s = rt[2] * (1.0f / O8), g2s = rt[3] * (1.0f / O8);
                f32x4 r;
                r[0] = xv[0] * DN_ALPHA + g1s * (a1l.x + b1l.x) + g2s * (a2l.x + b2l.x);
                r[1] = xv[1] * DN_ALPHA + g1s * (a1l.y + b1l.y) + g2s * (a2l.y + b2l.y);
                r[2] = xv[2] * DN_ALPHA + g1s * (a1h.x + b1h.x) + g2s * (a2h.x + b2h.x);
                r[3] = xv[3] * DN_ALPHA + g1s * (a1h.y + b1h.y) + g2s * (a2h.y + b2h.y);
                if constexpr (WRY) st4h((ystream_t*)Ysrc + (size_t)m * DM + (lane + 64 * j) * 4, r);
                v[j] = r; }
        }
        float s = 0.f;
#pragma unroll
        for (int j = 0; j < 4; ++j) s += (v[j][0] + v[j][1]) + (v[j][2] + v[j][3]);
        const float mean = wave_sum(s) * (1.f / DM); float s2 = 0.f;
#pragma unroll
        for (int j = 0; j < 4; ++j) { v[j] = v[j] - mean; s2 += (v[j][0] * v[j][0] + v[j][1] * v[j][1]) + (v[j][2] * v[j][2] + v[j][3] * v[j][3]); }
        const float rstd = __builtin_amdgcn_rsqf(wave_sum(s2) * (1.f / DM) + 1e-5f);
#pragma unroll
        for (int j = 0; j < 4; ++j) { const f32x4 gv = *((const f32x4*)g + lane + 64 * j), bv = *((const f32x4*)b + lane + 64 * j);
            v[j] = v[j] * rstd * gv + bv;
            if constexpr (!NOX) *((f32x4*)(Xout + (size_t)m * DM) + lane + 64 * j) = v[j];
            if constexpr (OUT8) { *((unsigned*)((unsigned char*)XB + (size_t)m * DM) + lane + 64 * j) = cvt4_fp8(v[j][0], v[j][1], v[j][2], v[j][3]); }
            else if (XB) { u32x2 w; w.x = cvt_pk_bf16(v[j][0], v[j][1]); w.y = cvt_pk_bf16(v[j][2], v[j][3]); *((u32x2*)(XB + (size_t)m * DM) + lane + 64 * j) = w; } }
        if constexpr (NOX) { if (lane == 0) { st[(size_t)m * 32 + stslot] = mean; st[(size_t)m * 32 + stslot + 1] = rstd; } }
        if constexpr (ROUTE) {
            float lg[8];
#pragma unroll
            for (int e = 0; e < 8; ++e) lg[e] = 0.f;
#pragma unroll
            for (int j = 0; j < 4; ++j)
#pragma unroll
                for (int q = 0; q < 4; ++q) { const int k = (lane + 64 * j) * 4 + q; const f32x4 r0 = *(const f32x4*)(router + (size_t)k * 8), r1 = *(const f32x4*)(router + (size_t)k * 8 + 4); const float xv = v[j][q];
                    lg[0] += xv * r0[0]; lg[1] += xv * r0[1]; lg[2] += xv * r0[2]; lg[3] += xv * r0[3]; lg[4] += xv * r1[0]; lg[5] += xv * r1[1]; lg[6] += xv * r1[2]; lg[7] += xv * r1[3]; }
#pragma unroll
            for (int e = 0; e < 8; ++e) lg[e] = wave_sum(lg[e]);
            int e1 = 0; float v1 = lg[0];
#pragma unroll
            for (int e = 1; e < 8; ++e) if (lg[e] > v1) { v1 = lg[e]; e1 = e; }
            int e2 = -1; float v2 = -__builtin_inff();
#pragma unroll
            for (int e = 0; e < 8; ++e) if (e != e1 && lg[e] > v2) { v2 = lg[e]; e2 = e; }
            const float g2 = 1.0f / (1.0f + __expf(v1 - v2)), g1 = 1.0f - g2;
            if (lane == 0) { f32x4 rt; rt[0] = __int_as_float(e1); rt[1] = __int_as_float(e2); rt[2] = g1; rt[3] = g2; route[m] = rt; }
            pk += (1ull << (8 * e1)) + (1ull << (8 * e2));
        }
    }
    if constexpr (ROUTE) {
        LAS unsigned* lc = (LAS unsigned*)(lds_ + 131072);
        const bool w0 = (gw & 7) == 0;
        if (w0 && lane < 8) lc[lane] = 0u;
        __syncthreads();
        if (lane < 8) atomicAdd((unsigned*)(lc + lane), (unsigned)((pk >> (8 * lane)) & 255ull));
        __syncthreads();
        if (w0 && lane < 8) atomicAdd(cnt + lane, lc[lane]);
    }
}

#define XB_TMO      128
#define XB_XCNT(j)  (256  + 64 * (j))
#define XB_XSUB(j)  (1280 + 64 * (j))
#define XB_XGEN(j)  (2304 + 64 * (j))
#define XB_TOP      3328
#define XB_TOPGEN   3392
#define XCD_BAR_WORDS 3456
#define XB_SPIN_CAP (1u << 22)
__device__ __forceinline__ unsigned xb_ld(unsigned* p)              { return __hip_atomic_load(p, __ATOMIC_RELAXED, __HIP_MEMORY_SCOPE_AGENT); }
__device__ __forceinline__ unsigned xb_add(unsigned* p, unsigned v) { return __hip_atomic_fetch_add(p, v, __ATOMIC_RELAXED, __HIP_MEMORY_SCOPE_AGENT); }
__device__ __forceinline__ unsigned xb_xcc_id() { return (unsigned)__builtin_amdgcn_s_getreg((3 << 11) | 20) & 0xFu; }
#define XB_SPIN(cond, bar) do { unsigned _sp = 0; while (cond) { __builtin_amdgcn_s_sleep(1); \
    if ((++_sp & 255u) == 0u) { if (xb_ld(&(bar)[XB_TMO])) break; if (_sp > XB_SPIN_CAP) { atomicAdd(&(bar)[XB_TMO], 1u); break; } } } } while (0)
struct XcdBarrier { unsigned* bar; unsigned x; volatile LAS unsigned* st; };
__device__ __forceinline__ XcdBarrier xcd_barrier_post(unsigned* bar, volatile LAS unsigned* st) {
    XcdBarrier b; b.bar = bar; b.x = xb_xcc_id(); b.st = st;
    if (threadIdx.x == 0) (void)xb_add(&bar[XB_XCNT(b.x)], 1u);
    return b;
}
__device__ __forceinline__ void xcd_barrier_complete(unsigned* bar, unsigned x, unsigned& nloc, unsigned& nx) {
    const unsigned G = gridDim.x * gridDim.y * gridDim.z;
    unsigned sum, cnt, mine, sp = 0u;
    for (;;) {
        sum = 0u; cnt = 0u; mine = 0u;
#pragma unroll
        for (unsigned j = 0; j < 16; ++j) { const unsigned c = xb_ld(&bar[XB_XCNT(j)]); sum += c; cnt += (c > 0u) ? 1u : 0u; mine = (j == x) ? c : mine; }
        if (sum == G) break;
        __builtin_amdgcn_s_sleep(1);
        if ((++sp & 255u) == 0u) { if (xb_ld(&bar[XB_TMO])) break; if (sp > XB_SPIN_CAP) { atomicAdd(&bar[XB_TMO], 1u); break; } }
    }
    nloc = mine > 0u ? mine : 1u; nx = cnt > 0u ? cnt : 1u;
}
__device__ __forceinline__ void xcd_barrier(const XcdBarrier& b) {
    asm volatile("s_waitcnt vmcnt(0)" ::: "memory");
    __syncthreads();
    if (threadIdx.x == 0) {
        unsigned* bar = b.bar;
        __builtin_amdgcn_s_waitcnt(0);
        unsigned nloc = b.st[0], nx = b.st[1];
        if (nloc == 0u) { xcd_barrier_complete(bar, b.x, nloc, nx); b.st[0] = nloc; b.st[1] = nx; }
        const unsigned old = xb_add(&bar[XB_XSUB(b.x)], 1u);
        const unsigned gen = old / nloc;
        if (old + 1u == (gen + 1u) * nloc) {
            __builtin_amdgcn_fence(__ATOMIC_RELEASE, "agent");
            asm volatile("s_waitcnt vmcnt(0)" ::: "memory");
            const unsigned og = xb_add(&bar[XB_TOP], 1u);
            const unsigned tg = og / nx;
            if (og + 1u == (tg + 1u) * nx) xb_add(&bar[XB_TOPGEN], 1u);
            else XB_SPIN(xb_ld(&bar[XB_TOPGEN]) == tg, bar);
            __builtin_amdgcn_fence(__ATOMIC_ACQUIRE, "agent");
            xb_add(&bar[XB_XGEN(b.x)], 1u);
            asm volatile("s_waitcnt vmcnt(0)" ::: "memory");
        } else {
            XB_SPIN(xb_ld(&bar[XB_XGEN(b.x)]) == gen, bar);
            __builtin_amdgcn_fence(__ATOMIC_ACQUIRE, "agent");
            asm volatile("s_waitcnt vmcnt(0)" ::: "memory");
        }
    }
    __syncthreads();
}
constexpr int CW_BAR = 16384;

__global__ void __launch_bounds__(512, 2) mega_fwd(Args a) {
    extern __shared__ __attribute__((aligned(16))) unsigned char lds_raw[];
    LAS unsigned char* lds = (LAS unsigned char*)lds_raw;
    cg::grid_group grid = cg::this_grid();
    const int tid = threadIdx.x, wave = __builtin_amdgcn_readfirstlane(tid >> 6);
#define FRESH_LANE(name) int name = threadIdx.x; asm volatile("" : "+v"(name)); name &= 63
    const int G = gridDim.x, bx = blockIdx.x;
    const int vcu = (G % 8 == 0) ? (bx % 8) * (G / 8) + bx / 8 : bx;
    const int gw = vcu * 8 + wave, NGW = G * 8;
#define ws opq(a.ws)
#define ctl ((unsigned*)(ws + WS_CTL))
#define tab ((float*)(ws + WS_TAB))
#define ssq ((float*)(ws + WS_SS))
#define sskv ((float*)(ws + WS_SS))
#define WinT ((bf16_t*)(ws + WS_WIN))
#define WuqT ((bf16_t*)(ws + WS_WUQ))
#define WukvT ((bf16_t*)(ws + WS_WUKV))
#define WoT ((bf16_t*)(ws + WS_WO))
#define WguT ((bf16_t*)(ws + WS_WGU))
#define WdT ((bf16_t*)(ws + WS_WD))
#define MguT ((bf16_t*)(ws + WS_MGU))
#define MdT ((bf16_t*)(ws + WS_MD))
#define Xf ((float*)(ws + WS_X))
#define XB ((bf16_t*)(ws + WS_XB))
#define Y ((ystream_t*)(ws + WS_Y))
#define Hb ((bf16_t*)(ws + WS_H))
#define QMb ((bf16_t*)(ws + WS_QM))
#define KVb ((bf16_t*)(ws + WS_KVB))
#define MRG ((bf16_t*)(ws + WS_MRG))
#define O0buf ((float*)(ws + WS_O0))
#define O1buf ((float*)(ws + WS_O0 + 32 * MiB))
#define ACT ((bf16_t*)(ws + WS_ACT))
#define XG ((bf16_t*)(ws + WS_XG))
#define MACT ((bf16_t*)(ws + WS_MACT))
#define OSLOT ((bf16_t*)(ws + WS_OSLOT))
    LAS float* scr = (LAS float*)(lds + wave * 16384);

    volatile LAS unsigned* bst = (volatile LAS unsigned*)(lds + LDS_BYTES - 64);
    if (tid < 2) bst[tid] = 0u;
    __syncthreads();
    XcdBarrier xbar = xcd_barrier_post((unsigned*)(ws + WS_CTL) + CW_BAR, bst);
    int ph = 0;
    const int lo = a.ph_lo, hi = a.ph_hi;
#ifndef EN
#define EN 0xFFFFF
#endif
#ifndef REP
#define REP 0
#endif
#define PH_BEGIN(k) if (lo <= ph && ph < hi) { if constexpr ((EN >> (k)) & 1) for (int rep_ = 0; rep_ < ((((REP) >> (k)) & 1) ? 2 : 1); ++rep_) {
#define PH_END() } if (ph + 1 < hi) { if (ph == 0) grid.sync(); else xcd_barrier(xbar); } } ++ph;

    PH_BEGIN(0)
    {
        FRESH_LANE(lane_);
#define lane lane_
        constexpr int I_IN = (DM / 64) * (HC / 32), I_UQ = (384 / 64) * (768 / 32), I_UKV = (256 / 64) * (1024 / 32), I_O = (DM / 64) * (DM / 32), I_L = I_IN + I_UQ + I_UKV + I_O;
        constexpr int I_GU = (DM / 64) * (2 * FFD / 32), I_D = (FFD / 64) * (DM / 32), I_F = I_GU + I_D;
        for (int it = gw; it < 4 * I_L + 2 * I_F; it += NGW) {
            if (it < 4 * I_L) { const int l = it / I_L; int r = it % I_L;
                if (r < I_IN) { MapWin f{gfp(a.in[oi(2)]) + (size_t)l * DM * 2240}; cvt_item(f, nullptr, DM, WinT + (size_t)l * HC * DM, scr, r, HC / 32, lane); continue; } r -= I_IN;
                if (r < I_UQ) { MapWuq f{gfp(a.in[oi(5)]) + (size_t)l * 384 * 768}; cvt_item(f, gfp(a.in[oi(3)]) + l * 384, 384, WuqT + (size_t)l * 768 * 384, scr, r, 768 / 32, lane); continue; } r -= I_UQ;
                if (r < I_UKV) { MapWukv f{gfp(a.in[oi(6)]) + (size_t)l * 256 * 512, gfp(a.in[oi(7)]) + (size_t)l * 256 * 512}; cvt_item(f, gfp(a.in[oi(4)]) + l * 256, 256, WukvT + (size_t)l * 1024 * 256, scr, r, 1024 / 32, lane); continue; } r -= I_UKV;
                { MapPlain f{gfp(a.in[oi(10)]) + (size_t)l * DM * DM, DM}; cvt_item(f, nullptr, DM, WoT + (size_t)l * DM * DM, scr, r, DM / 32, lane); }
            } else { const int q = it - 4 * I_L, d = q / I_F; int r = q % I_F;
                if (r < I_GU) { MapGU f{gfp(a.in[oi(15)]) + (size_t)d * DM * FFD, gfp(a.in[oi(16)]) + (size_t)d * DM * FFD, FFD}; cvt_item<MapGU, true>(f, nullptr, DM, (bf16_t*)((unsigned char*)WguT + (size_t)d * 2 * FFD * DM), scr, r, 2 * FFD / 32, lane, W8_GU); }
                else { r -= I_GU; MapPlain f{gfp(a.in[oi(17)]) + (size_t)d * FFD * DM, DM}; cvt_item<MapPlain, true>(f, nullptr, FFD, (bf16_t*)((unsigned char*)WdT + (size_t)d * DM * FFD), scr, r, DM / 32, lane, W8_D); }
            }
        }
        cvt_moe(a, 0, scr, gw, NGW, fresh_lane());
        for (int m = gw; m < M; m += NGW) {
#pragma unroll
            for (int j = 0; j < 4; ++j) { const f32x4 v = *((const f32x4*)(gfp(a.in[oi(0)]) + (size_t)m * DM) + lane + 64 * j); u32x2 w; w.x = cvt_pk_bf16(v[0], v[1]); w.y = cvt_pk_bf16(v[2], v[3]); *((u32x2*)(XB + (size_t)m * DM) + lane + 64 * j) = w; }
        }
        for (int i = bx * 512 + tid; i < SEQ * 32; i += G * 512) { const int pos = i >> 5, fi = i & 31; const float ang = (float)pos * a.inv[fi];
            const double rev = (double)ang * 0.15915494309189535; const float fr = (float)(rev - __builtin_rint(rev));
            tab[2 * i] = __builtin_amdgcn_cosf(fr); tab[2 * i + 1] = __builtin_amdgcn_sinf(fr); }
        if (bx == 0 && tid < 128) ctl[tid] = 0u;
#undef lane
    }
    PH_END()

    for (int l = 0; l < DEPTH; ++l) {
        const bool moe = (l & 1) != 0; const int li = l >> 1;
        const float* xres = (l == 0) ? gfp(a.in[oi(0)]) : Xf;
#define splitA (G == 256)
        PH_BEGIN(1)
        { pg8::StaticOrder S; S.init(M, splitA ? 2048 : HC, G, obx()); pg8::EpiH E{Hb, ssq, sskv, tab};
          pg8::gemm_phase(lds, XB, DM, WinT + (size_t)l * HC * DM, DM, DM, S, E); }
        PH_END()
        PH_BEGIN(2)
        {
#ifndef NOQ
          if (splitA && bx >= 192) { pg8::OneUnit S{obx() - 192, 8, true}; pg8::EpiH E{Hb, ssq, sskv, tab};
            pg8::gemm_phase(lds, XB, DM, WinT + (size_t)l * HC * DM, DM, DM, S, E); }
          else { pg8::StaticOrder S; S.init(M, QMC, splitA ? 192 : G, obx()); pg8::EpiQ E{QMb, ssq, tab};
            pg8::gemm_phase(lds, Hb + C_CQ, HC, WuqT + (size_t)l * 768 * 384, 384, 384, S, E); }
#endif
#ifndef NOKV
          { pg8::StaticOrder S; S.init(M, KVC, G, obx()); pg8::EpiKV E{KVb, sskv};
            pg8::gemm_phase(lds, Hb + C_CKV, HC, WukvT + (size_t)l * 1024 * 256, 256, 256, S, E); }
#endif
        }
        PH_END()
        PH_BEGIN(3)
        {
            unsigned* qc = ctl + 512 + l;
            volatile LAS int* qslot = (volatile LAS int*)(lds + LDS_BYTES - 32);
            for (;;) {
                if (tid == 0) *qslot = (int)atomicAdd(qc, 1u);
                __syncthreads();
                const int it = __builtin_amdgcn_readfirstlane(*qslot);
                __syncthreads();
                if (it >= 768) break;
                int acc = 0, ent = 0, r = 0;
                for (int e = 0; e < 32; ++e) { const int en = (int)a.aq[e]; const int n = (en >> 8) ? 32 : 16; if (it >= acc && it < acc + n) { ent = en; r = it - acc; } acc += n; }
                const int qb = ent & 255; const bool is_diff = (ent >> 8) != 0;
                const int bh = is_diff ? (r >> 1) : r, c = r & 1, b = bh >> 2, hh = bh & 3;
                const size_t rb = (size_t)b * SEQ;
                if (!is_diff) {
                    att::AttnArgs A; A.Q = QMb + rb * QMC + hh * 192; A.K = KVb + rb * KVC + hh * 128; A.K2 = Hb + rb * HC + C_KR;
                    A.V = KVb + rb * KVC + 512 + hh * 128; A.P0 = qb * 256; A.Out = MRG + rb * 1024 + hh * 128; A.O0 = nullptr;
                    att::attn_block<true, 0, PIPE_MLA>(A, (char*)lds_raw);
                } else {
                    if (tid < 128) { const float* rbias = gfp(a.in[oi(1)]); ((float*)(lds_raw + att::LDS_BIAS))[tid] = (rbias[a.bucket[tid] * 4 + hh] - rbias[31 * 4 + hh]) * LOG2E; }
                    __syncthreads();
                    att::AttnArgs A; A.K = nullptr; A.V = Hb + rb * HC + C_DV + hh * 128; A.P0 = qb * 256; A.Out = nullptr;
                    A.O0 = (float*)((bf16_t*)(c ? O1buf : O0buf) + rb * 512 + hh * 128);
                    A.Q = Hb + rb * HC + C_DQ + hh * 128 + c * 64; A.K2 = Hb + rb * HC + C_DK + hh * 128 + c * 64;
                    att::attn_block<false, 1, PIPE_DIFF>(A, (char*)lds_raw);
                    asm volatile("s_waitcnt vmcnt(0)" ::: "memory");
                    __syncthreads();
                    if (tid == 0) {
                        __builtin_amdgcn_fence(__ATOMIC_RELEASE, "agent"); asm volatile("s_waitcnt vmcnt(0)" ::: "memory");
                        const unsigned old_ = __hip_atomic_fetch_add(ctl + 1024 + l * 256 + bh * 16 + qb, 1u, __ATOMIC_RELAXED, __HIP_MEMORY_SCOPE_AGENT);
                        if (old_ == 1u) { __builtin_amdgcn_fence(__ATOMIC_ACQUIRE, "agent"); asm volatile("s_waitcnt vmcnt(0)" ::: "memory"); }
                        *qslot = (int)old_;
                    }
                    __syncthreads();
                    const int second = __builtin_amdgcn_readfirstlane(*qslot);
                    __syncthreads();
                    if (second == 1) {
                        FRESH_LANE(ln_);
                        const float* lp = gfp(a.in[oi(8)]) + (size_t)l * 256;
                        const float s1 = wave_sum(lp[ln_] * lp[64 + ln_]), s2 = wave_sum(lp[128 + ln_] * lp[192 + ln_]);
                        const float lam = __expf(s1) - __expf(s2) + a.lam_init[oi(l)];
                        const float osc = 1.0f - a.lam_init[oi(l)];
                        const float* dn = gfp(a.in[oi(9)]) + l * 128 + (ln_ & 15) * 8;
                        const f32x4 g0 = *(const f32x4*)dn * osc, g1 = *(const f32x4*)(dn + 4) * osc;
                        const size_t row0 = rb + (size_t)qb * 256 + wave * 32 + (ln_ >> 4);
#pragma unroll 2
                        for (int i = 0; i < 8; ++i) { const size_t m = row0 + 4 * i;
                            const u32x4 q0 = *(const u32x4*)((const bf16_t*)O0buf + m * 512 + hh * 128 + (ln_ & 15) * 8), q1 = *(const u32x4*)((const bf16_t*)O1buf + m * 512 + hh * 128 + (ln_ & 15) * 8);
#define BLO(w) __uint_as_float((w) << 16)
#define BHI(w) __uint_as_float((w) & 0xffff0000u)
                            const f32x4 d0 = (f32x4){BLO(q0.x), BHI(q0.x), BLO(q0.y), BHI(q0.y)} - (f32x4){BLO(q1.x), BHI(q1.x), BLO(q1.y), BHI(q1.y)} * lam;
                            const f32x4 d1 = (f32x4){BLO(q0.z), BHI(q0.z), BLO(q0.w), BHI(q0.w)} - (f32x4){BLO(q1.z), BHI(q1.z), BLO(q1.w), BHI(q1.w)} * lam;
#undef BLO
#undef BHI
                            float ss = (d0[0] * d0[0] + d0[1] * d0[1]) + (d0[2] * d0[2] + d0[3] * d0[3]) + (d1[0] * d1[0] + d1[1] * d1[1]) + (d1[2] * d1[2] + d1[3] * d1[3]);
                            ss += __shfl_xor(ss, 1); ss += __shfl_xor(ss, 2); ss += __shfl_xor(ss, 4); ss += __shfl_xor(ss, 8);
                            const float rs = __builtin_amdgcn_rsqf(ss * (1.0f / 128.0f) + 1e-5f);
                            pg8::store8(MRG + m * 1024 + 512 + hh * 128 + (ln_ & 15) * 8, d0 * rs * g0, d1 * rs * g1); }
                    }
                }
            }
        }
        PH_END()
        PH_BEGIN(4)
        { pg8::StaticOrder S; S.init(M, DM, G, obx());
          if (l == 0) { pg8::EpiY E{xres, Y, 1.0f}; pg8::gemm_phase(lds, MRG, DM, WoT + (size_t)l * DM * DM, DM, DM, S, E); }
          else { pg8::EpiYLN E{Y, ssq, gfp(a.in[oi(13)]) + (l - 1) * DM, gfp(a.in[oi(14)]) + (l - 1) * DM, 1.0f, 22};
                 pg8::gemm_phase(lds, MRG, DM, WoT + (size_t)l * DM * DM, DM, DM, S, E); } }
        PH_END()
        PH_BEGIN(5)
        { if (moe) ln_pass<0, true, true, true>(a, Y, nullptr, gfp(a.in[oi(11)]) + l * DM, gfp(a.in[oi(12)]) + l * DM, Xf, (bf16_t*)(ws + WS_XB8), gfp(a.in[oi(18)]) + (size_t)li * DM * 8, ctl + CW_CNT + 8 * li, gw, NGW, fresh_lane(), lds);
          else ln_pass<0, false, true, true>(a, Y, nullptr, gfp(a.in[oi(11)]) + l * DM, gfp(a.in[oi(12)]) + l * DM, Xf, (bf16_t*)(ws + WS_XB8), nullptr, nullptr, gw, NGW, fresh_lane(), lds);
          if (l == 2) cvt_moe(a, 1, scr, gw, NGW, fresh_lane()); }
        PH_END()
        if (!moe) {
            PH_BEGIN(6)
            { pg8::StaticOrder S; S.init(M, 2 * FFD, G, obx()); pg8::EpiSwiGLU8 E{(unsigned char*)ACT, FFD};
              pg8::gemm_phase<pg8::EpiSwiGLU8, pg8::StaticOrder, true>(lds, (const bf16_t*)(ws + WS_XB8), DM / 2, (const bf16_t*)((unsigned char*)WguT + (size_t)li * 2 * FFD * DM), DM / 2, DM / 2, S, E); }
            PH_END()
            PH_BEGIN(7)
            { pg8::StaticOrder S; S.init(M, DM, G, obx()); pg8::EpiYLN E{Y, ssq, gfp(a.in[oi(11)]) + l * DM, gfp(a.in[oi(12)]) + l * DM, 1.0f / (W8_D * A8_ACT), 20};
              pg8::gemm_phase<pg8::EpiYLN, pg8::StaticOrder, true>(lds, ACT, FFD / 2, (const bf16_t*)((unsigned char*)WdT + (size_t)li * DM * FFD), FFD / 2, FFD / 2, S, E); }
            PH_END()
            PH_BEGIN(8)
            { ln_pass<0, false, false, true>(a, Y, nullptr, gfp(a.in[oi(13)]) + l * DM, gfp(a.in[oi(14)]) + l * DM, nullptr, XB, nullptr, nullptr, gw, NGW, fresh_lane(), lds, nullptr, nullptr, 22); }
            PH_END()
        } else {
            unsigned* cnt = ctl + CW_CNT + 8 * li; unsigned* cur = ctl + CW_CUR + 8 * li;
            PH_BEGIN(9)
            {
                FRESH_LANE(lane_);
#define lane lane_
                int rbase[8]; { int acc = 0;
#pragma unroll
                    for (int e = 0; e < 8; ++e) { rbase[e] = acc * 256; acc += (__builtin_amdgcn_readfirstlane((int)__hip_atomic_load(cnt + e, __ATOMIC_RELAXED, __HIP_MEMORY_SCOPE_AGENT)) + 255) >> 8; } }
                const f32x4* route = (const f32x4*)(ws + WS_ROUTE); int* slots = (int*)(ws + WS_ROUTE + 512 * 1024);
                LAS unsigned* lc = (LAS unsigned*)(lds + 131072);
                unsigned long long pk = 0ull;
                for (int m = gw; m < M; m += NGW) { const f32x4 rt = route[m]; pk += (1ull << (8 * __float_as_int(rt[0]))) + (1ull << (8 * __float_as_int(rt[1]))); }
                if (lane < 8) lc[wave * 8 + lane] = (unsigned)((pk >> (8 * lane)) & 255ull);
                __syncthreads();
                if (wave == 0 && lane < 8) {
                    unsigned tot = 0u, pre[8];
#pragma unroll
                    for (int w = 0; w < 8; ++w) { pre[w] = tot; tot += lc[w * 8 + lane]; }
                    int rb = 0;
#pragma unroll
                    for (int e = 0; e < 8; ++e) if (e == lane) rb = rbase[e];
                    const unsigned base = atomicAdd(cur + lane, tot) + (unsigned)rb;
#pragma unroll
                    for (int w = 0; w < 8; ++w) lc[64 + w * 8 + lane] = base + pre[w];
                }
                __syncthreads();
                unsigned nb[8];
#pragma unroll
                for (int e = 0; e < 8; ++e) nb[e] = lc[64 + wave * 8 + e];
                for (int m = gw; m < M; m += NGW) {
                    const f32x4 rt = route[m]; const int e1 = __float_as_int(rt[0]), e2 = __float_as_int(rt[1]);
                    int s1 = 0, s2 = 0;
#pragma unroll
                    for (int e = 0; e < 8; ++e) { if (e == e1) { s1 = (int)nb[e]; nb[e]++; } if (e == e2) { s2 = (int)nb[e]; nb[e]++; } }
                    const u32x4 q = *((const u32x4*)((const unsigned char*)(ws + WS_XB8) + (size_t)m * DM) + lane);
                    *((u32x4*)((unsigned char*)XG + (size_t)s1 * DM) + lane) = q; *((u32x4*)((unsigned char*)XG + (size_t)s2 * DM) + lane) = q;
                    if (lane == 0) { slots[2 * m] = s1; slots[2 * m + 1] = s2; }
                }
#undef lane
            }
            PH_END()
            pg8::MoeOrder MO; { int t[8], tot = 0;
#pragma unroll
                for (int e = 0; e < 8; ++e) { t[e] = (__builtin_amdgcn_readfirstlane((int)__hip_atomic_load(cnt + e, __ATOMIC_RELAXED, __HIP_MEMORY_SCOPE_AGENT)) + 255) >> 8; tot += t[e]; }
                MO.t0 = t[0]; MO.t1 = t[1]; MO.t2 = t[2]; MO.t3 = t[3]; MO.t4 = t[4]; MO.t5 = t[5]; MO.t6 = t[6]; MO.t7 = t[7]; MO.G = G; MO.c = bx; MO.NT = 0; MO.total = tot; MO.ks = 1; MO.kh = 0; }
            PH_BEGIN(10)
            { pg8::MoeOrder S = MO; S.NT = 2 * FFE / 256; S.total = MO.total * S.NT; pg8::EpiSwiGLU8 E{(unsigned char*)MACT, FFE};
              pg8::gemm_phase<pg8::EpiSwiGLU8, pg8::MoeOrder, true>(lds, XG, DM / 2, MguT, DM / 2, DM / 2, S, E); }
            PH_END()
            PH_BEGIN(11)
            { pg8::MoeOrder S = MO; S.NT = DM / 256; S.ks = 2; S.kh = FFE / 4; S.total = MO.total * S.NT * 2; pg8::EpiF8 E{(unsigned char*)OSLOT, DM, (size_t)(WS_OSLOT2 - WS_OSLOT), O8 / (W8_D * A8_ACT)};
              pg8::gemm_phase<pg8::EpiF8, pg8::MoeOrder, true>(lds, MACT, FFE / 2, MdT, FFE / 2, FFE / 4, S, E); }
            PH_END()
            PH_BEGIN(12)
            { if (l == DEPTH - 1) ln_pass<1, false>(a, Y, nullptr, gfp(a.in[oi(13)]) + l * DM, gfp(a.in[oi(14)]) + l * DM, a.out + oz(), nullptr, nullptr, nullptr, gw, NGW, fresh_lane(), lds, gfp(a.in[oi(11)]) + l * DM, gfp(a.in[oi(12)]) + l * DM);
              else ln_pass<1, false, false, true, true>(a, Y, nullptr, gfp(a.in[oi(13)]) + l * DM, gfp(a.in[oi(14)]) + l * DM, nullptr, XB, nullptr, nullptr, gw, NGW, fresh_lane(), lds, gfp(a.in[oi(11)]) + l * DM, gfp(a.in[oi(12)]) + l * DM, 22); }
            PH_END()
        }
    }
#undef PH_BEGIN
#undef PH_END
}
#undef ws
#undef ctl
#undef tab
#undef ssq
#undef sskv
#undef Y
#undef XB
#undef Xf
constexpr int N_PHASES = 1 + 2 * 8 + 2 * 9;

extern "C" void kernel_launch(void* const* d_in, const int* in_sizes, int n_in, void* d_out, int out_size, void* d_ws, size_t ws_size, hipStream_t stream) {
    static int grid = 0;
    if (grid == 0) {
        if (n_in != 22 || in_sizes[0] != M * DM || out_size != M * DM || ws_size < WS_END) { fprintf(stderr, "kernel_launch: unexpected shapes (n_in %d, ws %zu)\n", n_in, ws_size); grid = -1; return; }
        int dev = 0, cus = 0, per_cu = 0;
        (void)hipGetDevice(&dev); (void)hipDeviceGetAttribute(&cus, hipDeviceAttributeMultiprocessorCount, dev);
        if (hipFuncSetAttribute((const void*)mega_fwd, hipFuncAttributeMaxDynamicSharedMemorySize, LDS_BYTES) != hipSuccess) { fprintf(stderr, "kernel_launch: hipFuncSetAttribute failed\n"); grid = -1; return; }
        if (hipOccupancyMaxActiveBlocksPerMultiprocessor(&per_cu, (const void*)mega_fwd, 512, LDS_BYTES) != hipSuccess || per_cu < 1) { fprintf(stderr, "kernel_launch: occupancy query says %d\n", per_cu); per_cu = 1; }
        (void)hipGetLastError();
        grid = cus * 1;
        if (grid <= 0) grid = 256;
    }
    if (grid < 0) return;
    (void)hipMemsetAsync((char*)d_ws + WS_CTL, 0, 1 * MiB, stream);
    Args a{};
    for (int i = 0; i < 22; ++i) a.in[i] = (const float*)d_in[i];
    a.out = (float*)d_out; a.ws = (unsigned char*)d_ws;
    for (int i = 0; i < 32; ++i) a.inv[i] = 1.0f / powf(10000.0f, (float)(2 * i) / 64.0f);
    for (int l = 0; l < 4; ++l) a.lam_init[l] = (float)(0.8 - 0.6 * exp(-0.3 * (double)l));
    for (int n = 0; n < 128; ++n) { int bkt;
        if (n < 16) bkt = n; else { const float nf = (float)n; const float v = logf(nf / 16.0f) / (float)log(8.0) * 16.0f; bkt = 16 + (int)v; if (bkt > 31) bkt = 31; }
        a.bucket[n] = (unsigned char)bkt; }
    {
        int di = 15, mi = 15;
        for (int e = 0; e < 32; ++e) { const float dc = di >= 0 ? 4.0f * (di + 1) : -1.f, mc = mi >= 0 ? 2.8f * (mi + 1) : -1.f;
            if (dc >= mc) { a.aq[e] = (unsigned short)((1 << 8) | di); --di; } else { a.aq[e] = (unsigned short)mi; --mi; } }
    }
#if MK_SPLIT
    for (int p = 0; p < N_PHASES; ++p) { a.ph_lo = p; a.ph_hi = p + 1; hipLaunchKernelGGL(mega_fwd, dim3(grid), dim3(512), LDS_BYTES, stream, a); }
#else
    a.ph_lo = 0; a.ph_hi = N_PHASES;
    void* args[] = {&a};
    hipError_t e = hipLaunchCooperativeKernel((const void*)mega_fwd, dim3(grid), dim3(512), args, LDS_BYTES, stream);
    if (e != hipSuccess) fprintf(stderr, "cooperative launch failed: %s (grid %d)\n", hipGetErrorString(e), grid);
#endif
}
```

```cpp
#include <hip/hip_runtime.h>
#include <hip/hip_cooperative_groups.h>
#include <cstdint>
#include <cstdio>
#include <cmath>
namespace cg = cooperative_groups;

#ifndef PIPE_MLA
#define PIPE_MLA true
#endif
#ifndef PIPE_DIFF
#define PIPE_DIFF true
#endif
#ifndef MK_SPLIT
#define MK_SPLIT 0
#endif

#define LAS __attribute__((address_space(3)))
typedef unsigned short bf16_t;
typedef short bf16x8 __attribute__((ext_vector_type(8)));
typedef short s16x4 __attribute__((ext_vector_type(4)));
typedef float f32x2 __attribute__((ext_vector_type(2)));
typedef float f32x4 __attribute__((ext_vector_type(4)));
typedef float f32x16 __attribute__((ext_vector_type(16)));
typedef unsigned u32x2 __attribute__((ext_vector_type(2)));
typedef unsigned u32x4 __attribute__((ext_vector_type(4)));
typedef int i32x4 __attribute__((ext_vector_type(4)));
typedef int i32x8 __attribute__((ext_vector_type(8)));

constexpr int M = 16384, DM = 1024, SEQ = 4096, DEPTH = 4;
constexpr int HC = 2304;
constexpr int QMC = 768, KVC = 1024;
constexpr int FFD = 2816, FFE = 3584, NEXP = 8;
constexpr int SLOTS = 32768 + 8 * 256;
constexpr float LOG2E = 1.4426950408889634f;
constexpr float DN_ALPHA = 1.681792830507429f;
constexpr int C_CQ = 0, C_CKV = 384, C_KR = 640, C_DQ = 704, C_DK = 1216, C_DV = 1728;

constexpr size_t MiB = 1u << 20;
constexpr size_t WS_CTL = 0, WS_TAB = 1 * MiB, WS_SS = 2 * MiB;
constexpr size_t WS_WIN = 4 * MiB, WS_WUQ = 22 * MiB, WS_WUKV = 25 * MiB, WS_WO = 27 * MiB, WS_WGU = 35 * MiB, WS_WD = 57 * MiB;
constexpr size_t WS_MGU = 68 * MiB, WS_MD = 180 * MiB;
constexpr size_t WS_X = 236 * MiB, WS_XB = 300 * MiB, WS_Y = 332 * MiB, WS_OV = 396 * MiB;
constexpr size_t WS_H = WS_OV, WS_QM = WS_OV + 72 * MiB, WS_KVB = WS_OV + 96 * MiB, WS_MRG = WS_OV + 128 * MiB, WS_O0 = WS_OV + 160 * MiB;
constexpr size_t WS_ACT = WS_OV;
constexpr size_t WS_XG = WS_OV, WS_MACT = WS_OV + 68 * MiB, WS_OSLOT = WS_OV + 306 * MiB;
constexpr size_t WS_ROUTE = WS_OV + 374 * MiB;
constexpr size_t WS_OSLOT2 = WS_OV + 376 * MiB;
constexpr size_t WS_XB8 = WS_OV + 444 * MiB;
constexpr size_t WS_END = WS_OV + 460 * MiB;
constexpr int CW_CNT = 0, CW_CUR = 64;

constexpr int LDS_BYTES = 147456;
constexpr float W8_GU = 64.0f, W8_D = 128.0f, A8_ACT = 8.0f, O8 = 64.0f;

__device__ __forceinline__ unsigned cvt_pk_bf16(float lo, float hi) { unsigned r; asm volatile("v_cvt_pk_bf16_f32 %0, %1, %2" : "=v"(r) : "v"(lo), "v"(hi)); return r; }
__device__ __forceinline__ i32x8 cat8(bf16x8 a, bf16x8 b) { const i32x4 x = __builtin_bit_cast(i32x4, a), y = __builtin_bit_cast(i32x4, b); return __builtin_shufflevector(x, y, 0, 1, 2, 3, 4, 5, 6, 7); }
__device__ __forceinline__ bf16x8 lo8(i32x8 v) { return __builtin_bit_cast(bf16x8, __builtin_shufflevector(v, v, 0, 1, 2, 3)); }
__device__ __forceinline__ bf16x8 hi8(i32x8 v) { return __builtin_bit_cast(bf16x8, __builtin_shufflevector(v, v, 4, 5, 6, 7)); }
__device__ __forceinline__ unsigned cvt4_fp8(float a, float b, float c, float d) { unsigned w = __builtin_amdgcn_cvt_pk_fp8_f32(a, b, 0u, false); return (unsigned)__builtin_amdgcn_cvt_pk_fp8_f32(c, d, (int)w, true); }
typedef _Float16 ystream_t;
typedef _Float16 h16x4 __attribute__((ext_vector_type(4)));
__device__ __forceinline__ f32x4 ld4h(const ystream_t* p) { return __builtin_convertvector(*(const h16x4*)p, f32x4); }
__device__ __forceinline__ void st4h(ystream_t* p, f32x4 v) { *(h16x4*)p = __builtin_convertvector(v, h16x4); }
__device__ __forceinline__ float bf2f(unsigned short b) { return __uint_as_float(((unsigned)b) << 16); }
__device__ __forceinline__ float wave_sum(float v) {
#pragma unroll
    for (int o = 1; o < 64; o <<= 1) v += __shfl_xor(v, o);
    return v;
}
__device__ __forceinline__ int fresh_lane() { int t = threadIdx.x; asm volatile("" : "+v"(t)); return t & 63; }
__device__ __forceinline__ int obx() { int b = blockIdx.x; asm volatile("" : "+s"(b)); return b; }
__device__ __forceinline__ int oi(int k) { asm volatile("" : "+s"(k)); return k; }
typedef __attribute__((address_space(1))) unsigned char* gptr_t;
typedef __attribute__((address_space(1))) const float* gfptr_t;
#if defined(__HIP_DEVICE_COMPILE__)
#define ASSUME_GLOBAL(p) __builtin_assume(!__builtin_amdgcn_is_shared((const __attribute__((address_space(0))) void*)(p)) && !__builtin_amdgcn_is_private((const __attribute__((address_space(0))) void*)(p)))
#else
#define ASSUME_GLOBAL(p) ((void)0)
#endif
__device__ __forceinline__ size_t oz() { size_t z = 0; asm volatile("" : "+s"(z)); return z; }
#define opq(p) ((p) + oz())
__device__ __forceinline__ const float* gfp(const float* p) { ASSUME_GLOBAL(p); return p; }
#define LDS_WAIT() asm volatile("s_waitcnt lgkmcnt(0)" ::: "memory")
#define VM_WAIT() asm volatile("s_waitcnt vmcnt(0)" ::: "memory")

namespace pg8 {
constexpr int BM = 256, BK = 64, HALF = 128, HTB = HALF * BK * 2, NXCD = 8, WGM = 8;
__host__ __device__ __forceinline__ int lds_byte(int r, int c) { const int st = (r >> 4) * 2 + (c >> 5), rr = r & 15, cc = c & 31, ob = rr * 64 + cc * 2; return st * 1024 + (ob ^ (((ob >> 9) & 1) << 5)); }
__host__ __device__ __forceinline__ void stage_rc(int b, int& R, int& C) { const int st = b / 1024, sb = b % 1024, swz = sb ^ (((sb >> 9) & 1) << 5); R = (st >> 1) * 16 + swz / 64; C = (st & 1) * 32 + (swz % 64) / 2; }
__host__ __device__ __forceinline__ int perm32(int rho) { const int n = rho >> 4, i = rho & 15; return 8 * (i >> 2) + 4 * n + (i & 3); }

struct Unit { int pm, pn, bt, ko, os; };

struct StaticOrder {
    int nM, nN, nwg, G, c;
    __device__ __forceinline__ void init(int Mr, int N, int G_, int c_) { nM = Mr / BM; nN = N / BM; nwg = nM * nN; G = G_; c = c_; }
    __device__ __forceinline__ bool next(int i, Unit& u) const {
        const long L = (long)i * G + c; if (L >= nwg) return false;
        int wgid = (int)L; { const int q = nwg / NXCD, r = nwg % NXCD, xcd = wgid % NXCD, off = wgid / NXCD; wgid = (xcd < r ? xcd * (q + 1) : r * (q + 1) + (xcd - r) * q) + off; }
        const int nig = WGM * nN, gid = wgid / nig, fm = gid * WGM, gsz = (nM - fm) < WGM ? (nM - fm) : WGM;
        u.pm = fm + ((wgid % nig) % gsz); u.pn = (wgid % nig) / gsz; u.bt = u.pn; u.ko = 0; u.os = 0; return true;
    }
};
struct OneUnit {
    int pm, pn; bool valid;
    __device__ __forceinline__ bool next(int i, Unit& u) const { if (i != 0 || !valid) return false; u.pm = pm; u.pn = pn; u.bt = pn; u.ko = 0; u.os = 0; return true; }
};
struct MoeOrder {
    int t0, t1, t2, t3, t4, t5, t6, t7; int NT, G, c, total, ks, kh;
    __device__ __forceinline__ bool next(int i, Unit& u) const {
        const int cc = (G % 8 == 0) ? (c % 8) * (G / 8) + c / 8 : c;
        const long L = (long)i * G + cc; if (L >= total) return false;
        int acc = 0, e = 0, base = 0, te = 1;
#define MO_STEP(j, tj) { if (tj > 0 && L >= (long)acc * NT * ks) { e = j; base = acc; te = tj; } acc += tj; }
        MO_STEP(0, t0) MO_STEP(1, t1) MO_STEP(2, t2) MO_STEP(3, t3) MO_STEP(4, t4) MO_STEP(5, t5) MO_STEP(6, t6) MO_STEP(7, t7)
#undef MO_STEP
        const int loc = (int)(L - (long)base * NT * ks), sp = loc % ks, rest = loc / ks;
        u.pm = base + rest % te; u.pn = rest / te; u.bt = e * NT + u.pn; u.ko = sp * kh; u.os = sp; return true;
    }
};

template <class Epi, class Sched, bool F8 = false>
__device__ __forceinline__ void gemm_phase(LAS unsigned char* lds, const bf16_t* Ag, int lda, const bf16_t* Btg, int ldb, int K, const Sched& S, const Epi& E) {
    asm volatile("" : "+s"(K));
    int tid_ = threadIdx.x; asm volatile("" : "+v"(tid_));
    const int tid = tid_, wid = __builtin_amdgcn_readfirstlane(tid >> 6), lane = tid & 63, wr = wid >> 2, wc = wid & 3, fr = lane & 15, fq = lane >> 4;
    const int nt = K / BK;
    unsigned voffA[2], voffB[2];
#pragma unroll
    for (int i = 0; i < 2; ++i) { int R, C; stage_rc(tid * 16 + i * 8192, R, C); const int Rb = Epi::PERM ? ((R & ~31) + perm32(R & 31)) : R;
        voffA[i] = (unsigned)(R * lda + C) * 2u; voffB[i] = (unsigned)(Rb * ldb + C) * 2u; }
    const size_t kstep = (size_t)(BK * 2);
    const size_t hstepA = (size_t)HALF * lda * 2, hstepB = (size_t)HALF * ldb * 2;
    const size_t tstepA = 2 * hstepA, tstepB = 2 * hstepB;
    const unsigned ldsw = (unsigned)wid * 1024u;
    const int aoff = lds_byte(wr * 64 + fr, fq * 8), boff = lds_byte(wc * 32 + fr, fq * 8);
#define PG8_SA(b, h) (((b) * 2 + (h)) * HTB)
#define PG8_SB(b, h) ((4 + (b) * 2 + (h)) * HTB)
#define PG8_STAGE(bufoff, gbase, voff) do { _Pragma("unroll") for (int _i = 0; _i < 2; ++_i) \
        __builtin_amdgcn_global_load_lds((const unsigned*)((const char*)(gbase) + (voff)[_i]), (LAS unsigned*)(lds + (bufoff) + ldsw + _i * 8192), 16, 0, 0); } while (0)
#define PG8_LDA(dst, b, h) do { _Pragma("unroll") for (int m = 0; m < 4; ++m) dst[m] = cat8(*(const LAS bf16x8*)(lds + PG8_SA(b, h) + aoff + m * 2048), *(const LAS bf16x8*)(lds + PG8_SA(b, h) + aoff + m * 2048 + 1024)); } while (0)
#define PG8_LDB(dst, b, h) do { _Pragma("unroll") for (int n = 0; n < 2; ++n) dst[n] = cat8(*(const LAS bf16x8*)(lds + PG8_SB(b, h) + boff + n * 2048), *(const LAS bf16x8*)(lds + PG8_SB(b, h) + boff + n * 2048 + 1024)); } while (0)
#define PG8_MMA(ai, bj, At, Bt) do { __builtin_amdgcn_s_setprio(1); _Pragma("unroll") for (int m = 0; m < 4; ++m) _Pragma("unroll") for (int n = 0; n < 2; ++n) { \
        if constexpr (F8) asm volatile("v_mfma_f32_16x16x128_f8f6f4 %0, %1, %2, %0" : "+v"(acc[ai][bj][m][n]) : "v"(Bt[n]), "v"(At[m]));   \
        else { acc[ai][bj][m][n] = __builtin_amdgcn_mfma_f32_16x16x32_bf16(lo8(Bt[n]), lo8(At[m]), acc[ai][bj][m][n], 0, 0, 0); \
               acc[ai][bj][m][n] = __builtin_amdgcn_mfma_f32_16x16x32_bf16(hi8(Bt[n]), hi8(At[m]), acc[ai][bj][m][n], 0, 0, 0); } } \
        __builtin_amdgcn_s_setprio(0); } while (0)
#define PG8_WAIT_V(n) asm volatile("s_waitcnt vmcnt(" #n ")" ::: "memory")
#define PG8_WAIT_L(n) asm volatile("s_waitcnt lgkmcnt(" #n ")" ::: "memory")
#define PG8_BAR __builtin_amdgcn_s_barrier()
#define PG8_SCHED __builtin_amdgcn_sched_barrier(0)
    Unit cur, nxt; int ui = 0;
    if (!S.next(0, cur)) return;
    f32x4 acc[2][2][4][2];
#pragma unroll
    for (int a = 0; a < 2; ++a)
#pragma unroll
        for (int b = 0; b < 2; ++b)
#pragma unroll
            for (int m = 0; m < 4; ++m)
#pragma unroll
                for (int n = 0; n < 2; ++n) acc[a][b][m][n] = (f32x4){0.f, 0.f, 0.f, 0.f};
    i32x8 At[4], B0[2], B1[2];
    const char* cA = (const char*)Ag + (size_t)cur.pm * tstepA + (size_t)cur.ko * 2; const char* cB = (const char*)Btg + (size_t)cur.bt * tstepB + (size_t)cur.ko * 2;
    PG8_STAGE(PG8_SB(0, 0), cB, voffB); PG8_STAGE(PG8_SB(0, 1), cB + hstepB, voffB); PG8_STAGE(PG8_SA(0, 0), cA, voffA); PG8_STAGE(PG8_SA(0, 1), cA + hstepA, voffA);
    if (wr == 1) PG8_BAR;
    PG8_WAIT_V(2); PG8_BAR;
    PG8_STAGE(PG8_SB(1, 0), cB + kstep, voffB); PG8_STAGE(PG8_SA(1, 0), cA + kstep, voffA); PG8_STAGE(PG8_SB(1, 1), cB + hstepB + kstep, voffB);
    PG8_WAIT_V(6); PG8_BAR;
    for (;;) {
        const bool has_next = S.next(ui + 1, nxt);
        const char* nA = has_next ? (const char*)Ag + (size_t)nxt.pm * tstepA + (size_t)nxt.ko * 2 : cA; const char* nB = has_next ? (const char*)Btg + (size_t)nxt.bt * tstepB + (size_t)nxt.ko * 2 : cB;
        for (int t = 0; t < nt; t += 2) {
            const bool last = (t == nt - 2);
            const char* a1 = cA + (size_t)(t + 1) * kstep;
            const char* a2 = last ? nA : cA + (size_t)(t + 2) * kstep; const char* b2 = last ? nB : cB + (size_t)(t + 2) * kstep;
            const char* a3 = a2 + kstep; const char* b3 = b2 + kstep;
            PG8_LDB(B0, 0, 0); PG8_LDB(B1, 0, 1); PG8_SCHED; PG8_LDA(At, 0, 0); PG8_STAGE(PG8_SA(1, 1), a1 + hstepA, voffA);
            PG8_WAIT_V(8); PG8_WAIT_L(0); PG8_BAR; PG8_MMA(0, 0, At, B0); PG8_MMA(0, 1, At, B1); PG8_BAR; PG8_SCHED;
            PG8_LDA(At, 0, 1); PG8_STAGE(PG8_SB(0, 0), b2, voffB); PG8_STAGE(PG8_SB(0, 1), b2 + hstepB, voffB); PG8_STAGE(PG8_SA(0, 0), a2, voffA);
            PG8_WAIT_V(8); PG8_WAIT_L(0); PG8_BAR; PG8_MMA(1, 0, At, B0); PG8_MMA(1, 1, At, B1); PG8_BAR; PG8_SCHED;
            PG8_LDB(B0, 1, 0); PG8_LDB(B1, 1, 1); PG8_SCHED; PG8_LDA(At, 1, 0); PG8_STAGE(PG8_SA(0, 1), a2 + hstepA, voffA);
            PG8_WAIT_V(8); PG8_WAIT_L(0); PG8_BAR; PG8_MMA(0, 0, At, B0); PG8_MMA(0, 1, At, B1); PG8_BAR; PG8_SCHED;
            PG8_LDA(At, 1, 1); PG8_STAGE(PG8_SB(1, 0), b3, voffB); PG8_STAGE(PG8_SB(1, 1), b3 + hstepB, voffB); PG8_STAGE(PG8_SA(1, 0), a3, voffA);
            PG8_WAIT_V(8); PG8_WAIT_L(0); PG8_BAR; PG8_MMA(1, 0, At, B0); PG8_MMA(1, 1, At, B1); PG8_BAR; PG8_SCHED;
        }
        if (wr == 0) PG8_BAR;
        if constexpr (F8) asm volatile("s_nop 15\n\ts_nop 15\n\ts_nop 15" ::: "memory");
        E(acc, cur, wr, wc, fr, fq);
        if (!has_next) break;
#pragma unroll
        for (int a = 0; a < 2; ++a)
#pragma unroll
            for (int b = 0; b < 2; ++b)
#pragma unroll
                for (int m = 0; m < 4; ++m)
#pragma unroll
                    for (int n = 0; n < 2; ++n) acc[a][b][m][n] = (f32x4){0.f, 0.f, 0.f, 0.f};
        cur = nxt; cA = nA; cB = nB; ++ui;
        if (wr == 1) PG8_BAR;
    }
    PG8_WAIT_V(0);
    PG8_BAR;
#undef PG8_SA
#undef PG8_SB
#undef PG8_STAGE
#undef PG8_LDA
#undef PG8_LDB
#undef PG8_MMA
#undef PG8_WAIT_V
#undef PG8_WAIT_L
#undef PG8_BAR
#undef PG8_SCHED
}

__device__ __forceinline__ void store8(bf16_t* p, f32x4 v0, f32x4 v1) {
    u32x4 w; w.x = cvt_pk_bf16(v0[0], v0[1]); w.y = cvt_pk_bf16(v0[2], v0[3]); w.z = cvt_pk_bf16(v1[0], v1[1]); w.w = cvt_pk_bf16(v1[2], v1[3]);
    *(u32x4*)p = w;
}
__device__ __forceinline__ void rope8(f32x4& v0, f32x4& v1, const float* cs) {
    const f32x4 c0 = *(const f32x4*)cs, c1 = *(const f32x4*)(cs + 4);
    f32x4 o0, o1;
    o0[0] = v0[0] * c0[0] - v0[1] * c0[1]; o0[1] = v0[1] * c0[0] + v0[0] * c0[1];
    o0[2] = v0[2] * c0[2] - v0[3] * c0[3]; o0[3] = v0[3] * c0[2] + v0[2] * c0[3];
    o1[0] = v1[0] * c1[0] - v1[1] * c1[1]; o1[1] = v1[1] * c1[0] + v1[0] * c1[1];
    o1[2] = v1[2] * c1[2] - v1[3] * c1[3]; o1[3] = v1[3] * c1[2] + v1[2] * c1[3];
    v0 = o0; v1 = o1;
}
struct EpiH {
    static constexpr bool PERM = true;
    bf16_t* H; float* ssq; float* sskv; const float* tab;
    __device__ __forceinline__ void operator()(const f32x4 (&acc)[2][2][4][2], const Unit& u, int wr, int wc, int fr, int fq) const {
        const int row0 = u.pm * BM + wr * 64 + fr;
#pragma unroll
        for (int bj = 0; bj < 2; ++bj) {
            const int g32 = u.pn * BM + bj * HALF + wc * 32, col0 = g32 + 8 * fq;
            const int seg = g32 < C_CKV ? 0 : (g32 < C_KR ? 1 : (g32 < C_DQ ? 2 : 3));
#pragma unroll
            for (int ai = 0; ai < 2; ++ai)
#pragma unroll
                for (int m = 0; m < 4; ++m) {
                    const int row = row0 + ai * HALF + m * 16;
                    f32x4 v0 = acc[ai][bj][m][0], v1 = acc[ai][bj][m][1];
                    if (seg < 2) {
                        float s = (v0[0] * v0[0] + v0[1] * v0[1]) + (v0[2] * v0[2] + v0[3] * v0[3]) + (v1[0] * v1[0] + v1[1] * v1[1]) + (v1[2] * v1[2] + v1[3] * v1[3]);
                        s += __shfl_xor(s, 16); s += __shfl_xor(s, 32);
                        if (fq == 0) ssq[(size_t)row * 32 + (g32 >> 5)] = s;
                    } else if (seg == 2) {
                        rope8(v0, v1, tab + (size_t)(row & (SEQ - 1)) * 64 + (col0 - C_KR));
                    }
                    store8(H + (size_t)row * HC + col0, v0, v1);
                    asm volatile("" ::: "memory");
                }
        }
    }
};
struct EpiQ {
    static constexpr bool PERM = true;
    bf16_t* Q; const float* ssq; const float* tab;
    __device__ __forceinline__ void operator()(const f32x4 (&acc)[2][2][4][2], const Unit& u, int wr, int wc, int fr, int fq) const {
        const int row0 = u.pm * BM + wr * 64 + fr;
#pragma unroll
        for (int ai = 0; ai < 2; ++ai)
#pragma unroll
            for (int m = 0; m < 4; ++m) {
                const int row = row0 + ai * HALF + m * 16;
                const f32x4 q0 = *(const f32x4*)(ssq + (size_t)row * 32), q1 = *(const f32x4*)(ssq + (size_t)row * 32 + 4), q2 = *(const f32x4*)(ssq + (size_t)row * 32 + 8);
                const float rs = __builtin_amdgcn_rsqf((((q0[0] + q0[1]) + (q0[2] + q0[3])) + ((q1[0] + q1[1]) + (q1[2] + q1[3])) + ((q2[0] + q2[1]) + (q2[2] + q2[3]))) * (1.0f / 384.0f) + 1e-6f);
#pragma unroll
                for (int bj = 0; bj < 2; ++bj) {
                    const int g32 = u.pn * BM + bj * HALF + wc * 32, col0 = g32 + 8 * fq;
                    const int inh = g32 % 192;
                    f32x4 v0 = acc[ai][bj][m][0] * rs, v1 = acc[ai][bj][m][1] * rs;
                    if (inh >= 128) rope8(v0, v1, tab + (size_t)(row & (SEQ - 1)) * 64 + (inh - 128 + 8 * fq));
                    store8(Q + (size_t)row * QMC + col0, v0, v1);
                }
                asm volatile("" ::: "memory");
            }
    }
};
struct EpiKV {
    static constexpr bool PERM = true;
    bf16_t* O; const float* sskv;
    __device__ __forceinline__ void operator()(const f32x4 (&acc)[2][2][4][2], const Unit& u, int wr, int wc, int fr, int fq) const {
        const int row0 = u.pm * BM + wr * 64 + fr;
#pragma unroll
        for (int ai = 0; ai < 2; ++ai)
#pragma unroll
            for (int m = 0; m < 4; ++m) {
                const int row = row0 + ai * HALF + m * 16;
                const f32x4 q0 = *(const f32x4*)(sskv + (size_t)row * 32 + 12), q1 = *(const f32x4*)(sskv + (size_t)row * 32 + 16);
                const float rs = __builtin_amdgcn_rsqf((((q0[0] + q0[1]) + (q0[2] + q0[3])) + ((q1[0] + q1[1]) + (q1[2] + q1[3]))) * (1.0f / 256.0f) + 1e-6f);
#pragma unroll
                for (int bj = 0; bj < 2; ++bj) {
                    const int col0 = u.pn * BM + bj * HALF + wc * 32 + 8 * fq;
                    store8(O + (size_t)row * KVC + col0, acc[ai][bj][m][0] * rs, acc[ai][bj][m][1] * rs);
                }
            }
    }
};
struct EpiY {
    static constexpr bool PERM = false;
    const float* X; ystream_t* Y; float asc;
    __device__ __forceinline__ void operator()(const f32x4 (&acc)[2][2][4][2], const Unit& u, int wr, int wc, int fr, int fq) const {
        const int row0 = u.pm * BM + wr * 64 + fr, colb = u.pn * BM + wc * 32 + 4 * fq;
#pragma unroll
        for (int ai = 0; ai < 2; ++ai)
#pragma unroll
            for (int m = 0; m < 4; ++m) {
                const size_t off = (size_t)(row0 + ai * HALF + m * 16) * DM + colb;
#pragma unroll
                for (int bj = 0; bj < 2; ++bj)
#pragma unroll
                    for (int n = 0; n < 2; ++n) { const f32x4 xv = *(const f32x4*)(X + off + bj * HALF + n * 16); st4h(Y + off + bj * HALF + n * 16, xv * DN_ALPHA + acc[ai][bj][m][n] * asc); }
            }
    }
};
struct EpiYLN {
    static constexpr bool PERM = false;
    ystream_t* Y; const float* st; const float* g; const float* b; float asc; int so;
    __device__ __forceinline__ void operator()(const f32x4 (&acc)[2][2][4][2], const Unit& u, int wr, int wc, int fr, int fq) const {
        const int row0 = u.pm * BM + wr * 64 + fr, colb = u.pn * BM + wc * 32 + 4 * fq;
#pragma unroll
        for (int ai = 0; ai < 2; ++ai)
#pragma unroll
            for (int m = 0; m < 4; ++m) {
                const int row = row0 + ai * HALF + m * 16;
                const float mu = st[(size_t)row * 32 + so], rs = st[(size_t)row * 32 + so + 1];
                const size_t off = (size_t)row * DM + colb;
#pragma unroll
                for (int bj = 0; bj < 2; ++bj)
#pragma unroll
                    for (int n = 0; n < 2; ++n) { const int c = colb + bj * HALF + n * 16;
                        const f32x4 gv = *(const f32x4*)(g + c), bv = *(const f32x4*)(b + c), yv = ld4h(Y + off + bj * HALF + n * 16);
                        st4h(Y + off + bj * HALF + n * 16, ((yv - mu) * rs * gv + bv) * DN_ALPHA + acc[ai][bj][m][n] * asc); }
                asm volatile("" ::: "memory");
            }
    }
};
struct EpiSwiGLU {
    static constexpr bool PERM = true;
    bf16_t* O; int ldo;
    __device__ __forceinline__ void operator()(const f32x4 (&acc)[2][2][4][2], const Unit& u, int wr, int wc, int fr, int fq) const {
        const int row0 = u.pm * BM + wr * 64 + fr, col0 = u.pn * HALF + wc * 32 + 8 * fq;
#pragma unroll
        for (int ai = 0; ai < 2; ++ai)
#pragma unroll
            for (int m = 0; m < 4; ++m) {
                f32x4 r[2];
#pragma unroll
                for (int n = 0; n < 2; ++n) { const f32x4 g = acc[ai][0][m][n], up = acc[ai][1][m][n];
#pragma unroll
                    for (int j = 0; j < 4; ++j) { const float e = __builtin_amdgcn_exp2f(-g[j] * LOG2E); r[n][j] = g[j] * __builtin_amdgcn_rcpf(1.0f + e) * up[j]; } }
                store8(O + (size_t)(row0 + ai * HALF + m * 16) * ldo + col0, r[0], r[1]);
            }
    }
};
struct EpiSwiGLU8 {
    static constexpr bool PERM = true;
    unsigned char* O; int ldo;
    __device__ __forceinline__ u32x2 act8(const f32x4 (&acc)[2][2][4][2], int ai, int m) const {
        f32x4 r[2];
#pragma unroll
        for (int n = 0; n < 2; ++n) { const f32x4 g = acc[ai][0][m][n] * (1.0f / W8_GU), up = acc[ai][1][m][n] * (A8_ACT / W8_GU);
#pragma unroll
            for (int j = 0; j < 4; ++j) { const float e = __builtin_amdgcn_exp2f(-g[j] * LOG2E); r[n][j] = g[j] * __builtin_amdgcn_rcpf(1.0f + e) * up[j]; } }
        u32x2 w; w.x = cvt4_fp8(r[0][0], r[0][1], r[0][2], r[0][3]); w.y = cvt4_fp8(r[1][0], r[1][1], r[1][2], r[1][3]); return w;
    }
    __device__ __forceinline__ void operator()(const f32x4 (&acc)[2][2][4][2], const Unit& u, int wr, int wc, int fr, int fq) const {
        const int row0 = u.pm * BM + wr * 64 + fr, colp = u.pn * HALF + wc * 32 + 16 * (fq >> 1);
#pragma unroll
        for (int ai = 0; ai < 2; ++ai)
#pragma unroll
            for (int mp = 0; mp < 2; ++mp) {
                const u32x2 wa = act8(acc, ai, 2 * mp), wb = act8(acc, ai, 2 * mp + 1);
                const auto sx = __builtin_amdgcn_permlane16_swap(wa.x, wb.x, false, false);
                const auto sy = __builtin_amdgcn_permlane16_swap(wa.y, wb.y, false, false);
                u32x4 o; o.x = sx[0]; o.y = sy[0]; o.z = sx[1]; o.w = sy[1];
                const int m = 2 * mp + (fq & 1);
                *(u32x4*)(O + (size_t)(row0 + ai * HALF + m * 16) * ldo + colp) = o;
            }
    }
};
struct EpiBf16 {
    static constexpr bool PERM = true;
    bf16_t* O; int ldo; size_t sstride; float osc;
    __device__ __forceinline__ void operator()(const f32x4 (&acc)[2][2][4][2], const Unit& u, int wr, int wc, int fr, int fq) const {
        const int row0 = u.pm * BM + wr * 64 + fr;
#pragma unroll
        for (int ai = 0; ai < 2; ++ai)
#pragma unroll
            for (int m = 0; m < 4; ++m)
#pragma unroll
                for (int bj = 0; bj < 2; ++bj)
                    store8(O + (size_t)u.os * sstride + (size_t)(row0 + ai * HALF + m * 16) * ldo + u.pn * BM + bj * HALF + wc * 32 + 8 * fq, acc[ai][bj][m][0] * osc, acc[ai][bj][m][1] * osc);
    }
};
struct EpiF8 {
    static constexpr bool PERM = true;
    unsigned char* O; int ldo; size_t sstride; float osc;
    __device__ __forceinline__ void operator()(const f32x4 (&acc)[2][2][4][2], const Unit& u, int wr, int wc, int fr, int fq) const {
        const int row0 = u.pm * BM + wr * 64 + fr;
#pragma unroll
        for (int ai = 0; ai < 2; ++ai)
#pragma unroll
            for (int m = 0; m < 4; ++m)
#pragma unroll
                for (int bj = 0; bj < 2; ++bj) { const f32x4 v0 = acc[ai][bj][m][0] * osc, v1 = acc[ai][bj][m][1] * osc;
                    u32x2 w; w.x = cvt4_fp8(v0[0], v0[1], v0[2], v0[3]); w.y = cvt4_fp8(v1[0], v1[1], v1[2], v1[3]);
                    *(u32x2*)(O + (size_t)u.os * sstride + (size_t)(row0 + ai * HALF + m * 16) * ldo + u.pn * BM + bj * HALF + wc * 32 + 8 * fq) = w; }
    }
};
}

namespace att {
constexpr int NW = 8, QBLK = 32, KVBLK = 64, QB = 256;
constexpr int SHM_V = KVBLK * 128 * 2;
constexpr int LDS_K = 2 * SHM_V, LDS_WS = LDS_K + 2 * 64 * 192 * 2, LDS_BIAS = LDS_WS + NW * 64 * 4, LDS_QR = LDS_BIAS + 512;
#define SBAR() __builtin_amdgcn_sched_barrier(0)
__device__ __forceinline__ int v_st(int k, int c) { const int kk = (k & ~0xC) | ((k & 4) << 1) | ((k & 8) >> 1); return ((kk >> 3) * 4 + (c >> 5)) * 512 + ((kk & 7) * 32 + (c & 31)) * 2; }
__device__ __forceinline__ int v_rd_base(int lane) { return ((lane & 3) << 3) | (((lane >> 2) & 3) << 6) | (((lane >> 4) & 1) << 5) | (((lane >> 5) & 1) << 8); }
constexpr int v_rd_off(int d0, int ks, int half) { return d0 * 512 + ks * 4096 + half * 2048; }
__device__ __forceinline__ int crow(int r, int hi) { return (r & 3) + 8 * (r >> 2) + 4 * hi; }
__device__ __forceinline__ unsigned cvtpk(float lo, float hi) { unsigned r; asm volatile("v_cvt_pk_bf16_f32 %0, %1, %2" : "=v"(r) : "v"(lo), "v"(hi)); return r; }

__device__ __forceinline__ void mask_tile(f32x16& p0, f32x16& p1, int dq) {
    const float NEG = -__builtin_inff();
#pragma unroll
    for (int r = 0; r < 16; ++r) {
        const int c = (r & 3) + 8 * (r >> 2);
        if (dq - c < 0) p0[r] = NEG;
        if (dq - c - 32 < 0) p1[r] = NEG;
    }
}
__device__ __forceinline__ void bias_tile(f32x16& p0, f32x16& p1, int dq, const float* tb) {
#pragma unroll
    for (int r = 0; r < 16; ++r) {
        const int c = (r & 3) + 8 * (r >> 2);
        int d0 = dq - c, d1 = dq - c - 32;
        d0 = d0 < 0 ? 0 : (d0 > 127 ? 127 : d0); d1 = d1 < 0 ? 0 : (d1 > 127 ? 127 : d1);
        p0[r] += tb[d0]; p1[r] += tb[d1];
    }
}
constexpr float THR = 8.f;
__device__ __forceinline__ void partialSM(f32x16& p0, f32x16& p1, float& m_reg, float& mn, float& alpha) {
    float pmax = p0[0];
#pragma unroll
    for (int r = 1; r < 16; ++r) pmax = fmaxf(pmax, p0[r]);
#pragma unroll
    for (int r = 0; r < 16; ++r) pmax = fmaxf(pmax, p1[r]);
    { auto rr = __builtin_amdgcn_permlane32_swap(__float_as_uint(pmax), __float_as_uint(pmax), false, false);
      pmax = fmaxf(__uint_as_float(rr[0]), __uint_as_float(rr[1])); }
    if (__builtin_expect(__all((pmax - m_reg) <= THR), 1)) { mn = m_reg; alpha = 1.f; }
    else { mn = fmaxf(m_reg, pmax); alpha = __builtin_amdgcn_exp2f(m_reg - mn); m_reg = mn; }
#pragma unroll
    for (int r = 0; r < 16; ++r) p0[r] = p0[r] - mn;
#pragma unroll
    for (int r = 0; r < 16; ++r) p1[r] = p1[r] - mn;
#pragma unroll
    for (int r = 0; r < 16; ++r) p0[r] = __builtin_amdgcn_exp2f(p0[r]);
}
__device__ __forceinline__ void finishSM(f32x16& p0, f32x16& p1, float alpha, float& l_reg, bf16x8& pa0, bf16x8& pa1, bf16x8& pa2, bf16x8& pa3) {
#pragma unroll
    for (int r = 0; r < 16; ++r) p1[r] = __builtin_amdgcn_exp2f(p1[r]);
    float ps = 0;
#pragma unroll
    for (int r = 0; r < 16; ++r) ps += p0[r];
#pragma unroll
    for (int r = 0; r < 16; ++r) ps += p1[r];
    { auto rr = __builtin_amdgcn_permlane32_swap(__float_as_uint(ps), __float_as_uint(ps), false, false);
      ps = __uint_as_float(rr[0]) + __uint_as_float(rr[1]); }
    l_reg = l_reg * alpha + ps;
#define PK4(P, B_, OUT) do { unsigned a0 = cvtpk(P[B_+0], P[B_+1]), a1 = cvtpk(P[B_+2], P[B_+3]);                          \
        unsigned b0 = cvtpk(P[B_+4], P[B_+5]), b1 = cvtpk(P[B_+6], P[B_+7]);                                             \
        auto r0 = __builtin_amdgcn_permlane32_swap(a0, b0, false, false); auto r1 = __builtin_amdgcn_permlane32_swap(a1, b1, false, false); \
        u32x4 w = {r0[0], r1[0], r0[1], r1[1]}; OUT = *reinterpret_cast<bf16x8*>(&w); } while (0)
    PK4(p0, 0, pa0); PK4(p0, 8, pa1); PK4(p1, 0, pa2); PK4(p1, 8, pa3);
#undef PK4
}
template <int DQK> __device__ __forceinline__ int kswz(int row, int colB) { return row * (DQK * 2) + (colB ^ ((row & 7) << 4)); }
template <int KB, int DQK>
__device__ __forceinline__ void qkt(f32x16& p0, f32x16& p1, const char* K_lds, int r32, int hi, const bf16x8* qr, const char* qrl) {
    constexpr int SHMK = 64 * DQK * 2, NF = DQK / 16, NFR = NF > 8 ? 8 : NF;
    p0 = f32x16{}; p1 = f32x16{};
    const char* kb[4];
#pragma unroll
    for (int dd = 0; dd < 4; ++dd) kb[dd] = K_lds + KB * SHMK + kswz<DQK>(r32, (dd * 16 + hi * 8) * 2);
#pragma unroll
    for (int d0 = 0; d0 < NF; ++d0) { const char* a = kb[d0 & 3] + (d0 >> 2) * 128;
        bf16x8 b0 = *reinterpret_cast<const bf16x8*>(a);
        bf16x8 b1 = *reinterpret_cast<const bf16x8*>(a + 32 * DQK * 2);
        bf16x8 q; if (d0 < NFR) q = qr[d0]; else q = *reinterpret_cast<const bf16x8*>(qrl + (d0 - NFR) * 1024);
        p0 = __builtin_amdgcn_mfma_f32_32x32x16_bf16(b0, q, p0, 0, 0, 0);
        p1 = __builtin_amdgcn_mfma_f32_32x32x16_bf16(b1, q, p1, 0, 0, 0); }
}
template <int VB>
__device__ __forceinline__ void pv_tile(f32x16* o, int vb0, bf16x8 pa0, bf16x8 pa1, bf16x8 pa2, bf16x8 pa3) {
#define TRRD(dst, off) asm volatile("ds_read_b64_tr_b16 %0, %1 offset:%2" : "=&v"(dst) : "v"(vb0), "i"(off) : "memory")
#define PV_D0(d0) do { s16x4 l0, l1, l2, l3, h0, h1, h2, h3; constexpr int b_ = VB * SHM_V + v_rd_off(d0, 0, 0); \
        TRRD(l0, b_); TRRD(h0, b_ + 2048); TRRD(l1, b_ + 4096); TRRD(h1, b_ + 6144); TRRD(l2, b_ + 8192); TRRD(h2, b_ + 10240); TRRD(l3, b_ + 12288); TRRD(h3, b_ + 14336); \
        asm volatile("s_waitcnt lgkmcnt(0)" ::: "memory"); SBAR();   \
        o[d0] = __builtin_amdgcn_mfma_f32_32x32x16_bf16(pa0, (bf16x8){l0[0], l0[1], l0[2], l0[3], h0[0], h0[1], h0[2], h0[3]}, o[d0], 0, 0, 0);   \
        o[d0] = __builtin_amdgcn_mfma_f32_32x32x16_bf16(pa1, (bf16x8){l1[0], l1[1], l1[2], l1[3], h1[0], h1[1], h1[2], h1[3]}, o[d0], 0, 0, 0);   \
        o[d0] = __builtin_amdgcn_mfma_f32_32x32x16_bf16(pa2, (bf16x8){l2[0], l2[1], l2[2], l2[3], h2[0], h2[1], h2[2], h2[3]}, o[d0], 0, 0, 0);   \
        o[d0] = __builtin_amdgcn_mfma_f32_32x32x16_bf16(pa3, (bf16x8){l3[0], l3[1], l3[2], l3[3], h3[0], h3[1], h3[2], h3[3]}, o[d0], 0, 0, 0); } while (0)
    PV_D0(0); PV_D0(1); PV_D0(2); PV_D0(3);
#undef PV_D0
#undef TRRD
}

struct AttnArgs {
    const bf16_t* Q; const bf16_t* K; const bf16_t* K2; const bf16_t* V; int P0;
    bf16_t* Out; float* O0; float lam; const float* dnorm; float oscale;
};
template <bool MLA, int MODE, bool PIPE>
__device__ __forceinline__ void attn_block(const AttnArgs& a, char* lds) {
    constexpr int DQK = MLA ? 192 : 64, NF = DQK / 16, KROW = DQK * 2, SHMK = 64 * KROW;
    constexpr bool BIAS = !MLA;
    int tid_ = threadIdx.x; asm volatile("" : "+v"(tid_));
    const int tid = tid_, wid = __builtin_amdgcn_readfirstlane(tid >> 6), lane = tid & 63, r32 = lane & 31, hi = lane >> 5;
    constexpr int ldq = MLA ? QMC : HC, ldk = KVC, ldk2 = HC, ldv = MLA ? KVC : HC;
    const int P0 = a.P0, NT = (P0 + QB) / KVBLK;
    const int qlo = P0 + wid * QBLK, qm = qlo + r32 - 4 * hi;
    char* V_lds = lds; char* K_lds = lds + LDS_K;
    float* ws = (float*)(lds + LDS_WS) + wid * 64; float* li_l = ws; float* al_l = ws + 32;
    const float* tb = (const float*)(lds + LDS_BIAS);
    float m_reg = -1e30f, l_reg = 0; f32x16 o[4] = {};
    const int sr = tid >> 4, sc = (tid & 15) * 8, vst0 = v_st(sr, sc), vst1 = v_st(32 + sr, sc);
    const int kws = kswz<DQK>(sr, sc * 2);
    const int kr_row = tid >> 3, kr_c = (tid & 7) * 8;
    const int kws2 = kswz<DQK>(kr_row, ((MLA ? 128 : 0) + kr_c) * 2);
    const int vb0 = (int)(uintptr_t)V_lds + v_rd_base(lane);
    bf16x8 st_v0, st_v1, st_k0, st_k1, st_k2;
    constexpr int NFR = NF > 8 ? 8 : NF;
    bf16x8 qr[NFR];
    char* qrl = lds + LDS_QR + wid * 4096 + lane * 16;
#pragma unroll
    for (int d0 = 0; d0 < NFR; ++d0) qr[d0] = *reinterpret_cast<const bf16x8*>(a.Q + (size_t)(qlo + r32) * ldq + d0 * 16 + hi * 8);
#pragma unroll
    for (int d0 = NFR; d0 < NF; ++d0) *reinterpret_cast<bf16x8*>(qrl + (d0 - NFR) * 1024) = *reinterpret_cast<const bf16x8*>(a.Q + (size_t)(qlo + r32) * ldq + d0 * 16 + hi * 8);
    const unsigned voV = (unsigned)(sr * ldv + sc) * 2u, voK = (unsigned)(sr * ldk + sc) * 2u, voK2 = (unsigned)(kr_row * ldk2 + kr_c) * 2u;
    constexpr size_t v32 = (size_t)32 * ldv * 2, k32 = (size_t)32 * ldk * 2;
#define VMW() asm volatile("s_waitcnt vmcnt(0)" ::: "memory")
#define SLOAD(k0) do { const char* vb_ = (const char*)a.V + (size_t)(k0) * ldv * 2; const char* k2b_ = (const char*)a.K2 + (size_t)(k0) * ldk2 * 2; \
        st_v0 = *reinterpret_cast<const bf16x8*>(vb_ + voV); st_v1 = *reinterpret_cast<const bf16x8*>(vb_ + v32 + voV); \
        if constexpr (MLA) { const char* kb_ = (const char*)a.K + (size_t)(k0) * ldk * 2; st_k0 = *reinterpret_cast<const bf16x8*>(kb_ + voK); st_k1 = *reinterpret_cast<const bf16x8*>(kb_ + k32 + voK); } \
        st_k2 = *reinterpret_cast<const bf16x8*>(k2b_ + voK2); } while (0)
#define SWRITE(bf) do { *(bf16x8*)(V_lds + (bf) * SHM_V + vst0) = st_v0; *(bf16x8*)(V_lds + (bf) * SHM_V + vst1) = st_v1; \
        if constexpr (MLA) { *(bf16x8*)(K_lds + (bf) * SHMK + kws) = st_k0; *(bf16x8*)(K_lds + (bf) * SHMK + kws + 32 * KROW) = st_k1; } \
        *(bf16x8*)(K_lds + (bf) * SHMK + kws2) = st_k2; } while (0)
#define RESC(al) do { if (__any((al) < 1.f)) { if (hi == 0) al_l[r32] = (al); asm volatile("s_waitcnt lgkmcnt(0)" ::: "memory");              \
                     for (int d_ = 0; d_ < 4; ++d_) for (int r = 0; r < 16; ++r) o[d_][r] *= al_l[crow(r, hi)]; } } while (0)
#define KBASE(t) ((t) * KVBLK)
#define MASKT(P0_, P1_, t) do { const int kb_ = KBASE(t); \
        if (BIAS && kb_ + 176 > qlo) bias_tile(P0_, P1_, qm - kb_, tb); \
        if (kb_ + KVBLK - 1 > qlo) mask_tile(P0_, P1_, qm - kb_); } while (0)
    bf16x8 pa0, pa1, pa2, pa3;
    if constexpr (!PIPE) {
    f32x16 p0, p1; float mn, al;
    SLOAD(0); VMW(); SWRITE(0);
    __syncthreads();
#define STEP(t, BF) do { \
        if ((t) + 1 < NT) { SLOAD(KBASE((t) + 1)); } SBAR(); \
        qkt<BF, DQK>(p0, p1, K_lds, r32, hi, qr, qrl); \
        MASKT(p0, p1, (t)); partialSM(p0, p1, m_reg, mn, al); RESC(al); \
        finishSM(p0, p1, al, l_reg, pa0, pa1, pa2, pa3); SBAR(); \
        pv_tile<BF>(o, vb0, pa0, pa1, pa2, pa3); SBAR(); \
        if ((t) + 1 < NT) { VMW(); SWRITE(1 - (BF)); } \
        __syncthreads(); } while (0)
    for (int t = 0; t < NT; t += 2) { STEP(t, 0); STEP(t + 1, 1); }
#undef STEP
    } else {
    f32x16 pA0, pA1, pB0, pB1; float mnA, mnB, alA, alB;
    SLOAD(0); VMW(); SWRITE(0); SBAR();
    SLOAD(KBASE(1));
    __syncthreads();
    SBAR(); qkt<0, DQK>(pA0, pA1, K_lds, r32, hi, qr, qrl);
    MASKT(pA0, pA1, 0); partialSM(pA0, pA1, m_reg, mnA, alA);
    VMW(); SWRITE(1);
    __syncthreads();
#define HALF_STEP(PX0, PX1, mnX, alX, PY0, PY1, alY, t, KB, VB, SB) do {                                                      \
        SBAR(); qkt<KB, DQK>(PX0, PX1, K_lds, r32, hi, qr, qrl);                                                              \
        finishSM(PY0, PY1, alY, l_reg, pa0, pa1, pa2, pa3); SBAR();                                                           \
        if ((t) + 1 < NT) { SLOAD(KBASE((t) + 1)); SBAR(); }                                                                  \
        pv_tile<VB>(o, vb0, pa0, pa1, pa2, pa3); MASKT(PX0, PX1, (t)); partialSM(PX0, PX1, m_reg, mnX, alX);                  \
        __syncthreads();                                                                                                      \
        if ((t) + 1 < NT) { VMW(); SWRITE(SB); }                                                                              \
        RESC(alX); __syncthreads(); } while (0)
    for (int t = 1; t + 1 < NT; t += 2) {
        HALF_STEP(pB0, pB1, mnB, alB, pA0, pA1, alA, t, 1, 0, 0);
        HALF_STEP(pA0, pA1, mnA, alA, pB0, pB1, alB, t + 1, 0, 1, 1);
    }
#undef HALF_STEP
    SBAR(); qkt<1, DQK>(pB0, pB1, K_lds, r32, hi, qr, qrl); SBAR();
    finishSM(pA0, pA1, alA, l_reg, pa0, pa1, pa2, pa3); SBAR();
    pv_tile<0>(o, vb0, pa0, pa1, pa2, pa3);
    MASKT(pB0, pB1, NT - 1); partialSM(pB0, pB1, m_reg, mnB, alB); RESC(alB);
    finishSM(pB0, pB1, alB, l_reg, pa0, pa1, pa2, pa3); SBAR(); pv_tile<1>(o, vb0, pa0, pa1, pa2, pa3);
    SBAR();
    __syncthreads();
    }
    if (hi == 0) li_l[r32] = l_reg; asm volatile("s_waitcnt lgkmcnt(0)" ::: "memory");
    float rli[16];
#pragma unroll
    for (int r = 0; r < 16; ++r) rli[r] = __builtin_amdgcn_rcpf(li_l[crow(r, hi)]);
    if constexpr (MODE == 0) {
        bf16_t* Ow = a.Out + (size_t)qlo * 1024;
#pragma unroll
        for (int r = 0; r < 16; ++r) { const int orow = crow(r, hi);
#pragma unroll
            for (int d0 = 0; d0 < 4; ++d0) { const float v = o[d0][r] * rli[r]; const float vn = __shfl_xor(v, 1);
                if ((r32 & 1) == 0) *(unsigned*)(Ow + (size_t)orow * 1024 + d0 * 32 + r32) = cvtpk(v, vn); } }
    } else if constexpr (MODE == 1) {
        bf16_t* Ow = (bf16_t*)a.O0 + (size_t)qlo * 512;
#pragma unroll
        for (int r = 0; r < 16; ++r) { const int orow = crow(r, hi);
#pragma unroll
            for (int d0 = 0; d0 < 4; ++d0) { const float v = o[d0][r] * rli[r]; const float vn = __shfl_xor(v, 1);
                if ((r32 & 1) == 0) *(unsigned*)(Ow + (size_t)orow * 512 + d0 * 32 + r32) = cvtpk(v, vn); } }
    } else {
        const float* O0w = a.O0 + (size_t)qlo * 512;
        bf16_t* Ow = a.Out + (size_t)qlo * 1024;
        float gn[4];
#pragma unroll
        for (int d0 = 0; d0 < 4; ++d0) gn[d0] = a.dnorm[d0 * 32 + r32] * a.oscale;
#pragma unroll
        for (int r = 0; r < 16; ++r) { const int orow = crow(r, hi);
            float d[4]; float ss = 0.f;
#pragma unroll
            for (int d0 = 0; d0 < 4; ++d0) { d[d0] = O0w[(size_t)orow * 512 + d0 * 32 + r32] - a.lam * (o[d0][r] * rli[r]); ss += d[d0] * d[d0]; }
#pragma unroll
            for (int s = 1; s < 32; s <<= 1) ss += __shfl_xor(ss, s);
            const float rs = __builtin_amdgcn_rsqf(ss * (1.0f / 128.0f) + 1e-5f);
#pragma unroll
            for (int d0 = 0; d0 < 4; ++d0) { const float v = d[d0] * rs * gn[d0]; const float vn = __shfl_xor(v, 1);
                if ((r32 & 1) == 0) *(unsigned*)(Ow + (size_t)orow * 1024 + d0 * 32 + r32) = cvtpk(v, vn); } }
    }
    __syncthreads();
#undef VMW
#undef SLOAD
#undef SWRITE
#undef RESC
#undef KBASE
#undef MASKT
#undef HALF_STEP
}
#undef SBAR
}

struct Args {
    const float* in[22]; float* out; unsigned char* ws;
    float inv[32];
    float lam_init[4];
    unsigned char bucket[128];
    unsigned short aq[32];
    int ph_lo, ph_hi;
};

template <class F, bool F8OUT = false>
__device__ __forceinline__ void cvt_item(const F& f, const float* kscale, int K, bf16_t* WT, LAS float* scr, int item, int nblk, int lane, float mul = 1.0f) {
    const int kb = item / nblk, nb = item % nblk, k0 = 64 * kb, n0 = 32 * nb;
    if (f.contig(n0)) {
        const float* base; int ld; float sc; f(n0, base, ld, sc); sc *= mul;
        const int r8 = lane >> 3, c4 = (lane & 7) * 4;
        f32x4 v[8];
#pragma unroll
        for (int i = 0; i < 8; ++i) v[i] = __builtin_nontemporal_load((const f32x4*)(base + (size_t)(k0 + 8 * i + r8) * ld + c4));
#pragma unroll
        for (int i = 0; i < 8; ++i) { const int kk = 8 * i + r8; const float m = kscale ? sc * kscale[k0 + kk] : sc;
            scr[kk * 33 + c4 + 0] = v[i][0] * m; scr[kk * 33 + c4 + 1] = v[i][1] * m; scr[kk * 33 + c4 + 2] = v[i][2] * m; scr[kk * 33 + c4 + 3] = v[i][3] * m; }
    } else {
        const float* src; int ld; float sc; f(n0 + (lane & 31), src, ld, sc); sc *= mul;
#pragma unroll 8
        for (int i = 0; i < 32; ++i) { const int kk = 2 * i + (lane >> 5); float v = src[(size_t)(k0 + kk) * ld] * sc; if (kscale) v *= kscale[k0 + kk]; scr[kk * 33 + (lane & 31)] = v; }
    }
    LDS_WAIT(); asm volatile("" ::: "memory");
    const int c = lane & 7;
#pragma unroll
    for (int j = 0; j < 4; ++j) { const int n = (lane >> 3) + 8 * j; const LAS float* s = scr + (8 * c) * 33 + n;
        if constexpr (F8OUT) {
            u32x2 o; o.x = cvt4_fp8(s[0 * 33], s[1 * 33], s[2 * 33], s[3 * 33]); o.y = cvt4_fp8(s[4 * 33], s[5 * 33], s[6 * 33], s[7 * 33]);
            *(u32x2*)((unsigned char*)WT + (size_t)(n0 + n) * K + k0 + 8 * c) = o;
        } else {
            u32x4 o; o.x = cvt_pk_bf16(s[0 * 33], s[1 * 33]); o.y = cvt_pk_bf16(s[2 * 33], s[3 * 33]); o.z = cvt_pk_bf16(s[4 * 33], s[5 * 33]); o.w = cvt_pk_bf16(s[6 * 33], s[7 * 33]);
            *(u32x4*)(WT + (size_t)(n0 + n) * K + k0 + 8 * c) = o; } }
    LDS_WAIT(); asm volatile("" ::: "memory");
}
struct MapWin { const float* W;
    __device__ __forceinline__ bool contig(int n0) const { return !(n0 >= C_KR && n0 < C_DQ); }
    __device__ __forceinline__ void operator()(int n, const float*& src, int& ld, float& sc) const {
        ld = 2240; sc = 1.f; int c = n;
        if (n >= 2240) { c = 0; sc = 0.f; }
        else if (n >= C_KR && n < C_DQ) { const int j = n - C_KR, i = j >> 1; c = C_KR + ((j & 1) ? 32 + i : i); }
        else if (n >= C_DQ && n < C_DK) sc = 0.125f * LOG2E;
        src = W + c; } };
struct MapWuq { const float* W;
    __device__ __forceinline__ bool contig(int n0) const { return (n0 % 192) < 128; }
    __device__ __forceinline__ void operator()(int n, const float*& src, int& ld, float& sc) const {
        ld = 768; sc = 0.07216878364870323f * LOG2E;
        const int hh = n / 192, j = n % 192; int c = j;
        if (j >= 128) { const int jj = j - 128, i = jj >> 1; c = 128 + ((jj & 1) ? 32 + i : i); }
        src = W + hh * 192 + c; } };
struct MapWukv { const float* Wk; const float* Wv;
    __device__ __forceinline__ bool contig(int) const { return true; }
    __device__ __forceinline__ void operator()(int n, const float*& src, int& ld, float& sc) const { ld = 512; sc = 1.f; src = n < 512 ? Wk + n : Wv + (n - 512); } };
struct MapPlain { const float* W; int N;
    __device__ __forceinline__ bool contig(int) const { return true; }
    __device__ __forceinline__ void operator()(int n, const float*& src, int& ld, float& sc) const { ld = N; sc = 1.f; src = W + n; } };
struct MapGU { const float* Wg; const float* Wu; int F;
    __device__ __forceinline__ bool contig(int) const { return true; }
    __device__ __forceinline__ void operator()(int n, const float*& src, int& ld, float& sc) const { ld = F; sc = 1.f; const int pn = n >> 8, j = n & 255; src = (j < 128) ? Wg + pn * 128 + j : Wu + pn * 128 + (j - 128); } };

__device__ __forceinline__ void cvt_moe(const Args& a, int ml, LAS float* scr, int gw, int NGW, int lane) {
    asm volatile("" : "+v"(lane));
    constexpr int I_GU = (DM / 64) * (2 * FFE / 32), I_D = (FFE / 64) * (DM / 32), I_E = I_GU + I_D;
    const float* wg = gfp(a.in[oi(19)]) + (size_t)ml * NEXP * DM * FFE; const float* wu = gfp(a.in[oi(20)]) + (size_t)ml * NEXP * DM * FFE; const float* wd = gfp(a.in[oi(21)]) + (size_t)ml * NEXP * FFE * DM;
    unsigned char* wsl = opq(a.ws); bf16_t* mgu = (bf16_t*)(wsl + WS_MGU); bf16_t* md = (bf16_t*)(wsl + WS_MD);
    for (int it = gw; it < NEXP * I_E; it += NGW) {
        const int e = it / I_E; int r = it % I_E;
        if (r < I_GU) { MapGU f{wg + (size_t)e * DM * FFE, wu + (size_t)e * DM * FFE, FFE}; cvt_item<MapGU, true>(f, nullptr, DM, (bf16_t*)((unsigned char*)mgu + (size_t)e * 2 * FFE * DM), scr, r, 2 * FFE / 32, lane, W8_GU); }
        else { r -= I_GU; MapPlain f{wd + (size_t)e * FFE * DM, DM}; cvt_item<MapPlain, true>(f, nullptr, FFE, (bf16_t*)((unsigned char*)md + (size_t)e * DM * FFE), scr, r, DM / 32, lane, W8_D); }
    }
}

template <int MODE, bool ROUTE, bool OUT8 = false, bool NOX = false, bool WRY = false>
__device__ __forceinline__ void ln_pass(const Args& a, const ystream_t* Ysrc, const float* Xres, const float* g, const float* b, float* Xout, bf16_t* XB,
                                        const float* router, unsigned* cnt, int gw, int NGW, int lane, LAS unsigned char* lds_, const float* g1 = nullptr, const float* b1 = nullptr, int stslot = 20) {
    asm volatile("" : "+v"(lane));
    unsigned char* wsl = opq(a.ws);
    const bf16_t* oslot = (const bf16_t*)(wsl + WS_OSLOT); const bf16_t* oslot2 = (const bf16_t*)(wsl + WS_OSLOT2);
    f32x4* route = (f32x4*)(wsl + WS_ROUTE);
    const int* slots = (const int*)(wsl + WS_ROUTE + 512 * 1024);
    float* st = (float*)(wsl + WS_SS);
    unsigned long long pk = 0ull;
#pragma unroll 2
    for (int m = gw; m < M; m += NGW) {
        f32x4 v[4];
        if constexpr (MODE == 0) {
#pragma unroll
            for (int j = 0; j < 4; ++j) v[j] = ld4h(Ysrc + (size_t)m * DM + (lane + 64 * j) * 4);
        } else {
            const f32x4 rt = route[m]; const int s1 = slots[2 * m], s2 = slots[2 * m + 1];
            const float mu1 = st[(size_t)m * 32 + 20], rs1 = st[(size_t)m * 32 + 21];
#pragma unroll
            for (int j = 0; j < 4; ++j) { const f32x4 yv1 = ld4h(Ysrc + (size_t)m * DM + (lane + 64 * j) * 4);
                const f32x4 xv = (yv1 - mu1) * rs1 * *((const f32x4*)g1 + lane + 64 * j) + *((const f32x4*)b1 + lane + 64 * j);
                const unsigned o1 = *((const unsigned*)((const unsigned char*)oslot + (size_t)s1 * DM) + lane + 64 * j), o2 = *((const unsigned*)((const unsigned char*)oslot + (size_t)s2 * DM) + lane + 64 * j);
                const unsigned p1 = *((const unsigned*)((const unsigned char*)oslot2 + (size_t)s1 * DM) + lane + 64 * j), p2 = *((const unsigned*)((const unsigned char*)oslot2 + (size_t)s2 * DM) + lane + 64 * j);
                const f32x2 a1l = __builtin_amdgcn_cvt_pk_f32_fp8((int)o1, false), a1h = __builtin_amdgcn_cvt_pk_f32_fp8((int)o1, true), b1l = __builtin_amdgcn_cvt_pk_f32_fp8((int)p1, false), b1h = __builtin_amdgcn_cvt_pk_f32_fp8((int)p1, true);
                const f32x2 a2l = __builtin_amdgcn_cvt_pk_f32_fp8((int)o2, false), a2h = __builtin_amdgcn_cvt_pk_f32_fp8((int)o2, true), b2l = __builtin_amdgcn_cvt_pk_f32_fp8((int)p2, false), b2h = __builtin_amdgcn_cvt_pk_f32_fp8((int)p2, true);
                const float g1s = rt[2] * (1.0f / O8), g2s = rt[3] * (1.0f / O8);
                f32x4 r;
                r[0] = xv[0] * DN_ALPHA + g1s * (a1l.x + b1l.x) + g2s * (a2l.x + b2l.x);
                r[1] = xv[1] * DN_ALPHA + g1s * (a1l.y + b1l.y) + g2s * (a2l.y + b2l.y);
                r[2] = xv[2] * DN_ALPHA + g1s * (a1h.x + b1h.x) + g2s * (a2h.x + b2h.x);
                r[3] = xv[3] * DN_ALPHA + g1s * (a1h.y + b1h.y) + g2s * (a2h.y + b2h.y);
                if constexpr (WRY) st4h((ystream_t*)Ysrc + (size_t)m * DM + (lane + 64 * j) * 4, r);
                v[j] = r; }
        }
        float s = 0.f;
#pragma unroll
        for (int j = 0; j < 4; ++j) s += (v[j][0] + v[j][1]) + (v[j][2] + v[j][3]);
        const float mean = wave_sum(s) * (1.f / DM); float s2 = 0.f;
#pragma unroll
        for (int j = 0; j < 4; ++j) { v[j] = v[j] - mean; s2 += (v[j][0] * v[j][0] + v[j][1] * v[j][1]) + (v[j][2] * v[j][2] + v[j][3] * v[j][3]); }
        const float rstd = __builtin_amdgcn_rsqf(wave_sum(s2) * (1.f / DM) + 1e-5f);
#pragma unroll
        for (int j = 0; j < 4; ++j) { const f32x4 gv = *((const f32x4*)g + lane + 64 * j), bv = *((const f32x4*)b + lane + 64 * j);
            v[j] = v[j] * rstd * gv + bv;
            if constexpr (!NOX) *((f32x4*)(Xout + (size_t)m * DM) + lane + 64 * j) = v[j];
            if constexpr (OUT8) { *((unsigned*)((unsigned char*)XB + (size_t)m * DM) + lane + 64 * j) = cvt4_fp8(v[j][0], v[j][1], v[j][2], v[j][3]); }
            else if (XB) { u32x2 w; w.x = cvt_pk_bf16(v[j][0], v[j][1]); w.y = cvt_pk_bf16(v[j][2], v[j][3]); *((u32x2*)(XB + (size_t)m * DM) + lane + 64 * j) = w; } }
        if constexpr (NOX) { if (lane == 0) { st[(size_t)m * 32 + stslot] = mean; st[(size_t)m * 32 + stslot + 1] = rstd; } }
        if constexpr (ROUTE) {
            float lg[8];
#pragma unroll
            for (int e = 0; e < 8; ++e) lg[e] = 0.f;
#pragma unroll
            for (int j = 0; j < 4; ++j)
#pragma unroll
                for (int q = 0; q < 4; ++q) { const int k = (lane + 64 * j) * 4 + q; const f32x4 r0 = *(const f32x4*)(router + (size_t)k * 8), r1 = *(const f32x4*)(router + (size_t)k * 8 + 4); const float xv = v[j][q];
                    lg[0] += xv * r0[0]; lg[1] += xv * r0[1]; lg[2] += xv * r0[2]; lg[3] += xv * r0[3]; lg[4] += xv * r1[0]; lg[5] += xv * r1[1]; lg[6] += xv * r1[2]; lg[7] += xv * r1[3]; }
#pragma unroll
            for (int e = 0; e < 8; ++e) lg[e] = wave_sum(lg[e]);
            int e1 = 0; float v1 = lg[0];
#pragma unroll
            for (int e = 1; e < 8; ++e) if (lg[e] > v1) { v1 = lg[e]; e1 = e; }
            int e2 = -1; float v2 = -__builtin_inff();
#pragma unroll
            for (int e = 0; e < 8; ++e) if (e != e1 && lg[e] > v2) { v2 = lg[e]; e2 = e; }
            const float g2 = 1.0f / (1.0f + __expf(v1 - v2)), g1 = 1.0f - g2;
            if (lane == 0) { f32x4 rt; rt[0] = __int_as_float(e1); rt[1] = __int_as_float(e2); rt[2] = g1; rt[3] = g2; route[m] = rt; }
            pk += (1ull << (8 * e1)) + (1ull << (8 * e2));
        }
    }
    if constexpr (ROUTE) {
        LAS unsigned* lc = (LAS unsigned*)(lds_ + 131072);
        const bool w0 = (gw & 7) == 0;
        if (w0 && lane < 8) lc[lane] = 0u;
        __syncthreads();
        if (lane < 8) atomicAdd((unsigned*)(lc + lane), (unsigned)((pk >> (8 * lane)) & 255ull));
        __syncthreads();
        if (w0 && lane < 8) atomicAdd(cnt + lane, lc[lane]);
    }
}

#define XB_TMO      128
#define XB_XCNT(j)  (256  + 64 * (j))
#define XB_XSUB(j)  (1280 + 64 * (j))
#define XB_XGEN(j)  (2304 + 64 * (j))
#define XB_TOP      3328
#define XB_TOPGEN   3392
#define XCD_BAR_WORDS 3456
#define XB_SPIN_CAP (1u << 22)
__device__ __forceinline__ unsigned xb_ld(unsigned* p)              { return __hip_atomic_load(p, __ATOMIC_RELAXED, __HIP_MEMORY_SCOPE_AGENT); }
__device__ __forceinline__ unsigned xb_add(unsigned* p, unsigned v) { return __hip_atomic_fetch_add(p, v, __ATOMIC_RELAXED, __HIP_MEMORY_SCOPE_AGENT); }
__device__ __forceinline__ unsigned xb_xcc_id() { return (unsigned)__builtin_amdgcn_s_getreg((3 << 11) | 20) & 0xFu; }
#define XB_SPIN(cond, bar) do { unsigned _sp = 0; while (cond) { __builtin_amdgcn_s_sleep(1); \
    if ((++_sp & 255u) == 0u) { if (xb_ld(&(bar)[XB_TMO])) break; if (_sp > XB_SPIN_CAP) { atomicAdd(&(bar)[XB_TMO], 1u); break; } } } } while (0)
struct XcdBarrier { unsigned* bar; unsigned x; volatile LAS unsigned* st; };
__device__ __forceinline__ XcdBarrier xcd_barrier_post(unsigned* bar, volatile LAS unsigned* st) {
    XcdBarrier b; b.bar = bar; b.x = xb_xcc_id(); b.st = st;
    if (threadIdx.x == 0) (void)xb_add(&bar[XB_XCNT(b.x)], 1u);
    return b;
}
__device__ __forceinline__ void xcd_barrier_complete(unsigned* bar, unsigned x, unsigned& nloc, unsigned& nx) {
    const unsigned G = gridDim.x * gridDim.y * gridDim.z;
    unsigned sum, cnt, mine, sp = 0u;
    for (;;) {
        sum = 0u; cnt = 0u; mine = 0u;
#pragma unroll
        for (unsigned j = 0; j < 16; ++j) { const unsigned c = xb_ld(&bar[XB_XCNT(j)]); sum += c; cnt += (c > 0u) ? 1u : 0u; mine = (j == x) ? c : mine; }
        if (sum == G) break;
        __builtin_amdgcn_s_sleep(1);
        if ((++sp & 255u) == 0u) { if (xb_ld(&bar[XB_TMO])) break; if (sp > XB_SPIN_CAP) { atomicAdd(&bar[XB_TMO], 1u); break; } }
    }
    nloc = mine > 0u ? mine : 1u; nx = cnt > 0u ? cnt : 1u;
}
__device__ __forceinline__ void xcd_barrier(const XcdBarrier& b) {
    asm volatile("s_waitcnt vmcnt(0)" ::: "memory");
    __syncthreads();
    if (threadIdx.x == 0) {
        unsigned* bar = b.bar;
        __builtin_amdgcn_s_waitcnt(0);
        unsigned nloc = b.st[0], nx = b.st[1];
        if (nloc == 0u) { xcd_barrier_complete(bar, b.x, nloc, nx); b.st[0] = nloc; b.st[1] = nx; }
        const unsigned old = xb_add(&bar[XB_XSUB(b.x)], 1u);
        const unsigned gen = old / nloc;
        if (old + 1u == (gen + 1u) * nloc) {
            __builtin_amdgcn_fence(__ATOMIC_RELEASE, "agent");
            asm volatile("s_waitcnt vmcnt(0)" ::: "memory");
            const unsigned og = xb_add(&bar[XB_TOP], 1u);
            const unsigned tg = og / nx;
            if (og + 1u == (tg + 1u) * nx) xb_add(&bar[XB_TOPGEN], 1u);
            else XB_SPIN(xb_ld(&bar[XB_TOPGEN]) == tg, bar);
            __builtin_amdgcn_fence(__ATOMIC_ACQUIRE, "agent");
            xb_add(&bar[XB_XGEN(b.x)], 1u);
            asm volatile("s_waitcnt vmcnt(0)" ::: "memory");
        } else {
            XB_SPIN(xb_ld(&bar[XB_XGEN(b.x)]) == gen, bar);
            __builtin_amdgcn_fence(__ATOMIC_ACQUIRE, "agent");
            asm volatile("s_waitcnt vmcnt(0)" ::: "memory");
        }
    }
    __syncthreads();
}
constexpr int CW_BAR = 16384;

__global__ void __launch_bounds__(512, 2) mega_fwd(Args a) {
    extern __shared__ __attribute__((aligned(16))) unsigned char lds_raw[];
    LAS unsigned char* lds = (LAS unsigned char*)lds_raw;
    cg::grid_group grid = cg::this_grid();
    const int tid = threadIdx.x, wave = __builtin_amdgcn_readfirstlane(tid >> 6);
#define FRESH_LANE(name) int name = threadIdx.x; asm volatile("" : "+v"(name)); name &= 63
    const int G = gridDim.x, bx = blockIdx.x;
    const int vcu = (G % 8 == 0) ? (bx % 8) * (G / 8) + bx / 8 : bx;
    const int gw = vcu * 8 + wave, NGW = G * 8;
#define ws opq(a.ws)
#define ctl ((unsigned*)(ws + WS_CTL))
#define tab ((float*)(ws + WS_TAB))
#define ssq ((float*)(ws + WS_SS))
#define sskv ((float*)(ws + WS_SS))
#define WinT ((bf16_t*)(ws + WS_WIN))
#define WuqT ((bf16_t*)(ws + WS_WUQ))
#define WukvT ((bf16_t*)(ws + WS_WUKV))
#define WoT ((bf16_t*)(ws + WS_WO))
#define WguT ((bf16_t*)(ws + WS_WGU))
#define WdT ((bf16_t*)(ws + WS_WD))
#define MguT ((bf16_t*)(ws + WS_MGU))
#define MdT ((bf16_t*)(ws + WS_MD))
#define Xf ((float*)(ws + WS_X))
#define XB ((bf16_t*)(ws + WS_XB))
#define Y ((ystream_t*)(ws + WS_Y))
#define Hb ((bf16_t*)(ws + WS_H))
#define QMb ((bf16_t*)(ws + WS_QM))
#define KVb ((bf16_t*)(ws + WS_KVB))
#define MRG ((bf16_t*)(ws + WS_MRG))
#define O0buf ((float*)(ws + WS_O0))
#define O1buf ((float*)(ws + WS_O0 + 32 * MiB))
#define ACT ((bf16_t*)(ws + WS_ACT))
#define XG ((bf16_t*)(ws + WS_XG))
#define MACT ((bf16_t*)(ws + WS_MACT))
#define OSLOT ((bf16_t*)(ws + WS_OSLOT))
    LAS float* scr = (LAS float*)(lds + wave * 16384);

    volatile LAS unsigned* bst = (volatile LAS unsigned*)(lds + LDS_BYTES - 64);
    if (tid < 2) bst[tid] = 0u;
    __syncthreads();
    XcdBarrier xbar = xcd_barrier_post((unsigned*)(ws + WS_CTL) + CW_BAR, bst);
    int ph = 0;
    const int lo = a.ph_lo, hi = a.ph_hi;
#ifndef EN
#define EN 0xFFFFF
#endif
#ifndef REP
#define REP 0
#endif
#define PH_BEGIN(k) if (lo <= ph && ph < hi) { if constexpr ((EN >> (k)) & 1) for (int rep_ = 0; rep_ < ((((REP) >> (k)) & 1) ? 2 : 1); ++rep_) {
#define PH_END() } if (ph + 1 < hi) { if (ph == 0) grid.sync(); else xcd_barrier(xbar); } } ++ph;

    PH_BEGIN(0)
    {
        FRESH_LANE(lane_);
#define lane lane_
        constexpr int I_IN = (DM / 64) * (HC / 32), I_UQ = (384 / 64) * (768 / 32), I_UKV = (256 / 64) * (1024 / 32), I_O = (DM / 64) * (DM / 32), I_L = I_IN + I_UQ + I_UKV + I_O;
        constexpr int I_GU = (DM / 64) * (2 * FFD / 32), I_D = (FFD / 64) * (DM / 32), I_F = I_GU + I_D;
        for (int it = gw; it < 4 * I_L + 2 * I_F; it += NGW) {
            if (it < 4 * I_L) { const int l = it / I_L; int r = it % I_L;
                if (r < I_IN) { MapWin f{gfp(a.in[oi(2)]) + (size_t)l * DM * 2240}; cvt_item(f, nullptr, DM, WinT + (size_t)l * HC * DM, scr, r, HC / 32, lane); continue; } r -= I_IN;
                if (r < I_UQ) { MapWuq f{gfp(a.in[oi(5)]) + (size_t)l * 384 * 768}; cvt_item(f, gfp(a.in[oi(3)]) + l * 384, 384, WuqT + (size_t)l * 768 * 384, scr, r, 768 / 32, lane); continue; } r -= I_UQ;
                if (r < I_UKV) { MapWukv f{gfp(a.in[oi(6)]) + (size_t)l * 256 * 512, gfp(a.in[oi(7)]) + (size_t)l * 256 * 512}; cvt_item(f, gfp(a.in[oi(4)]) + l * 256, 256, WukvT + (size_t)l * 1024 * 256, scr, r, 1024 / 32, lane); continue; } r -= I_UKV;
                { MapPlain f{gfp(a.in[oi(10)]) + (size_t)l * DM * DM, DM}; cvt_item(f, nullptr, DM, WoT + (size_t)l * DM * DM, scr, r, DM / 32, lane); }
            } else { const int q = it - 4 * I_L, d = q / I_F; int r = q % I_F;
                if (r < I_GU) { MapGU f{gfp(a.in[oi(15)]) + (size_t)d * DM * FFD, gfp(a.in[oi(16)]) + (size_t)d * DM * FFD, FFD}; cvt_item<MapGU, true>(f, nullptr, DM, (bf16_t*)((unsigned char*)WguT + (size_t)d * 2 * FFD * DM), scr, r, 2 * FFD / 32, lane, W8_GU); }
                else { r -= I_GU; MapPlain f{gfp(a.in[oi(17)]) + (size_t)d * FFD * DM, DM}; cvt_item<MapPlain, true>(f, nullptr, FFD, (bf16_t*)((unsigned char*)WdT + (size_t)d * DM * FFD), scr, r, DM / 32, lane, W8_D); }
            }
        }
        cvt_moe(a, 0, scr, gw, NGW, fresh_lane());
        for (int m = gw; m < M; m += NGW) {
#pragma unroll
            for (int j = 0; j < 4; ++j) { const f32x4 v = *((const f32x4*)(gfp(a.in[oi(0)]) + (size_t)m * DM) + lane + 64 * j); u32x2 w; w.x = cvt_pk_bf16(v[0], v[1]); w.y = cvt_pk_bf16(v[2], v[3]); *((u32x2*)(XB + (size_t)m * DM) + lane + 64 * j) = w; }
        }
        for (int i = bx * 512 + tid; i < SEQ * 32; i += G * 512) { const int pos = i >> 5, fi = i & 31; const float ang = (float)pos * a.inv[fi];
            const double rev = (double)ang * 0.15915494309189535; const float fr = (float)(rev - __builtin_rint(rev));
            tab[2 * i] = __builtin_amdgcn_cosf(fr); tab[2 * i + 1] = __builtin_amdgcn_sinf(fr); }
        if (bx == 0 && tid < 128) ctl[tid] = 0u;
#undef lane
    }
    PH_END()

    for (int l = 0; l < DEPTH; ++l) {
        const bool moe = (l & 1) != 0; const int li = l >> 1;
        const float* xres = (l == 0) ? gfp(a.in[oi(0)]) : Xf;
#define splitA (G == 256)
        PH_BEGIN(1)
        { pg8::StaticOrder S; S.init(M, splitA ? 2048 : HC, G, obx()); pg8::EpiH E{Hb, ssq, sskv, tab};
          pg8::gemm_phase(lds, XB, DM, WinT + (size_t)l * HC * DM, DM, DM, S, E); }
        PH_END()
        PH_BEGIN(2)
        {
#ifndef NOQ
          if (splitA && bx >= 192) { pg8::OneUnit S{obx() - 192, 8, true}; pg8::EpiH E{Hb, ssq, sskv, tab};
            pg8::gemm_phase(lds, XB, DM, WinT + (size_t)l * HC * DM, DM, DM, S, E); }
          else { pg8::StaticOrder S; S.init(M, QMC, splitA ? 192 : G, obx()); pg8::EpiQ E{QMb, ssq, tab};
            pg8::gemm_phase(lds, Hb + C_CQ, HC, WuqT + (size_t)l * 768 * 384, 384, 384, S, E); }
#endif
#ifndef NOKV
          { pg8::StaticOrder S; S.init(M, KVC, G, obx()); pg8::EpiKV E{KVb, sskv};
            pg8::gemm_phase(lds, Hb + C_CKV, HC, WukvT + (size_t)l * 1024 * 256, 256, 256, S, E); }
#endif
        }
        PH_END()
        PH_BEGIN(3)
        {
            unsigned* qc = ctl + 512 + l;
            volatile LAS int* qslot = (volatile LAS int*)(lds + LDS_BYTES - 32);
            for (;;) {
                if (tid == 0) *qslot = (int)atomicAdd(qc, 1u);
                __syncthreads();
                const int it = __builtin_amdgcn_readfirstlane(*qslot);
                __syncthreads();
                if (it >= 768) break;
                int acc = 0, ent = 0, r = 0;
                for (int e = 0; e < 32; ++e) { const int en = (int)a.aq[e]; const int n = (en >> 8) ? 32 : 16; if (it >= acc && it < acc + n) { ent = en; r = it - acc; } acc += n; }
                const int qb = ent & 255; const bool is_diff = (ent >> 8) != 0;
                const int bh = is_diff ? (r >> 1) : r, c = r & 1, b = bh >> 2, hh = bh & 3;
                const size_t rb = (size_t)b * SEQ;
                if (!is_diff) {
                    att::AttnArgs A; A.Q = QMb + rb * QMC + hh * 192; A.K = KVb + rb * KVC + hh * 128; A.K2 = Hb + rb * HC + C_KR;
                    A.V = KVb + rb * KVC + 512 + hh * 128; A.P0 = qb * 256; A.Out = MRG + rb * 1024 + hh * 128; A.O0 = nullptr;
                    att::attn_block<true, 0, PIPE_MLA>(A, (char*)lds_raw);
                } else {
                    if (tid < 128) { const float* rbias = gfp(a.in[oi(1)]); ((float*)(lds_raw + att::LDS_BIAS))[tid] = (rbias[a.bucket[tid] * 4 + hh] - rbias[31 * 4 + hh]) * LOG2E; }
                    __syncthreads();
                    att::AttnArgs A; A.K = nullptr; A.V = Hb + rb * HC + C_DV + hh * 128; A.P0 = qb * 256; A.Out = nullptr;
                    A.O0 = (float*)((bf16_t*)(c ? O1buf : O0buf) + rb * 512 + hh * 128);
                    A.Q = Hb + rb * HC + C_DQ + hh * 128 + c * 64; A.K2 = Hb + rb * HC + C_DK + hh * 128 + c * 64;
                    att::attn_block<false, 1, PIPE_DIFF>(A, (char*)lds_raw);
                    asm volatile("s_waitcnt vmcnt(0)" ::: "memory");
                    __syncthreads();
                    if (tid == 0) {
                        __builtin_amdgcn_fence(__ATOMIC_RELEASE, "agent"); asm volatile("s_waitcnt vmcnt(0)" ::: "memory");
                        const unsigned old_ = __hip_atomic_fetch_add(ctl + 1024 + l * 256 + bh * 16 + qb, 1u, __ATOMIC_RELAXED, __HIP_MEMORY_SCOPE_AGENT);
                        if (old_ == 1u) { __builtin_amdgcn_fence(__ATOMIC_ACQUIRE, "agent"); asm volatile("s_waitcnt vmcnt(0)" ::: "memory"); }
                        *qslot = (int)old_;
                    }
                    __syncthreads();
                    const int second = __builtin_amdgcn_readfirstlane(*qslot);
                    __syncthreads();
                    if (second == 1) {
                        FRESH_LANE(ln_);
                        const float* lp = gfp(a.in[oi(8)]) + (size_t)l * 256;
                        const float s1 = wave_sum(lp[ln_] * lp[64 + ln_]), s2 = wave_sum(lp[128 + ln_] * lp[192 + ln_]);
                        const float lam = __expf(s1) - __expf(s2) + a.lam_init[oi(l)];
                        const float osc = 1.0f - a.lam_init[oi(l)];
                        const float* dn = gfp(a.in[oi(9)]) + l * 128 + (ln_ & 15) * 8;
                        const f32x4 g0 = *(const f32x4*)dn * osc, g1 = *(const f32x4*)(dn + 4) * osc;
                        const size_t row0 = rb + (size_t)qb * 256 + wave * 32 + (ln_ >> 4);
#pragma unroll 2
                        for (int i = 0; i < 8; ++i) { const size_t m = row0 + 4 * i;
                            const u32x4 q0 = *(const u32x4*)((const bf16_t*)O0buf + m * 512 + hh * 128 + (ln_ & 15) * 8), q1 = *(const u32x4*)((const bf16_t*)O1buf + m * 512 + hh * 128 + (ln_ & 15) * 8);
#define BLO(w) __uint_as_float((w) << 16)
#define BHI(w) __uint_as_float((w) & 0xffff0000u)
                            const f32x4 d0 = (f32x4){BLO(q0.x), BHI(q0.x), BLO(q0.y), BHI(q0.y)} - (f32x4){BLO(q1.x), BHI(q1.x), BLO(q1.y), BHI(q1.y)} * lam;
                            const f32x4 d1 = (f32x4){BLO(q0.z), BHI(q0.z), BLO(q0.w), BHI(q0.w)} - (f32x4){BLO(q1.z), BHI(q1.z), BLO(q1.w), BHI(q1.w)} * lam;
#undef BLO
#undef BHI
                            float ss = (d0[0] * d0[0] + d0[1] * d0[1]) + (d0[2] * d0[2] + d0[3] * d0[3]) + (d1[0] * d1[0] + d1[1] * d1[1]) + (d1[2] * d1[2] + d1[3] * d1[3]);
                            ss += __shfl_xor(ss, 1); ss += __shfl_xor(ss, 2); ss += __shfl_xor(ss, 4); ss += __shfl_xor(ss, 8);
                            const float rs = __builtin_amdgcn_rsqf(ss * (1.0f / 128.0f) + 1e-5f);
                            pg8::store8(MRG + m * 1024 + 512 + hh * 128 + (ln_ & 15) * 8, d0 * rs * g0, d1 * rs * g1); }
                    }
                }
            }
        }
        PH_END()
        PH_BEGIN(4)
        { pg8::StaticOrder S; S.init(M, DM, G, obx());
          if (l == 0) { pg8::EpiY E{xres, Y, 1.0f}; pg8::gemm_phase(lds, MRG, DM, WoT + (size_t)l * DM * DM, DM, DM, S, E); }
          else { pg8::EpiYLN E{Y, ssq, gfp(a.in[oi(13)]) + (l - 1) * DM, gfp(a.in[oi(14)]) + (l - 1) * DM, 1.0f, 22};
                 pg8::gemm_phase(lds, MRG, DM, WoT + (size_t)l * DM * DM, DM, DM, S, E); } }
        PH_END()
        PH_BEGIN(5)
        { if (moe) ln_pass<0, true, true, true>(a, Y, nullptr, gfp(a.in[oi(11)]) + l * DM, gfp(a.in[oi(12)]) + l * DM, Xf, (bf16_t*)(ws + WS_XB8), gfp(a.in[oi(18)]) + (size_t)li * DM * 8, ctl + CW_CNT + 8 * li, gw, NGW, fresh_lane(), lds);
          else ln_pass<0, false, true, true>(a, Y, nullptr, gfp(a.in[oi(11)]) + l * DM, gfp(a.in[oi(12)]) + l * DM, Xf, (bf16_t*)(ws + WS_XB8), nullptr, nullptr, gw, NGW, fresh_lane(), lds);
          if (l == 2) cvt_moe(a, 1, scr, gw, NGW, fresh_lane()); }
        PH_END()
        if (!moe) {
            PH_BEGIN(6)
            { pg8::StaticOrder S; S.init(M, 2 * FFD, G, obx()); pg8::EpiSwiGLU8 E{(unsigned char*)ACT, FFD};
              pg8::gemm_phase<pg8::EpiSwiGLU8, pg8::StaticOrder, true>(lds, (const bf16_t*)(ws + WS_XB8), DM / 2, (const bf16_t*)((unsigned char*)WguT + (size_t)li * 2 * FFD * DM), DM / 2, DM / 2, S, E); }
            PH_END()
            PH_BEGIN(7)
            { pg8::StaticOrder S; S.init(M, DM, G, obx()); pg8::EpiYLN E{Y, ssq, gfp(a.in[oi(11)]) + l * DM, gfp(a.in[oi(12)]) + l * DM, 1.0f / (W8_D * A8_ACT), 20};
              pg8::gemm_phase<pg8::EpiYLN, pg8::StaticOrder, true>(lds, ACT, FFD / 2, (const bf16_t*)((unsigned char*)WdT + (size_t)li * DM * FFD), FFD / 2, FFD / 2, S, E); }
            PH_END()
            PH_BEGIN(8)
            { ln_pass<0, false, false, true>(a, Y, nullptr, gfp(a.in[oi(13)]) + l * DM, gfp(a.in[oi(14)]) + l * DM, nullptr, XB, nullptr, nullptr, gw, NGW, fresh_lane(), lds, nullptr, nullptr, 22); }
            PH_END()
        } else {
            unsigned* cnt = ctl + CW_CNT + 8 * li; unsigned* cur = ctl + CW_CUR + 8 * li;
            PH_BEGIN(9)
            {
                FRESH_LANE(lane_);
#define lane lane_
                int rbase[8]; { int acc = 0;
#pragma unroll
                    for (int e = 0; e < 8; ++e) { rbase[e] = acc * 256; acc += (__builtin_amdgcn_readfirstlane((int)__hip_atomic_load(cnt + e, __ATOMIC_RELAXED, __HIP_MEMORY_SCOPE_AGENT)) + 255) >> 8; } }
                const f32x4* route = (const f32x4*)(ws + WS_ROUTE); int* slots = (int*)(ws + WS_ROUTE + 512 * 1024);
                LAS unsigned* lc = (LAS unsigned*)(lds + 131072);
                unsigned long long pk = 0ull;
                for (int m = gw; m < M; m += NGW) { const f32x4 rt = route[m]; pk += (1ull << (8 * __float_as_int(rt[0]))) + (1ull << (8 * __float_as_int(rt[1]))); }
                if (lane < 8) lc[wave * 8 + lane] = (unsigned)((pk >> (8 * lane)) & 255ull);
                __syncthreads();
                if (wave == 0 && lane < 8) {
                    unsigned tot = 0u, pre[8];
#pragma unroll
                    for (int w = 0; w < 8; ++w) { pre[w] = tot; tot += lc[w * 8 + lane]; }
                    int rb = 0;
#pragma unroll
                    for (int e = 0; e < 8; ++e) if (e == lane) rb = rbase[e];
                    const unsigned base = atomicAdd(cur + lane, tot) + (unsigned)rb;
#pragma unroll
                    for (int w = 0; w < 8; ++w) lc[64 + w * 8 + lane] = base + pre[w];
                }
                __syncthreads();
                unsigned nb[8];
#pragma unroll
                for (int e = 0; e < 8; ++e) nb[e] = lc[64 + wave * 8 + e];
                for (int m = gw; m < M; m += NGW) {
                    const f32x4 rt = route[m]; const int e1 = __float_as_int(rt[0]), e2 = __float_as_int(rt[1]);
                    int s1 = 0, s2 = 0;
#pragma unroll
                    for (int e = 0; e < 8; ++e) { if (e == e1) { s1 = (int)nb[e]; nb[e]++; } if (e == e2) { s2 = (int)nb[e]; nb[e]++; } }
                    const u32x4 q = *((const u32x4*)((const unsigned char*)(ws + WS_XB8) + (size_t)m * DM) + lane);
                    *((u32x4*)((unsigned char*)XG + (size_t)s1 * DM) + lane) = q; *((u32x4*)((unsigned char*)XG + (size_t)s2 * DM) + lane) = q;
                    if (lane == 0) { slots[2 * m] = s1; slots[2 * m + 1] = s2; }
                }
#undef lane
            }
            PH_END()
            pg8::MoeOrder MO; { int t[8], tot = 0;
#pragma unroll
                for (int e = 0; e < 8; ++e) { t[e] = (__builtin_amdgcn_readfirstlane((int)__hip_atomic_load(cnt + e, __ATOMIC_RELAXED, __HIP_MEMORY_SCOPE_AGENT)) + 255) >> 8; tot += t[e]; }
                MO.t0 = t[0]; MO.t1 = t[1]; MO.t2 = t[2]; MO.t3 = t[3]; MO.t4 = t[4]; MO.t5 = t[5]; MO.t6 = t[6]; MO.t7 = t[7]; MO.G = G; MO.c = bx; MO.NT = 0; MO.total = tot; MO.ks = 1; MO.kh = 0; }
            PH_BEGIN(10)
            { pg8::MoeOrder S = MO; S.NT = 2 * FFE / 256; S.total = MO.total * S.NT; pg8::EpiSwiGLU8 E{(unsigned char*)MACT, FFE};
              pg8::gemm_phase<pg8::EpiSwiGLU8, pg8::MoeOrder, true>(lds, XG, DM / 2, MguT, DM / 2, DM / 2, S, E); }
            PH_END()
            PH_BEGIN(11)
            { pg8::MoeOrder S = MO; S.NT = DM / 256; S.ks = 2; S.kh = FFE / 4; S.total = MO.total * S.NT * 2; pg8::EpiF8 E{(unsigned char*)OSLOT, DM, (size_t)(WS_OSLOT2 - WS_OSLOT), O8 / (W8_D * A8_ACT)};
              pg8::gemm_phase<pg8::EpiF8, pg8::MoeOrder, true>(lds, MACT, FFE / 2, MdT, FFE / 2, FFE / 4, S, E); }
            PH_END()
            PH_BEGIN(12)
            { if (l == DEPTH - 1) ln_pass<1, false>(a, Y, nullptr, gfp(a.in[oi(13)]) + l * DM, gfp(a.in[oi(14)]) + l * DM, a.out + oz(), nullptr, nullptr, nullptr, gw, NGW, fresh_lane(), lds, gfp(a.in[oi(11)]) + l * DM, gfp(a.in[oi(12)]) + l * DM);
              else ln_pass<1, false, false, true, true>(a, Y, nullptr, gfp(a.in[oi(13)]) + l * DM, gfp(a.in[oi(14)]) + l * DM, nullptr, XB, nullptr, nullptr, gw, NGW, fresh_lane(), lds, gfp(a.in[oi(11)]) + l * DM, gfp(a.in[oi(12)]) + l * DM, 22); }
            PH_END()
        }
    }
#undef PH_BEGIN
#undef PH_END
}
#undef ws
#undef ctl
#undef tab
#undef ssq
#undef sskv
#undef Y
#undef XB
#undef Xf
constexpr int N_PHASES = 1 + 2 * 8 + 2 * 9;

extern "C" void kernel_launch(void* const* d_in, const int* in_sizes, int n_in, void* d_out, int out_size, void* d_ws, size_t ws_size, hipStream_t stream) {
    static int grid = 0;
    if (grid == 0) {
        if (n_in != 22 || in_sizes[0] != M * DM || out_size != M * DM || ws_size < WS_END) { fprintf(stderr, "kernel_launch: unexpected shapes (n_in %d, ws %zu)\n", n_in, ws_size); grid = -1; return; }
        int dev = 0, cus = 0, per_cu = 0;
        (void)hipGetDevice(&dev); (void)hipDeviceGetAttribute(&cus, hipDeviceAttributeMultiprocessorCount, dev);
        if (hipFuncSetAttribute((const void*)mega_fwd, hipFuncAttributeMaxDynamicSharedMemorySize, LDS_BYTES) != hipSuccess) { fprintf(stderr, "kernel_launch: hipFuncSetAttribute failed\n"); grid = -1; return; }
        if (hipOccupancyMaxActiveBlocksPerMultiprocessor(&per_cu, (const void*)mega_fwd, 512, LDS_BYTES) != hipSuccess || per_cu < 1) { fprintf(stderr, "kernel_launch: occupancy query says %d\n", per_cu); per_cu = 1; }
        (void)hipGetLastError();
        grid = cus * 1;
        if (grid <= 0) grid = 256;
    }
    if (grid < 0) return;
    (void)hipMemsetAsync((char*)d_ws + WS_CTL, 0, 1 * MiB, stream);
    Args a{};
    for (int i = 0; i < 22; ++i) a.in[i] = (const float*)d_in[i];
    a.out = (float*)d_out; a.ws = (unsigned char*)d_ws;
    for (int i = 0; i < 32; ++i) a.inv[i] = 1.0f / powf(10000.0f, (float)(2 * i) / 64.0f);
    for (int l = 0; l < 4; ++l) a.lam_init[l] = (float)(0.8 - 0.6 * exp(-0.3 * (double)l));
    for (int n = 0; n < 128; ++n) { int bkt;
        if (n < 16) bkt = n; else { const float nf = (float)n; const float v = logf(nf / 16.0f) / (float)log(8.0) * 16.0f; bkt = 16 + (int)v; if (bkt > 31) bkt = 31; }
        a.bucket[n] = (unsigned char)bkt; }
    {
        int di = 15, mi = 15;
        for (int e = 0; e < 32; ++e) { const float dc = di >= 0 ? 4.0f * (di + 1) : -1.f, mc = mi >= 0 ? 2.8f * (mi + 1) : -1.f;
            if (dc >= mc) { a.aq[e] = (unsigned short)((1 << 8) | di); --di; } else { a.aq[e] = (unsigned short)mi; --mi; } }
    }
#if MK_SPLIT
    for (int p = 0; p < N_PHASES; ++p) { a.ph_lo = p; a.ph_hi = p + 1; hipLaunchKernelGGL(mega_fwd, dim3(grid), dim3(512), LDS_BYTES, stream, a); }
#else
    a.ph_lo = 0; a.ph_hi = N_PHASES;
    void* args[] = {&a};
    hipError_t e = hipLaunchCooperativeKernel((const void*)mega_fwd, dim3(grid), dim3(512), args, LDS_BYTES, stream);
    if (e != hipSuccess) fprintf(stderr, "cooperative launch failed: %s (grid %d)\n", hipGetErrorString(e), grid);
#endif
}
```

```cpp
#include <hip/hip_runtime.h>
#include <hip/hip_cooperative_groups.h>
#include <cstdint>
#include <cstdio>
#include <cmath>
namespace cg = cooperative_groups;

#ifndef PIPE_MLA
#define PIPE_MLA true
#endif
#ifndef PIPE_DIFF
#define PIPE_DIFF true
#endif
#ifndef MK_SPLIT
#define MK_SPLIT 0
#endif

#define LAS __attribute__((address_space(3)))
typedef unsigned short bf16_t;
typedef short bf16x8 __attribute__((ext_vector_type(8)));
typedef short s16x4 __attribute__((ext_vector_type(4)));
typedef float f32x2 __attribute__((ext_vector_type(2)));
typedef float f32x4 __attribute__((ext_vector_type(4)));
typedef float f32x16 __attribute__((ext_vector_type(16)));
typedef unsigned u32x2 __attribute__((ext_vector_type(2)));
typedef unsigned u32x4 __attribute__((ext_vector_type(4)));
typedef int i32x4 __attribute__((ext_vector_type(4)));
typedef int i32x8 __attribute__((ext_vector_type(8)));

constexpr int M = 16384, DM = 1024, SEQ = 4096, DEPTH = 4;
constexpr int HC = 2304;
constexpr int QMC = 768, KVC = 1024;
constexpr int FFD = 2816, FFE = 3584, NEXP = 8;
constexpr int SLOTS = 32768 + 8 * 256;
constexpr float LOG2E = 1.4426950408889634f;
constexpr float DN_ALPHA = 1.681792830507429f;
constexpr int C_CQ = 0, C_CKV = 384, C_KR = 640, C_DQ = 704, C_DK = 1216, C_DV = 1728;

constexpr size_t MiB = 1u << 20;
constexpr size_t WS_CTL = 0, WS_TAB = 1 * MiB, WS_SS = 2 * MiB;
constexpr size_t WS_WIN = 4 * MiB, WS_WUQ = 22 * MiB, WS_WUKV = 25 * MiB, WS_WO = 27 * MiB, WS_WGU = 35 * MiB, WS_WD = 57 * MiB;
constexpr size_t WS_MGU = 68 * MiB, WS_MD = 180 * MiB;
constexpr size_t WS_X = 236 * MiB, WS_XB = 300 * MiB, WS_Y = 332 * MiB, WS_OV = 396 * MiB;
constexpr size_t WS_H = WS_OV, WS_QM = WS_OV + 72 * MiB, WS_KVB = WS_OV + 96 * MiB, WS_MRG = WS_OV + 128 * MiB, WS_O0 = WS_OV + 160 * MiB;
constexpr size_t WS_ACT = WS_OV;
constexpr size_t WS_XG = WS_OV, WS_MACT = WS_OV + 68 * MiB, WS_OSLOT = WS_OV + 306 * MiB;
constexpr size_t WS_ROUTE = WS_OV + 374 * MiB;
constexpr size_t WS_OSLOT2 = WS_OV + 376 * MiB;
constexpr size_t WS_XB8 = WS_OV + 444 * MiB;
constexpr size_t WS_END = WS_OV + 460 * MiB;
constexpr int CW_CNT = 0, CW_CUR = 64;

constexpr int LDS_BYTES = 147456;
constexpr float W8_GU = 64.0f, W8_D = 128.0f, A8_ACT = 8.0f, O8 = 64.0f;

__device__ __forceinline__ unsigned cvt_pk_bf16(float lo, float hi) { unsigned r; asm volatile("v_cvt_pk_bf16_f32 %0, %1, %2" : "=v"(r) : "v"(lo), "v"(hi)); return r; }
__device__ __forceinline__ i32x8 cat8(bf16x8 a, bf16x8 b) { const i32x4 x = __builtin_bit_cast(i32x4, a), y = __builtin_bit_cast(i32x4, b); return __builtin_shufflevector(x, y, 0, 1, 2, 3, 4, 5, 6, 7); }
__device__ __forceinline__ bf16x8 lo8(i32x8 v) { return __builtin_bit_cast(bf16x8, __builtin_shufflevector(v, v, 0, 1, 2, 3)); }
__device__ __forceinline__ bf16x8 hi8(i32x8 v) { return __builtin_bit_cast(bf16x8, __builtin_shufflevector(v, v, 4, 5, 6, 7)); }
__device__ __forceinline__ unsigned cvt4_fp8(float a, float b, float c, float d) { unsigned w = __builtin_amdgcn_cvt_pk_fp8_f32(a, b, 0u, false); return (unsigned)__builtin_amdgcn_cvt_pk_fp8_f32(c, d, (int)w, true); }
typedef _Float16 ystream_t;
typedef _Float16 h16x4 __attribute__((ext_vector_type(4)));
__device__ __forceinline__ f32x4 ld4h(const ystream_t* p) { return __builtin_convertvector(*(const h16x4*)p, f32x4); }
__device__ __forceinline__ void st4h(ystream_t* p, f32x4 v) { *(h16x4*)p = __builtin_convertvector(v, h16x4); }
__device__ __forceinline__ float bf2f(unsigned short b) { return __uint_as_float(((unsigned)b) << 16); }
__device__ __forceinline__ float wave_sum(float v) {
#pragma unroll
    for (int o = 1; o < 64; o <<= 1) v += __shfl_xor(v, o);
    return v;
}
__device__ __forceinline__ int fresh_lane() { int t = threadIdx.x; asm volatile("" : "+v"(t)); return t & 63; }
__device__ __forceinline__ int obx() { int b = blockIdx.x; asm volatile("" : "+s"(b)); return b; }
__device__ __forceinline__ int oi(int k) { asm volatile("" : "+s"(k)); return k; }
typedef __attribute__((address_space(1))) unsigned char* gptr_t;
typedef __attribute__((address_space(1))) const float* gfptr_t;
#if defined(__HIP_DEVICE_COMPILE__)
#define ASSUME_GLOBAL(p) __builtin_assume(!__builtin_amdgcn_is_shared((const __attribute__((address_space(0))) void*)(p)) && !__builtin_amdgcn_is_private((const __attribute__((address_space(0))) void*)(p)))
#else
#define ASSUME_GLOBAL(p) ((void)0)
#endif
__device__ __forceinline__ size_t oz() { size_t z = 0; asm volatile("" : "+s"(z)); return z; }
#define opq(p) ((p) + oz())
__device__ __forceinline__ const float* gfp(const float* p) { ASSUME_GLOBAL(p); return p; }
#define LDS_WAIT() asm volatile("s_waitcnt lgkmcnt(0)" ::: "memory")
#define VM_WAIT() asm volatile("s_waitcnt vmcnt(0)" ::: "memory")

namespace pg8 {
constexpr int BM = 256, BK = 64, HALF = 128, HTB = HALF * BK * 2, NXCD = 8, WGM = 8;
__host__ __device__ __forceinline__ int lds_byte(int r, int c) { const int st = (r >> 4) * 2 + (c >> 5), rr = r & 15, cc = c & 31, ob = rr * 64 + cc * 2; return st * 1024 + (ob ^ (((ob >> 9) & 1) << 5)); }
__host__ __device__ __forceinline__ void stage_rc(int b, int& R, int& C) { const int st = b / 1024, sb = b % 1024, swz = sb ^ (((sb >> 9) & 1) << 5); R = (st >> 1) * 16 + swz / 64; C = (st & 1) * 32 + (swz % 64) / 2; }
__host__ __device__ __forceinline__ int perm32(int rho) { const int n = rho >> 4, i = rho & 15; return 8 * (i >> 2) + 4 * n + (i & 3); }

struct Unit { int pm, pn, bt, ko, os; };

struct StaticOrder {
    int nM, nN, nwg, G, c;
    __device__ __forceinline__ void init(int Mr, int N, int G_, int c_) { nM = Mr / BM; nN = N / BM; nwg = nM * nN; G = G_; c = c_; }
    __device__ __forceinline__ bool next(int i, Unit& u) const {
        const long L = (long)i * G + c; if (L >= nwg) return false;
        int wgid = (int)L; { const int q = nwg / NXCD, r = nwg % NXCD, xcd = wgid % NXCD, off = wgid / NXCD; wgid = (xcd < r ? xcd * (q + 1) : r * (q + 1) + (xcd - r) * q) + off; }
        const int nig = WGM * nN, gid = wgid / nig, fm = gid * WGM, gsz = (nM - fm) < WGM ? (nM - fm) : WGM;
        u.pm = fm + ((wgid % nig) % gsz); u.pn = (wgid % nig) / gsz; u.bt = u.pn; u.ko = 0; u.os = 0; return true;
    }
};
struct OneUnit {
    int pm, pn; bool valid;
    __device__ __forceinline__ bool next(int i, Unit& u) const { if (i != 0 || !valid) return false; u.pm = pm; u.pn = pn; u.bt = pn; u.ko = 0; u.os = 0; return true; }
};
struct MoeOrder {
    int t0, t1, t2, t3, t4, t5, t6, t7; int NT, G, c, total, ks, kh;
    __device__ __forceinline__ bool next(int i, Unit& u) const {
        const int cc = (G % 8 == 0) ? (c % 8) * (G / 8) + c / 8 : c;
        const long L = (long)i * G + cc; if (L >= total) return false;
        int acc = 0, e = 0, base = 0, te = 1;
#define MO_STEP(j, tj) { if (tj > 0 && L >= (long)acc * NT * ks) { e = j; base = acc; te = tj; } acc += tj; }
        MO_STEP(0, t0) MO_STEP(1, t1) MO_STEP(2, t2) MO_STEP(3, t3) MO_STEP(4, t4) MO_STEP(5, t5) MO_STEP(6, t6) MO_STEP(7, t7)
#undef MO_STEP
        const int loc = (int)(L - (long)base * NT * ks), sp = loc % ks, rest = loc / ks;
        u.pm = base + rest % te; u.pn = rest / te; u.bt = e * NT + u.pn; u.ko = sp * kh; u.os = sp; return true;
    }
};

template <class Epi, class Sched, bool F8 = false>
__device__ __forceinline__ void gemm_phase(LAS unsigned char* lds, const bf16_t* Ag, int lda, const bf16_t* Btg, int ldb, int K, const Sched& S, const Epi& E) {
    asm volatile("" : "+s"(K));
    int tid_ = threadIdx.x; asm volatile("" : "+v"(tid_));
    const int tid = tid_, wid = __builtin_amdgcn_readfirstlane(tid >> 6), lane = tid & 63, wr = wid >> 2, wc = wid & 3, fr = lane & 15, fq = lane >> 4;
    const int nt = K / BK;
    unsigned voffA[2], voffB[2];
#pragma unroll
    for (int i = 0; i < 2; ++i) { int R, C; stage_rc(tid * 16 + i * 8192, R, C); const int Rb = Epi::PERM ? ((R & ~31) + perm32(R & 31)) : R;
        voffA[i] = (unsigned)(R * lda + C) * 2u; voffB[i] = (unsigned)(Rb * ldb + C) * 2u; }
    const size_t kstep = (size_t)(BK * 2);
    const size_t hstepA = (size_t)HALF * lda * 2, hstepB = (size_t)HALF * ldb * 2;
    const size_t tstepA = 2 * hstepA, tstepB = 2 * hstepB;
    const unsigned ldsw = (unsigned)wid * 1024u;
    const int aoff = lds_byte(wr * 64 + fr, fq * 8), boff = lds_byte(wc * 32 + fr, fq * 8);
#define PG8_SA(b, h) (((b) * 2 + (h)) * HTB)
#define PG8_SB(b, h) ((4 + (b) * 2 + (h)) * HTB)
#define PG8_STAGE(bufoff, gbase, voff) do { _Pragma("unroll") for (int _i = 0; _i < 2; ++_i) \
        __builtin_amdgcn_global_load_lds((const unsigned*)((const char*)(gbase) + (voff)[_i]), (LAS unsigned*)(lds + (bufoff) + ldsw + _i * 8192), 16, 0, 0); } while (0)
#define PG8_LDA(dst, b, h) do { _Pragma("unroll") for (int m = 0; m < 4; ++m) dst[m] = cat8(*(const LAS bf16x8*)(lds + PG8_SA(b, h) + aoff + m * 2048), *(const LAS bf16x8*)(lds + PG8_SA(b, h) + aoff + m * 2048 + 1024)); } while (0)
#define PG8_LDB(dst, b, h) do { _Pragma("unroll") for (int n = 0; n < 2; ++n) dst[n] = cat8(*(const LAS bf16x8*)(lds + PG8_SB(b, h) + boff + n * 2048), *(const LAS bf16x8*)(lds + PG8_SB(b, h) + boff + n * 2048 + 1024)); } while (0)
#define PG8_MMA(ai, bj, At, Bt) do { __builtin_amdgcn_s_setprio(1); _Pragma("unroll") for (int m = 0; m < 4; ++m) _Pragma("unroll") for (int n = 0; n < 2; ++n) { \
        if constexpr (F8) asm volatile("v_mfma_f32_16x16x128_f8f6f4 %0, %1, %2, %0" : "+v"(acc[ai][bj][m][n]) : "v"(Bt[n]), "v"(At[m]));   \
        else { acc[ai][bj][m][n] = __builtin_amdgcn_mfma_f32_16x16x32_bf16(lo8(Bt[n]), lo8(At[m]), acc[ai][bj][m][n], 0, 0, 0); \
               acc[ai][bj][m][n] = __builtin_amdgcn_mfma_f32_16x16x32_bf16(hi8(Bt[n]), hi8(At[m]), acc[ai][bj][m][n], 0, 0, 0); } } \
        __builtin_amdgcn_s_setprio(0); } while (0)
#define PG8_WAIT_V(n) asm volatile("s_waitcnt vmcnt(" #n ")" ::: "memory")
#define PG8_WAIT_L(n) asm volatile("s_waitcnt lgkmcnt(" #n ")" ::: "memory")
#define PG8_BAR __builtin_amdgcn_s_barrier()
#define PG8_SCHED __builtin_amdgcn_sched_barrier(0)
    Unit cur, nxt; int ui = 0;
    if (!S.next(0, cur)) return;
    f32x4 acc[2][2][4][2];
#pragma unroll
    for (int a = 0; a < 2; ++a)
#pragma unroll
        for (int b = 0; b < 2; ++b)
#pragma unroll
            for (int m = 0; m < 4; ++m)
#pragma unroll
                for (int n = 0; n < 2; ++n) acc[a][b][m][n] = (f32x4){0.f, 0.f, 0.f, 0.f};
    i32x8 At[4], B0[2], B1[2];
    const char* cA = (const char*)Ag + (size_t)cur.pm * tstepA + (size_t)cur.ko * 2; const char* cB = (const char*)Btg + (size_t)cur.bt * tstepB + (size_t)cur.ko * 2;
    PG8_STAGE(PG8_SB(0, 0), cB, voffB); PG8_STAGE(PG8_SB(0, 1), cB + hstepB, voffB); PG8_STAGE(PG8_SA(0, 0), cA, voffA); PG8_STAGE(PG8_SA(0, 1), cA + hstepA, voffA);
    if (wr == 1) PG8_BAR;
    PG8_WAIT_V(2); PG8_BAR;
    PG8_STAGE(PG8_SB(1, 0), cB + kstep, voffB); PG8_STAGE(PG8_SA(1, 0), cA + kstep, voffA); PG8_STAGE(PG8_SB(1, 1), cB + hstepB + kstep, voffB);
    PG8_WAIT_V(6); PG8_BAR;
    for (;;) {
        const bool has_next = S.next(ui + 1, nxt);
        const char* nA = has_next ? (const char*)Ag + (size_t)nxt.pm * tstepA + (size_t)nxt.ko * 2 : cA; const char* nB = has_next ? (const char*)Btg + (size_t)nxt.bt * tstepB + (size_t)nxt.ko * 2 : cB;
        for (int t = 0; t < nt; t += 2) {
            const bool last = (t == nt - 2);
            const char* a1 = cA + (size_t)(t + 1) * kstep;
            const char* a2 = last ? nA : cA + (size_t)(t + 2) * kstep; const char* b2 = last ? nB : cB + (size_t)(t + 2) * kstep;
            const char* a3 = a2 + kstep; const char* b3 = b2 + kstep;
            PG8_LDB(B0, 0, 0); PG8_LDB(B1, 0, 1); PG8_SCHED; PG8_LDA(At, 0, 0); PG8_STAGE(PG8_SA(1, 1), a1 + hstepA, voffA);
            PG8_WAIT_V(8); PG8_WAIT_L(0); PG8_BAR; PG8_MMA(0, 0, At, B0); PG8_MMA(0, 1, At, B1); PG8_BAR; PG8_SCHED;
            PG8_LDA(At, 0, 1); PG8_STAGE(PG8_SB(0, 0), b2, voffB); PG8_STAGE(PG8_SB(0, 1), b2 + hstepB, voffB); PG8_STAGE(PG8_SA(0, 0), a2, voffA);
            PG8_WAIT_V(8); PG8_WAIT_L(0); PG8_BAR; PG8_MMA(1, 0, At, B0); PG8_MMA(1, 1, At, B1); PG8_BAR; PG8_SCHED;
            PG8_LDB(B0, 1, 0); PG8_LDB(B1, 1, 1); PG8_SCHED; PG8_LDA(At, 1, 0); PG8_STAGE(PG8_SA(0, 1), a2 + hstepA, voffA);
            PG8_WAIT_V(8); PG8_WAIT_L(0); PG8_BAR; PG8_MMA(0, 0, At, B0); PG8_MMA(0, 1, At, B1); PG8_BAR; PG8_SCHED;
            PG8_LDA(At, 1, 1); PG8_STAGE(PG8_SB(1, 0), b3, voffB); PG8_STAGE(PG8_SB(1, 1), b3 + hstepB, voffB); PG8_STAGE(PG8_SA(1, 0), a3, voffA);
            PG8_WAIT_V(8); PG8_WAIT_L(0); PG8_BAR; PG8_MMA(1, 0, At, B0); PG8_MMA(1, 1, At, B1); PG8_BAR; PG8_SCHED;
        }
        if (wr == 0) PG8_BAR;
        if constexpr (F8) asm volatile("s_nop 15\n\ts_nop 15\n\ts_nop 15" ::: "memory");
        E(acc, cur, wr, wc, fr, fq);
        if (!has_next) break;
#pragma unroll
        for (int a = 0; a < 2; ++a)
#pragma unroll
            for (int b = 0; b < 2; ++b)
#pragma unroll
                for (int m = 0; m < 4; ++m)
#pragma unroll
                    for (int n = 0; n < 2; ++n) acc[a][b][m][n] = (f32x4){0.f, 0.f, 0.f, 0.f};
        cur = nxt; cA = nA; cB = nB; ++ui;
        if (wr == 1) PG8_BAR;
    }
    PG8_WAIT_V(0);
    PG8_BAR;
#undef PG8_SA
#undef PG8_SB
#undef PG8_STAGE
#undef PG8_LDA
#undef PG8_LDB
#undef PG8_MMA
#undef PG8_WAIT_V
#undef PG8_WAIT_L
#undef PG8_BAR
#undef PG8_SCHED
}

__device__ __forceinline__ void store8(bf16_t* p, f32x4 v0, f32x4 v1) {
    u32x4 w; w.x = cvt_pk_bf16(v0[0], v0[1]); w.y = cvt_pk_bf16(v0[2], v0[3]); w.z = cvt_pk_bf16(v1[0], v1[1]); w.w = cvt_pk_bf16(v1[2], v1[3]);
    *(u32x4*)p = w;
}
__device__ __forceinline__ void rope8(f32x4& v0, f32x4& v1, const float* cs) {
    const f32x4 c0 = *(const f32x4*)cs, c1 = *(const f32x4*)(cs + 4);
    f32x4 o0, o1;
    o0[0] = v0[0] * c0[0] - v0[1] * c0[1]; o0[1] = v0[1] * c0[0] + v0[0] * c0[1];
    o0[2] = v0[2] * c0[2] - v0[3] * c0[3]; o0[3] = v0[3] * c0[2] + v0[2] * c0[3];
    o1[0] = v1[0] * c1[0] - v1[1] * c1[1]; o1[1] = v1[1] * c1[0] + v1[0] * c1[1];
    o1[2] = v1[2] * c1[2] - v1[3] * c1[3]; o1[3] = v1[3] * c1[2] + v1[2] * c1[3];
    v0 = o0; v1 = o1;
}
struct EpiH {
    static constexpr bool PERM = true;
    bf16_t* H; float* ssq; float* sskv; const float* tab;
    __device__ __forceinline__ void operator()(const f32x4 (&acc)[2][2][4][2], const Unit& u, int wr, int wc, int fr, int fq) const {
        const int row0 = u.pm * BM + wr * 64 + fr;
#pragma unroll
        for (int bj = 0; bj < 2; ++bj) {
            const int g32 = u.pn * BM + bj * HALF + wc * 32, col0 = g32 + 8 * fq;
            const int seg = g32 < C_CKV ? 0 : (g32 < C_KR ? 1 : (g32 < C_DQ ? 2 : 3));
#pragma unroll
            for (int ai = 0; ai < 2; ++ai)
#pragma unroll
                for (int m = 0; m < 4; ++m) {
                    const int row = row0 + ai * HALF + m * 16;
                    f32x4 v0 = acc[ai][bj][m][0], v1 = acc[ai][bj][m][1];
                    if (seg < 2) {
                        float s = (v0[0] * v0[0] + v0[1] * v0[1]) + (v0[2] * v0[2] + v0[3] * v0[3]) + (v1[0] * v1[0] + v1[1] * v1[1]) + (v1[2] * v1[2] + v1[3] * v1[3]);
                        s += __shfl_xor(s, 16); s += __shfl_xor(s, 32);
                        if (fq == 0) ssq[(size_t)row * 32 + (g32 >> 5)] = s;
                    } else if (seg == 2) {
                        rope8(v0, v1, tab + (size_t)(row & (SEQ - 1)) * 64 + (col0 - C_KR));
                    }
                    store8(H + (size_t)row * HC + col0, v0, v1);
                    asm volatile("" ::: "memory");
                }
        }
    }
};
struct EpiQ {
    static constexpr bool PERM = true;
    bf16_t* Q; const float* ssq; const float* tab;
    __device__ __forceinline__ void operator()(const f32x4 (&acc)[2][2][4][2], const Unit& u, int wr, int wc, int fr, int fq) const {
        const int row0 = u.pm * BM + wr * 64 + fr;
#pragma unroll
        for (int ai = 0; ai < 2; ++ai)
#pragma unroll
            for (int m = 0; m < 4; ++m) {
                const int row = row0 + ai * HALF + m * 16;
                const f32x4 q0 = *(const f32x4*)(ssq + (size_t)row * 32), q1 = *(const f32x4*)(ssq + (size_t)row * 32 + 4), q2 = *(const f32x4*)(ssq + (size_t)row * 32 + 8);
                const float rs = __builtin_amdgcn_rsqf((((q0[0] + q0[1]) + (q0[2] + q0[3])) + ((q1[0] + q1[1]) + (q1[2] + q1[3])) + ((q2[0] + q2[1]) + (q2[2] + q2[3]))) * (1.0f / 384.0f) + 1e-6f);
#pragma unroll
                for (int bj = 0; bj < 2; ++bj) {
                    const int g32 = u.pn * BM + bj * HALF + wc * 32, col0 = g32 + 8 * fq;
                    const int inh = g32 % 192;
                    f32x4 v0 = acc[ai][bj][m][0] * rs, v1 = acc[ai][bj][m][1] * rs;
                    if (inh >= 128) rope8(v0, v1, tab + (size_t)(row & (SEQ - 1)) * 64 + (inh - 128 + 8 * fq));
                    store8(Q + (size_t)row * QMC + col0, v0, v1);
                }
                asm volatile("" ::: "memory");
            }
    }
};
struct EpiKV {
    static constexpr bool PERM = true;
    bf16_t* O; const float* sskv;
    __device__ __forceinline__ void operator()(const f32x4 (&acc)[2][2][4][2], const Unit& u, int wr, int wc, int fr, int fq) const {
        const int row0 = u.pm * BM + wr * 64 + fr;
#pragma unroll
        for (int ai = 0; ai < 2; ++ai)
#pragma unroll
            for (int m = 0; m < 4; ++m) {
                const int row = row0 + ai * HALF + m * 16;
                const f32x4 q0 = *(const f32x4*)(sskv + (size_t)row * 32 + 12), q1 = *(const f32x4*)(sskv + (size_t)row * 32 + 16);
                const float rs = __builtin_amdgcn_rsqf((((q0[0] + q0[1]) + (q0[2] + q0[3])) + ((q1[0] + q1[1]) + (q1[2] + q1[3]))) * (1.0f / 256.0f) + 1e-6f);
#pragma unroll
                for (int bj = 0; bj < 2; ++bj) {
                    const int col0 = u.pn * BM + bj * HALF + wc * 32 + 8 * fq;
                    store8(O + (size_t)row * KVC + col0, acc[ai][bj][m][0] * rs, acc[ai][bj][m][1] * rs);
                }
            }
    }
};
struct EpiY {
    static constexpr bool PERM = false;
    const float* X; ystream_t* Y; float asc;
    __device__ __forceinline__ void operator()(const f32x4 (&acc)[2][2][4][2], const Unit& u, int wr, int wc, int fr, int fq) const {
        const int row0 = u.pm * BM + wr * 64 + fr, colb = u.pn * BM + wc * 32 + 4 * fq;
#pragma unroll
        for (int ai = 0; ai < 2; ++ai)
#pragma unroll
            for (int m = 0; m < 4; ++m) {
                const size_t off = (size_t)(row0 + ai * HALF + m * 16) * DM + colb;
#pragma unroll
                for (int bj = 0; bj < 2; ++bj)
#pragma unroll
                    for (int n = 0; n < 2; ++n) { const f32x4 xv = *(const f32x4*)(X + off + bj * HALF + n * 16); st4h(Y + off + bj * HALF + n * 16, xv * DN_ALPHA + acc[ai][bj][m][n] * asc); }
            }
    }
};
struct EpiYLN {
    static constexpr bool PERM = false;
    ystream_t* Y; const float* st; const float* g; const float* b; float asc; int so;
    __device__ __forceinline__ void operator()(const f32x4 (&acc)[2][2][4][2], const Unit& u, int wr, int wc, int fr, int fq) const {
        const int row0 = u.pm * BM + wr * 64 + fr, colb = u.pn * BM + wc * 32 + 4 * fq;
#pragma unroll
        for (int ai = 0; ai < 2; ++ai)
#pragma unroll
            for (int m = 0; m < 4; ++m) {
                const int row = row0 + ai * HALF + m * 16;
                const float mu = st[(size_t)row * 32 + so], rs = st[(size_t)row * 32 + so + 1];
                const size_t off = (size_t)row * DM + colb;
#pragma unroll
                for (int bj = 0; bj < 2; ++bj)
#pragma unroll
                    for (int n = 0; n < 2; ++n) { const int c = colb + bj * HALF + n * 16;
                        const f32x4 gv = *(const f32x4*)(g + c), bv = *(const f32x4*)(b + c), yv = ld4h(Y + off + bj * HALF + n * 16);
                        st4h(Y + off + bj * HALF + n * 16, ((yv - mu) * rs * gv + bv) * DN_ALPHA + acc[ai][bj][m][n] * asc); }
                asm volatile("" ::: "memory");
            }
    }
};
struct EpiSwiGLU {
    static constexpr bool PERM = true;
    bf16_t* O; int ldo;
    __device__ __forceinline__ void operator()(const f32x4 (&acc)[2][2][4][2], const Unit& u, int wr, int wc, int fr, int fq) const {
        const int row0 = u.pm * BM + wr * 64 + fr, col0 = u.pn * HALF + wc * 32 + 8 * fq;
#pragma unroll
        for (int ai = 0; ai < 2; ++ai)
#pragma unroll
            for (int m = 0; m < 4; ++m) {
                f32x4 r[2];
#pragma unroll
                for (int n = 0; n < 2; ++n) { const f32x4 g = acc[ai][0][m][n], up = acc[ai][1][m][n];
#pragma unroll
                    for (int j = 0; j < 4; ++j) { const float e = __builtin_amdgcn_exp2f(-g[j] * LOG2E); r[n][j] = g[j] * __builtin_amdgcn_rcpf(1.0f + e) * up[j]; } }
                store8(O + (size_t)(row0 + ai * HALF + m * 16) * ldo + col0, r[0], r[1]);
            }
    }
};
struct EpiSwiGLU8 {
    static constexpr bool PERM = true;
    unsigned char* O; int ldo;
    __device__ __forceinline__ u32x2 act8(const f32x4 (&acc)[2][2][4][2], int ai, int m) const {
        f32x4 r[2];
#pragma unroll
        for (int n = 0; n < 2; ++n) { const f32x4 g = acc[ai][0][m][n] * (1.0f / W8_GU), up = acc[ai][1][m][n] * (A8_ACT / W8_GU);
#pragma unroll
            for (int j = 0; j < 4; ++j) { const float e = __builtin_amdgcn_exp2f(-g[j] * LOG2E); r[n][j] = g[j] * __builtin_amdgcn_rcpf(1.0f + e) * up[j]; } }
        u32x2 w; w.x = cvt4_fp8(r[0][0], r[0][1], r[0][2], r[0][3]); w.y = cvt4_fp8(r[1][0], r[1][1], r[1][2], r[1][3]); return w;
    }
    __device__ __forceinline__ void operator()(const f32x4 (&acc)[2][2][4][2], const Unit& u, int wr, int wc, int fr, int fq) const {
        const int row0 = u.pm * BM + wr * 64 + fr, colp = u.pn * HALF + wc * 32 + 16 * (fq >> 1);
#pragma unroll
        for (int ai = 0; ai < 2; ++ai)
#pragma unroll
            for (int mp = 0; mp < 2; ++mp) {
                const u32x2 wa = act8(acc, ai, 2 * mp), wb = act8(acc, ai, 2 * mp + 1);
                const auto sx = __builtin_amdgcn_permlane16_swap(wa.x, wb.x, false, false);
                const auto sy = __builtin_amdgcn_permlane16_swap(wa.y, wb.y, false, false);
                u32x4 o; o.x = sx[0]; o.y = sy[0]; o.z = sx[1]; o.w = sy[1];
                const int m = 2 * mp + (fq & 1);
                *(u32x4*)(O + (size_t)(row0 + ai * HALF + m * 16) * ldo + colp) = o;
            }
    }
};
struct EpiBf16 {
    static constexpr bool PERM = true;
    bf16_t* O; int ldo; size_t sstride; float osc;
    __device__ __forceinline__ void operator()(const f32x4 (&acc)[2][2][4][2], const Unit& u, int wr, int wc, int fr, int fq) const {
        const int row0 = u.pm * BM + wr * 64 + fr;
#pragma unroll
        for (int ai = 0; ai < 2; ++ai)
#pragma unroll
            for (int m = 0; m < 4; ++m)
#pragma unroll
                for (int bj = 0; bj < 2; ++bj)
                    store8(O + (size_t)u.os * sstride + (size_t)(row0 + ai * HALF + m * 16) * ldo + u.pn * BM + bj * HALF + wc * 32 + 8 * fq, acc[ai][bj][m][0] * osc, acc[ai][bj][m][1] * osc);
    }
};
struct EpiF8 {
    static constexpr bool PERM = true;
    unsigned char* O; int ldo; size_t sstride; float osc;
    __device__ __forceinline__ void operator()(const f32x4 (&acc)[2][2][4][2], const Unit& u, int wr, int wc, int fr, int fq) const {
        const int row0 = u.pm * BM + wr * 64 + fr;
        unsigned char* base = O + (size_t)u.os * sstride + u.pn * BM + wc * 32 + 16 * (fq >> 1);
#pragma unroll
        for (int ai = 0; ai < 2; ++ai)
#pragma unroll
            for (int mp = 0; mp < 2; ++mp)
#pragma unroll
                for (int bj = 0; bj < 2; ++bj) {
                    const f32x4 a0 = acc[ai][bj][2 * mp][0] * osc, a1 = acc[ai][bj][2 * mp][1] * osc, b0 = acc[ai][bj][2 * mp + 1][0] * osc, b1 = acc[ai][bj][2 * mp + 1][1] * osc;
                    const unsigned wax = cvt4_fp8(a0[0], a0[1], a0[2], a0[3]), way = cvt4_fp8(a1[0], a1[1], a1[2], a1[3]);
                    const unsigned wbx = cvt4_fp8(b0[0], b0[1], b0[2], b0[3]), wby = cvt4_fp8(b1[0], b1[1], b1[2], b1[3]);
                    const auto sx = __builtin_amdgcn_permlane16_swap(wax, wbx, false, false);
                    const auto sy = __builtin_amdgcn_permlane16_swap(way, wby, false, false);
                    u32x4 o; o.x = sx[0]; o.y = sy[0]; o.z = sx[1]; o.w = sy[1];
                    const int m = 2 * mp + (fq & 1);
                    *(u32x4*)(base + (size_t)(row0 + ai * HALF + m * 16) * ldo + bj * HALF) = o;
                }
    }
};
}

namespace att {
constexpr int NW = 8, QBLK = 32, KVBLK = 64, QB = 256;
constexpr int SHM_V = KVBLK * 128 * 2;
constexpr int LDS_K = 2 * SHM_V, LDS_WS = LDS_K + 2 * 64 * 192 * 2, LDS_BIAS = LDS_WS + NW * 64 * 4, LDS_QR = LDS_BIAS + 512;
#define SBAR() __builtin_amdgcn_sched_barrier(0)
__device__ __forceinline__ int v_st(int k, int c) { const int kk = (k & ~0xC) | ((k & 4) << 1) | ((k & 8) >> 1); return ((kk >> 3) * 4 + (c >> 5)) * 512 + ((kk & 7) * 32 + (c & 31)) * 2; }
__device__ __forceinline__ int v_rd_base(int lane) { return ((lane & 3) << 3) | (((lane >> 2) & 3) << 6) | (((lane >> 4) & 1) << 5) | (((lane >> 5) & 1) << 8); }
constexpr int v_rd_off(int d0, int ks, int half) { return d0 * 512 + ks * 4096 + half * 2048; }
__device__ __forceinline__ int crow(int r, int hi) { return (r & 3) + 8 * (r >> 2) + 4 * hi; }
__device__ __forceinline__ unsigned cvtpk(float lo, float hi) { unsigned r; asm volatile("v_cvt_pk_bf16_f32 %0, %1, %2" : "=v"(r) : "v"(lo), "v"(hi)); return r; }

__device__ __forceinline__ void mask_tile(f32x16& p0, f32x16& p1, int dq) {
    const float NEG = -__builtin_inff();
#pragma unroll
    for (int r = 0; r < 16; ++r) {
        const int c = (r & 3) + 8 * (r >> 2);
        if (dq - c < 0) p0[r] = NEG;
        if (dq - c - 32 < 0) p1[r] = NEG;
    }
}
__device__ __forceinline__ void bias_tile(f32x16& p0, f32x16& p1, int dq, const float* tb) {
#pragma unroll
    for (int r = 0; r < 16; ++r) {
        const int c = (r & 3) + 8 * (r >> 2);
        int d0 = dq - c, d1 = dq - c - 32;
        d0 = d0 < 0 ? 0 : (d0 > 127 ? 127 : d0); d1 = d1 < 0 ? 0 : (d1 > 127 ? 127 : d1);
        p0[r] += tb[d0]; p1[r] += tb[d1];
    }
}
constexpr float THR = 8.f;
__device__ __forceinline__ void partialSM(f32x16& p0, f32x16& p1, float& m_reg, float& mn, float& alpha) {
    float pmax = p0[0];
#pragma unroll
    for (int r = 1; r < 16; ++r) pmax = fmaxf(pmax, p0[r]);
#pragma unroll
    for (int r = 0; r < 16; ++r) pmax = fmaxf(pmax, p1[r]);
    { auto rr = __builtin_amdgcn_permlane32_swap(__float_as_uint(pmax), __float_as_uint(pmax), false, false);
      pmax = fmaxf(__uint_as_float(rr[0]), __uint_as_float(rr[1])); }
    if (__builtin_expect(__all((pmax - m_reg) <= THR), 1)) { mn = m_reg; alpha = 1.f; }
    else { mn = fmaxf(m_reg, pmax); alpha = __builtin_amdgcn_exp2f(m_reg - mn); m_reg = mn; }
#pragma unroll
    for (int r = 0; r < 16; ++r) p0[r] = p0[r] - mn;
#pragma unroll
    for (int r = 0; r < 16; ++r) p1[r] = p1[r] - mn;
#pragma unroll
    for (int r = 0; r < 16; ++r) p0[r] = __builtin_amdgcn_exp2f(p0[r]);
}
__device__ __forceinline__ void finishSM(f32x16& p0, f32x16& p1, float alpha, float& l_reg, bf16x8& pa0, bf16x8& pa1, bf16x8& pa2, bf16x8& pa3) {
#pragma unroll
    for (int r = 0; r < 16; ++r) p1[r] = __builtin_amdgcn_exp2f(p1[r]);
    float ps = 0;
#pragma unroll
    for (int r = 0; r < 16; ++r) ps += p0[r];
#pragma unroll
    for (int r = 0; r < 16; ++r) ps += p1[r];
    { auto rr = __builtin_amdgcn_permlane32_swap(__float_as_uint(ps), __float_as_uint(ps), false, false);
      ps = __uint_as_float(rr[0]) + __uint_as_float(rr[1]); }
    l_reg = l_reg * alpha + ps;
#define PK4(P, B_, OUT) do { unsigned a0 = cvtpk(P[B_+0], P[B_+1]), a1 = cvtpk(P[B_+2], P[B_+3]);                          \
        unsigned b0 = cvtpk(P[B_+4], P[B_+5]), b1 = cvtpk(P[B_+6], P[B_+7]);                                             \
        auto r0 = __builtin_amdgcn_permlane32_swap(a0, b0, false, false); auto r1 = __builtin_amdgcn_permlane32_swap(a1, b1, false, false); \
        u32x4 w = {r0[0], r1[0], r0[1], r1[1]}; OUT = *reinterpret_cast<bf16x8*>(&w); } while (0)
    PK4(p0, 0, pa0); PK4(p0, 8, pa1); PK4(p1, 0, pa2); PK4(p1, 8, pa3);
#undef PK4
}
template <int DQK> __device__ __forceinline__ int kswz(int row, int colB) { return row * (DQK * 2) + (colB ^ ((row & 7) << 4)); }
template <int KB, int DQK>
__device__ __forceinline__ void qkt(f32x16& p0, f32x16& p1, const char* K_lds, int r32, int hi, const bf16x8* qr, const char* qrl) {
    constexpr int SHMK = 64 * DQK * 2, NF = DQK / 16, NFR = NF > 8 ? 8 : NF;
    p0 = f32x16{}; p1 = f32x16{};
    const char* kb[4];
#pragma unroll
    for (int dd = 0; dd < 4; ++dd) kb[dd] = K_lds + KB * SHMK + kswz<DQK>(r32, (dd * 16 + hi * 8) * 2);
#pragma unroll
    for (int d0 = 0; d0 < NF; ++d0) { const char* a = kb[d0 & 3] + (d0 >> 2) * 128;
        bf16x8 b0 = *reinterpret_cast<const bf16x8*>(a);
        bf16x8 b1 = *reinterpret_cast<const bf16x8*>(a + 32 * DQK * 2);
        bf16x8 q; if (d0 < NFR) q = qr[d0]; else q = *reinterpret_cast<const bf16x8*>(qrl + (d0 - NFR) * 1024);
        p0 = __builtin_amdgcn_mfma_f32_32x32x16_bf16(b0, q, p0, 0, 0, 0);
        p1 = __builtin_amdgcn_mfma_f32_32x32x16_bf16(b1, q, p1, 0, 0, 0); }
}
template <int VB>
__device__ __forceinline__ void pv_tile(f32x16* o, int vb0, bf16x8 pa0, bf16x8 pa1, bf16x8 pa2, bf16x8 pa3) {
#define TRRD(dst, off) asm volatile("ds_read_b64_tr_b16 %0, %1 offset:%2" : "=&v"(dst) : "v"(vb0), "i"(off) : "memory")
#define PV_D0(d0) do { s16x4 l0, l1, l2, l3, h0, h1, h2, h3; constexpr int b_ = VB * SHM_V + v_rd_off(d0, 0, 0); \
        TRRD(l0, b_); TRRD(h0, b_ + 2048); TRRD(l1, b_ + 4096); TRRD(h1, b_ + 6144); TRRD(l2, b_ + 8192); TRRD(h2, b_ + 10240); TRRD(l3, b_ + 12288); TRRD(h3, b_ + 14336); \
        asm volatile("s_waitcnt lgkmcnt(0)" ::: "memory"); SBAR();   \
        o[d0] = __builtin_amdgcn_mfma_f32_32x32x16_bf16(pa0, (bf16x8){l0[0], l0[1], l0[2], l0[3], h0[0], h0[1], h0[2], h0[3]}, o[d0], 0, 0, 0);   \
        o[d0] = __builtin_amdgcn_mfma_f32_32x32x16_bf16(pa1, (bf16x8){l1[0], l1[1], l1[2], l1[3], h1[0], h1[1], h1[2], h1[3]}, o[d0], 0, 0, 0);   \
        o[d0] = __builtin_amdgcn_mfma_f32_32x32x16_bf16(pa2, (bf16x8){l2[0], l2[1], l2[2], l2[3], h2[0], h2[1], h2[2], h2[3]}, o[d0], 0, 0, 0);   \
        o[d0] = __builtin_amdgcn_mfma_f32_32x32x16_bf16(pa3, (bf16x8){l3[0], l3[1], l3[2], l3[3], h3[0], h3[1], h3[2], h3[3]}, o[d0], 0, 0, 0); } while (0)
    PV_D0(0); PV_D0(1); PV_D0(2); PV_D0(3);
#undef PV_D0
#undef TRRD
}

struct AttnArgs {
    const bf16_t* Q; const bf16_t* K; const bf16_t* K2; const bf16_t* V; int P0;
    bf16_t* Out; float* O0; float lam; const float* dnorm; float oscale;
};
template <bool MLA, int MODE, bool PIPE>
__device__ __forceinline__ void attn_block(const AttnArgs& a, char* lds) {
    constexpr int DQK = MLA ? 192 : 64, NF = DQK / 16, KROW = DQK * 2, SHMK = 64 * KROW;
    constexpr bool BIAS = !MLA;
    int tid_ = threadIdx.x; asm volatile("" : "+v"(tid_));
    const int tid = tid_, wid = __builtin_amdgcn_readfirstlane(tid >> 6), lane = tid & 63, r32 = lane & 31, hi = lane >> 5;
    constexpr int ldq = MLA ? QMC : HC, ldk = KVC, ldk2 = HC, ldv = MLA ? KVC : HC;
    const int P0 = a.P0, NT = (P0 + QB) / KVBLK;
    const int qlo = P0 + wid * QBLK, qm = qlo + r32 - 4 * hi;
    char* V_lds = lds; char* K_lds = lds + LDS_K;
    float* ws = (float*)(lds + LDS_WS) + wid * 64; float* li_l = ws; float* al_l = ws + 32;
    const float* tb = (const float*)(lds + LDS_BIAS);
    float m_reg = -1e30f, l_reg = 0; f32x16 o[4] = {};
    const int sr = tid >> 4, sc = (tid & 15) * 8, vst0 = v_st(sr, sc), vst1 = v_st(32 + sr, sc);
    const int kws = kswz<DQK>(sr, sc * 2);
    const int kr_row = tid >> 3, kr_c = (tid & 7) * 8;
    const int kws2 = kswz<DQK>(kr_row, ((MLA ? 128 : 0) + kr_c) * 2);
    const int vb0 = (int)(uintptr_t)V_lds + v_rd_base(lane);
    bf16x8 st_v0, st_v1, st_k0, st_k1, st_k2;
    constexpr int NFR = NF > 8 ? 8 : NF;
    bf16x8 qr[NFR];
    char* qrl = lds + LDS_QR + wid * 4096 + lane * 16;
#pragma unroll
    for (int d0 = 0; d0 < NFR; ++d0) qr[d0] = *reinterpret_cast<const bf16x8*>(a.Q + (size_t)(qlo + r32) * ldq + d0 * 16 + hi * 8);
#pragma unroll
    for (int d0 = NFR; d0 < NF; ++d0) *reinterpret_cast<bf16x8*>(qrl + (d0 - NFR) * 1024) = *reinterpret_cast<const bf16x8*>(a.Q + (size_t)(qlo + r32) * ldq + d0 * 16 + hi * 8);
    const unsigned voV = (unsigned)(sr * ldv + sc) * 2u, voK = (unsigned)(sr * ldk + sc) * 2u, voK2 = (unsigned)(kr_row * ldk2 + kr_c) * 2u;
    constexpr size_t v32 = (size_t)32 * ldv * 2, k32 = (size_t)32 * ldk * 2;
#define VMW() asm volatile("s_waitcnt vmcnt(0)" ::: "memory")
#define SLOAD(k0) do { const char* vb_ = (const char*)a.V + (size_t)(k0) * ldv * 2; const char* k2b_ = (const char*)a.K2 + (size_t)(k0) * ldk2 * 2; \
        st_v0 = *reinterpret_cast<const bf16x8*>(vb_ + voV); st_v1 = *reinterpret_cast<const bf16x8*>(vb_ + v32 + voV); \
        if constexpr (MLA) { const char* kb_ = (const char*)a.K + (size_t)(k0) * ldk * 2; st_k0 = *reinterpret_cast<const bf16x8*>(kb_ + voK); st_k1 = *reinterpret_cast<const bf16x8*>(kb_ + k32 + voK); } \
        st_k2 = *reinterpret_cast<const bf16x8*>(k2b_ + voK2); } while (0)
#define SWRITE(bf) do { *(bf16x8*)(V_lds + (bf) * SHM_V + vst0) = st_v0; *(bf16x8*)(V_lds + (bf) * SHM_V + vst1) = st_v1; \
        if constexpr (MLA) { *(bf16x8*)(K_lds + (bf) * SHMK + kws) = st_k0; *(bf16x8*)(K_lds + (bf) * SHMK + kws + 32 * KROW) = st_k1; } \
        *(bf16x8*)(K_lds + (bf) * SHMK + kws2) = st_k2; } while (0)
#define RESC(al) do { if (__any((al) < 1.f)) { if (hi == 0) al_l[r32] = (al); asm volatile("s_waitcnt lgkmcnt(0)" ::: "memory");              \
                     for (int d_ = 0; d_ < 4; ++d_) for (int r = 0; r < 16; ++r) o[d_][r] *= al_l[crow(r, hi)]; } } while (0)
#define KBASE(t) ((t) * KVBLK)
#define MASKT(P0_, P1_, t) do { const int kb_ = KBASE(t); \
        if (BIAS && kb_ + 176 > qlo) bias_tile(P0_, P1_, qm - kb_, tb); \
        if (kb_ + KVBLK - 1 > qlo) mask_tile(P0_, P1_, qm - kb_); } while (0)
    bf16x8 pa0, pa1, pa2, pa3;
    if constexpr (!PIPE) {
    f32x16 p0, p1; float mn, al;
    SLOAD(0); VMW(); SWRITE(0);
    __syncthreads();
#define STEP(t, BF) do { \
        if ((t) + 1 < NT) { SLOAD(KBASE((t) + 1)); } SBAR(); \
        qkt<BF, DQK>(p0, p1, K_lds, r32, hi, qr, qrl); \
        MASKT(p0, p1, (t)); partialSM(p0, p1, m_reg, mn, al); RESC(al); \
        finishSM(p0, p1, al, l_reg, pa0, pa1, pa2, pa3); SBAR(); \
        pv_tile<BF>(o, vb0, pa0, pa1, pa2, pa3); SBAR(); \
        if ((t) + 1 < NT) { VMW(); SWRITE(1 - (BF)); } \
        __syncthreads(); } while (0)
    for (int t = 0; t < NT; t += 2) { STEP(t, 0); STEP(t + 1, 1); }
#undef STEP
    } else {
    f32x16 pA0, pA1, pB0, pB1; float mnA, mnB, alA, alB;
    SLOAD(0); VMW(); SWRITE(0); SBAR();
    SLOAD(KBASE(1));
    __syncthreads();
    SBAR(); qkt<0, DQK>(pA0, pA1, K_lds, r32, hi, qr, qrl);
    MASKT(pA0, pA1, 0); partialSM(pA0, pA1, m_reg, mnA, alA);
    VMW(); SWRITE(1);
    __syncthreads();
#define HALF_STEP(PX0, PX1, mnX, alX, PY0, PY1, alY, t, KB, VB, SB) do {                                                      \
        SBAR(); qkt<KB, DQK>(PX0, PX1, K_lds, r32, hi, qr, qrl);                                                              \
        finishSM(PY0, PY1, alY, l_reg, pa0, pa1, pa2, pa3); SBAR();                                                           \
        if ((t) + 1 < NT) { SLOAD(KBASE((t) + 1)); SBAR(); }                                                                  \
        pv_tile<VB>(o, vb0, pa0, pa1, pa2, pa3); MASKT(PX0, PX1, (t)); partialSM(PX0, PX1, m_reg, mnX, alX);                  \
        __syncthreads();                                                                                                      \
        if ((t) + 1 < NT) { VMW(); SWRITE(SB); }                                                                              \
        RESC(alX); __syncthreads(); } while (0)
    for (int t = 1; t + 1 < NT; t += 2) {
        HALF_STEP(pB0, pB1, mnB, alB, pA0, pA1, alA, t, 1, 0, 0);
        HALF_STEP(pA0, pA1, mnA, alA, pB0, pB1, alB, t + 1, 0, 1, 1);
    }
#undef HALF_STEP
    SBAR(); qkt<1, DQK>(pB0, pB1, K_lds, r32, hi, qr, qrl); SBAR();
    finishSM(pA0, pA1, alA, l_reg, pa0, pa1, pa2, pa3); SBAR();
    pv_tile<0>(o, vb0, pa0, pa1, pa2, pa3);
    MASKT(pB0, pB1, NT - 1); partialSM(pB0, pB1, m_reg, mnB, alB); RESC(alB);
    finishSM(pB0, pB1, alB, l_reg, pa0, pa1, pa2, pa3); SBAR(); pv_tile<1>(o, vb0, pa0, pa1, pa2, pa3);
    SBAR();
    __syncthreads();
    }
    if (hi == 0) li_l[r32] = l_reg; asm volatile("s_waitcnt lgkmcnt(0)" ::: "memory");
    float rli[16];
#pragma unroll
    for (int r = 0; r < 16; ++r) rli[r] = __builtin_amdgcn_rcpf(li_l[crow(r, hi)]);
    if constexpr (MODE == 0) {
        bf16_t* Ow = a.Out + (size_t)qlo * 1024;
#pragma unroll
        for (int r = 0; r < 16; ++r) { const int orow = crow(r, hi);
#pragma unroll
            for (int d0 = 0; d0 < 4; ++d0) { const float v = o[d0][r] * rli[r]; const float vn = __shfl_xor(v, 1);
                if ((r32 & 1) == 0) *(unsigned*)(Ow + (size_t)orow * 1024 + d0 * 32 + r32) = cvtpk(v, vn); } }
    } else if constexpr (MODE == 1) {
        bf16_t* Ow = (bf16_t*)a.O0 + (size_t)qlo * 512;
#pragma unroll
        for (int r = 0; r < 16; ++r) { const int orow = crow(r, hi);
#pragma unroll
            for (int d0 = 0; d0 < 4; ++d0) { const float v = o[d0][r] * rli[r]; const float vn = __shfl_xor(v, 1);
                if ((r32 & 1) == 0) *(unsigned*)(Ow + (size_t)orow * 512 + d0 * 32 + r32) = cvtpk(v, vn); } }
    } else {
        const float* O0w = a.O0 + (size_t)qlo * 512;
        bf16_t* Ow = a.Out + (size_t)qlo * 1024;
        float gn[4];
#pragma unroll
        for (int d0 = 0; d0 < 4; ++d0) gn[d0] = a.dnorm[d0 * 32 + r32] * a.oscale;
#pragma unroll
        for (int r = 0; r < 16; ++r) { const int orow = crow(r, hi);
            float d[4]; float ss = 0.f;
#pragma unroll
            for (int d0 = 0; d0 < 4; ++d0) { d[d0] = O0w[(size_t)orow * 512 + d0 * 32 + r32] - a.lam * (o[d0][r] * rli[r]); ss += d[d0] * d[d0]; }
#pragma unroll
            for (int s = 1; s < 32; s <<= 1) ss += __shfl_xor(ss, s);
            const float rs = __builtin_amdgcn_rsqf(ss * (1.0f / 128.0f) + 1e-5f);
#pragma unroll
            for (int d0 = 0; d0 < 4; ++d0) { const float v = d[d0] * rs * gn[d0]; const float vn = __shfl_xor(v, 1);
                if ((r32 & 1) == 0) *(unsigned*)(Ow + (size_t)orow * 1024 + d0 * 32 + r32) = cvtpk(v, vn); } }
    }
    __syncthreads();
#undef VMW
#undef SLOAD
#undef SWRITE
#undef RESC
#undef KBASE
#undef MASKT
#undef HALF_STEP
}
#undef SBAR
}

struct Args {
    const float* in[22]; float* out; unsigned char* ws;
    float inv[32];
    float lam_init[4];
    unsigned char bucket[128];
    unsigned short aq[32];
    int ph_lo, ph_hi;
};

template <class F, bool F8OUT = false>
__device__ __forceinline__ void cvt_item(const F& f, const float* kscale, int K, bf16_t* WT, LAS float* scr, int item, int nblk, int lane, float mul = 1.0f) {
    const int kb = item / nblk, nb = item % nblk, k0 = 64 * kb, n0 = 32 * nb;
    if (f.contig(n0)) {
        const float* base; int ld; float sc; f(n0, base, ld, sc); sc *= mul;
        const int r8 = lane >> 3, c4 = (lane & 7) * 4;
        f32x4 v[8];
#pragma unroll
        for (int i = 0; i < 8; ++i) v[i] = __builtin_nontemporal_load((const f32x4*)(base + (size_t)(k0 + 8 * i + r8) * ld + c4));
#pragma unroll
        for (int i = 0; i < 8; ++i) { const int kk = 8 * i + r8; const float m = kscale ? sc * kscale[k0 + kk] : sc;
            scr[kk * 33 + c4 + 0] = v[i][0] * m; scr[kk * 33 + c4 + 1] = v[i][1] * m; scr[kk * 33 + c4 + 2] = v[i][2] * m; scr[kk * 33 + c4 + 3] = v[i][3] * m; }
    } else {
        const float* src; int ld; float sc; f(n0 + (lane & 31), src, ld, sc); sc *= mul;
#pragma unroll 8
        for (int i = 0; i < 32; ++i) { const int kk = 2 * i + (lane >> 5); float v = src[(size_t)(k0 + kk) * ld] * sc; if (kscale) v *= kscale[k0 + kk]; scr[kk * 33 + (lane & 31)] = v; }
    }
    LDS_WAIT(); asm volatile("" ::: "memory");
    const int c = lane & 7;
#pragma unroll
    for (int j = 0; j < 4; ++j) { const int n = (lane >> 3) + 8 * j; const LAS float* s = scr + (8 * c) * 33 + n;
        if constexpr (F8OUT) {
            u32x2 o; o.x = cvt4_fp8(s[0 * 33], s[1 * 33], s[2 * 33], s[3 * 33]); o.y = cvt4_fp8(s[4 * 33], s[5 * 33], s[6 * 33], s[7 * 33]);
            *(u32x2*)((unsigned char*)WT + (size_t)(n0 + n) * K + k0 + 8 * c) = o;
        } else {
            u32x4 o; o.x = cvt_pk_bf16(s[0 * 33], s[1 * 33]); o.y = cvt_pk_bf16(s[2 * 33], s[3 * 33]); o.z = cvt_pk_bf16(s[4 * 33], s[5 * 33]); o.w = cvt_pk_bf16(s[6 * 33], s[7 * 33]);
            *(u32x4*)(WT + (size_t)(n0 + n) * K + k0 + 8 * c) = o; } }
    LDS_WAIT(); asm volatile("" ::: "memory");
}
struct MapWin { const float* W;
    __device__ __forceinline__ bool contig(int n0) const { return !(n0 >= C_KR && n0 < C_DQ); }
    __device__ __forceinline__ void operator()(int n, const float*& src, int& ld, float& sc) const {
        ld = 2240; sc = 1.f; int c = n;
        if (n >= 2240) { c = 0; sc = 0.f; }
        else if (n >= C_KR && n < C_DQ) { const int j = n - C_KR, i = j >> 1; c = C_KR + ((j & 1) ? 32 + i : i); }
        else if (n >= C_DQ && n < C_DK) sc = 0.125f * LOG2E;
        src = W + c; } };
struct MapWuq { const float* W;
    __device__ __forceinline__ bool contig(int n0) const { return (n0 % 192) < 128; }
    __device__ __forceinline__ void operator()(int n, const float*& src, int& ld, float& sc) const {
        ld = 768; sc = 0.07216878364870323f * LOG2E;
        const int hh = n / 192, j = n % 192; int c = j;
        if (j >= 128) { const int jj = j - 128, i = jj >> 1; c = 128 + ((jj & 1) ? 32 + i : i); }
        src = W + hh * 192 + c; } };
struct MapWukv { const float* Wk; const float* Wv;
    __device__ __forceinline__ bool contig(int) const { return true; }
    __device__ __forceinline__ void operator()(int n, const float*& src, int& ld, float& sc) const { ld = 512; sc = 1.f; src = n < 512 ? Wk + n : Wv + (n - 512); } };
struct MapPlain { const float* W; int N;
    __device__ __forceinline__ bool contig(int) const { return true; }
    __device__ __forceinline__ void operator()(int n, const float*& src, int& ld, float& sc) const { ld = N; sc = 1.f; src = W + n; } };
struct MapGU { const float* Wg; const float* Wu; int F;
    __device__ __forceinline__ bool contig(int) const { return true; }
    __device__ __forceinline__ void operator()(int n, const float*& src, int& ld, float& sc) const { ld = F; sc = 1.f; const int pn = n >> 8, j = n & 255; src = (j < 128) ? Wg + pn * 128 + j : Wu + pn * 128 + (j - 128); } };

__device__ __forceinline__ void cvt_moe(const Args& a, int ml, LAS float* scr, int gw, int NGW, int lane) {
    asm volatile("" : "+v"(lane));
    constexpr int I_GU = (DM / 64) * (2 * FFE / 32), I_D = (FFE / 64) * (DM / 32), I_E = I_GU + I_D;
    const float* wg = gfp(a.in[oi(19)]) + (size_t)ml * NEXP * DM * FFE; const float* wu = gfp(a.in[oi(20)]) + (size_t)ml * NEXP * DM * FFE; const float* wd = gfp(a.in[oi(21)]) + (size_t)ml * NEXP * FFE * DM;
    unsigned char* wsl = opq(a.ws); bf16_t* mgu = (bf16_t*)(wsl + WS_MGU); bf16_t* md = (bf16_t*)(wsl + WS_MD);
    for (int it = gw; it < NEXP * I_E; it += NGW) {
        const int e = it / I_E; int r = it % I_E;
        if (r < I_GU) { MapGU f{wg + (size_t)e * DM * FFE, wu + (size_t)e * DM * FFE, FFE}; cvt_item<MapGU, true>(f, nullptr, DM, (bf16_t*)((unsigned char*)mgu + (size_t)e * 2 * FFE * DM), scr, r, 2 * FFE / 32, lane, W8_GU); }
        else { r -= I_GU; MapPlain f{wd + (size_t)e * FFE * DM, DM}; cvt_item<MapPlain, true>(f, nullptr, FFE, (bf16_t*)((unsigned char*)md + (size_t)e * DM * FFE), scr, r, DM / 32, lane, W8_D); }
    }
}

template <int MODE, bool ROUTE, bool OUT8 = false, bool NOX = false, bool WRY = false>
__device__ __forceinline__ void ln_pass(const Args& a, const ystream_t* Ysrc, const float* Xres, const float* g, const float* b, float* Xout, bf16_t* XB,
                                        const float* router, unsigned* cnt, int gw, int NGW, int lane, LAS unsigned char* lds_, const float* g1 = nullptr, const float* b1 = nullptr, int stslot = 20) {
    asm volatile("" : "+v"(lane));
    unsigned char* wsl = opq(a.ws);
    const bf16_t* oslot = (const bf16_t*)(wsl + WS_OSLOT); const bf16_t* oslot2 = (const bf16_t*)(wsl + WS_OSLOT2);
    f32x4* route = (f32x4*)(wsl + WS_ROUTE);
    const int* slots = (const int*)(wsl + WS_ROUTE + 512 * 1024);
    float* st = (float*)(wsl + WS_SS);
    unsigned long long pk = 0ull;
#pragma unroll 2
    for (int m = gw; m < M; m += NGW) {
        f32x4 v[4];
        if constexpr (MODE == 0) {
#pragma unroll
            for (int j = 0; j < 4; ++j) v[j] = ld4h(Ysrc + (size_t)m * DM + (lane + 64 * j) * 4);
        } else {
            const f32x4 rt = route[m]; const int s1 = slots[2 * m], s2 = slots[2 * m + 1];
            const float mu1 = st[(size_t)m * 32 + 20], rs1 = st[(size_t)m * 32 + 21];
#pragma unroll
            for (int j = 0; j < 4; ++j) { const f32x4 yv1 = ld4h(Ysrc + (size_t)m * DM + (lane + 64 * j) * 4);
                const f32x4 xv = (yv1 - mu1) * rs1 * *((const f32x4*)g1 + lane + 64 * j) + *((const f32x4*)b1 + lane + 64 * j);
                const unsigned o1 = *((const unsigned*)((const unsigned char*)oslot + (size_t)s1 * DM) + lane + 64 * j), o2 = *((const unsigned*)((const unsigned char*)oslot + (size_t)s2 * DM) + lane + 64 * j);
                const unsigned p1 = *((const unsigned*)((const unsigned char*)oslot2 + (size_t)s1 * DM) + lane + 64 * j), p2 = *((const unsigned*)((const unsigned char*)oslot2 + (size_t)s2 * DM) + lane + 64 * j);
                const f32x2 a1l = __builtin_amdgcn_cvt_pk_f32_fp8((int)o1, false), a1h = __builtin_amdgcn_cvt_pk_f32_fp8((int)o1, true), b1l = __builtin_amdgcn_cvt_pk_f32_fp8((int)p1, false), b1h = __builtin_amdgcn_cvt_pk_f32_fp8((int)p1, true);
                const f32x2 a2l = __builtin_amdgcn_cvt_pk_f32_fp8((int)o2, false), a2h = __builtin_amdgcn_cvt_pk_f32_fp8((int)o2, true), b2l = __builtin_amdgcn_cvt_pk_f32_fp8((int)p2, false), b2h = __builtin_amdgcn_cvt_pk_f32_fp8((int)p2, true);
                const float g1s = rt[2] * (1.0f / O8), g2s = rt[3] * (1.0f / O8);
                f32x4 r;
                r[0] = xv[0] * DN_ALPHA + g1s * (a1l.x + b1l.x) + g2s * (a2l.x + b2l.x);
                r[1] = xv[1] * DN_ALPHA + g1s * (a1l.y + b1l.y) + g2s * (a2l.y + b2l.y);
                r[2] = xv[2] * DN_ALPHA + g1s * (a1h.x + b1h.x) + g2s * (a2h.x + b2h.x);
                r[3] = xv[3] * DN_ALPHA + g1s * (a1h.y + b1h.y) + g2s * (a2h.y + b2h.y);
                if constexpr (WRY) st4h((ystream_t*)Ysrc + (size_t)m * DM + (lane + 64 * j) * 4, r);
                v[j] = r; }
        }
        float s = 0.f;
#pragma unroll
        for (int j = 0; j < 4; ++j) s += (v[j][0] + v[j][1]) + (v[j][2] + v[j][3]);
        const float mean = wave_sum(s) * (1.f / DM); float s2 = 0.f;
#pragma unroll
        for (int j = 0; j < 4; ++j) { v[j] = v[j] - mean; s2 += (v[j][0] * v[j][0] + v[j][1] * v[j][1]) + (v[j][2] * v[j][2] + v[j][3] * v[j][3]); }
        const float rstd = __builtin_amdgcn_rsqf(wave_sum(s2) * (1.f / DM) + 1e-5f);
#pragma unroll
        for (int j = 0; j < 4; ++j) { const f32x4 gv = *((const f32x4*)g + lane + 64 * j), bv = *((const f32x4*)b + lane + 64 * j);
            v[j] = v[j] * rstd * gv + bv;
            if constexpr (!NOX) *((f32x4*)(Xout + (size_t)m * DM) + lane + 64 * j) = v[j];
            if constexpr (OUT8) { *((unsigned*)((unsigned char*)XB + (size_t)m * DM) + lane + 64 * j) = cvt4_fp8(v[j][0], v[j][1], v[j][2], v[j][3]); }
            else if (XB) { u32x2 w; w.x = cvt_pk_bf16(v[j][0], v[j][1]); w.y = cvt_pk_bf16(v[j][2], v[j][3]); *((u32x2*)(XB + (size_t)m * DM) + lane + 64 * j) = w; } }
        if constexpr (NOX) { if (lane == 0) { st[(size_t)m * 32 + stslot] = mean; st[(size_t)m * 32 + stslot + 1] = rstd; } }
        if constexpr (ROUTE) {
            float lg[8];
#pragma unroll
            for (int e = 0; e < 8; ++e) lg[e] = 0.f;
#pragma unroll
            for (int j = 0; j < 4; ++j)
#pragma unroll
                for (int q = 0; q < 4; ++q) { const int k = (lane + 64 * j) * 4 + q; const f32x4 r0 = *(const f32x4*)(router + (size_t)k * 8), r1 = *(const f32x4*)(router + (size_t)k * 8 + 4); const float xv = v[j][q];
                    lg[0] += xv * r0[0]; lg[1] += xv * r0[1]; lg[2] += xv * r0[2]; lg[3] += xv * r0[3]; lg[4] += xv * r1[0]; lg[5] += xv * r1[1]; lg[6] += xv * r1[2]; lg[7] += xv * r1[3]; }
#pragma unroll
            for (int e = 0; e < 8; ++e) lg[e] = wave_sum(lg[e]);
            int e1 = 0; float v1 = lg[0];
#pragma unroll
            for (int e = 1; e < 8; ++e) if (lg[e] > v1) { v1 = lg[e]; e1 = e; }
            int e2 = -1; float v2 = -__builtin_inff();
#pragma unroll
            for (int e = 0; e < 8; ++e) if (e != e1 && lg[e] > v2) { v2 = lg[e]; e2 = e; }
            const float g2 = 1.0f / (1.0f + __expf(v1 - v2)), g1 = 1.0f - g2;
            if (lane == 0) { f32x4 rt; rt[0] = __int_as_float(e1); rt[1] = __int_as_float(e2); rt[2] = g1; rt[3] = g2; route[m] = rt; }
            pk += (1ull << (8 * e1)) + (1ull << (8 * e2));
        }
    }
    if constexpr (ROUTE) {
        LAS unsigned* lc = (LAS unsigned*)(lds_ + 131072);
        const bool w0 = (gw & 7) == 0;
        if (w0 && lane < 8) lc[lane] = 0u;
        __syncthreads();
        if (lane < 8) atomicAdd((unsigned*)(lc + lane), (unsigned)((pk >> (8 * lane)) & 255ull));
        __syncthreads();
        if (w0 && lane < 8) atomicAdd(cnt + lane, lc[lane]);
    }
}

#define XB_TMO      128
#define XB_XCNT(j)  (256  + 64 * (j))
#define XB_XSUB(j)  (1280 + 64 * (j))
#define XB_XGEN(j)  (2304 + 64 * (j))
#define XB_TOP      3328
#define XB_TOPGEN   3392
#define XCD_BAR_WORDS 3456
#define XB_SPIN_CAP (1u << 22)
__device__ __forceinline__ unsigned xb_ld(unsigned* p)              { return __hip_atomic_load(p, __ATOMIC_RELAXED, __HIP_MEMORY_SCOPE_AGENT); }
__device__ __forceinline__ unsigned xb_add(unsigned* p, unsigned v) { return __hip_atomic_fetch_add(p, v, __ATOMIC_RELAXED, __HIP_MEMORY_SCOPE_AGENT); }
__device__ __forceinline__ unsigned xb_xcc_id() { return (unsigned)__builtin_amdgcn_s_getreg((3 << 11) | 20) & 0xFu; }
#define XB_SPIN(cond, bar) do { unsigned _sp = 0; while (cond) { __builtin_amdgcn_s_sleep(1); \
    if ((++_sp & 255u) == 0u) { if (xb_ld(&(bar)[XB_TMO])) break; if (_sp > XB_SPIN_CAP) { atomicAdd(&(bar)[XB_TMO], 1u); break; } } } } while (0)
struct XcdBarrier { unsigned* bar; unsigned x; volatile LAS unsigned* st; };
__device__ __forceinline__ XcdBarrier xcd_barrier_post(unsigned* bar, volatile LAS unsigned* st) {
    XcdBarrier b; b.bar = bar; b.x = xb_xcc_id(); b.st = st;
    if (threadIdx.x == 0) (void)xb_add(&bar[XB_XCNT(b.x)], 1u);
    return b;
}
__device__ __forceinline__ void xcd_barrier_complete(unsigned* bar, unsigned x, unsigned& nloc, unsigned& nx) {
    const unsigned G = gridDim.x * gridDim.y * gridDim.z;
    unsigned sum, cnt, mine, sp = 0u;
    for (;;) {
        sum = 0u; cnt = 0u; mine = 0u;
#pragma unroll
        for (unsigned j = 0; j < 16; ++j) { const unsigned c = xb_ld(&bar[XB_XCNT(j)]); sum += c; cnt += (c > 0u) ? 1u : 0u; mine = (j == x) ? c : mine; }
        if (sum == G) break;
        __builtin_amdgcn_s_sleep(1);
        if ((++sp & 255u) == 0u) { if (xb_ld(&bar[XB_TMO])) break; if (sp > XB_SPIN_CAP) { atomicAdd(&bar[XB_TMO], 1u); break; } }
    }
    nloc = mine > 0u ? mine : 1u; nx = cnt > 0u ? cnt : 1u;
}
__device__ __forceinline__ void xcd_barrier(const XcdBarrier& b) {
    asm volatile("s_waitcnt vmcnt(0)" ::: "memory");
    __syncthreads();
    if (threadIdx.x == 0) {
        unsigned* bar = b.bar;
        __builtin_amdgcn_s_waitcnt(0);
        unsigned nloc = b.st[0], nx = b.st[1];
        if (nloc == 0u) { xcd_barrier_complete(bar, b.x, nloc, nx); b.st[0] = nloc; b.st[1] = nx; }
        const unsigned old = xb_add(&bar[XB_XSUB(b.x)], 1u);
        const unsigned gen = old / nloc;
        if (old + 1u == (gen + 1u) * nloc) {
            __builtin_amdgcn_fence(__ATOMIC_RELEASE, "agent");
            asm volatile("s_waitcnt vmcnt(0)" ::: "memory");
            const unsigned og = xb_add(&bar[XB_TOP], 1u);
            const unsigned tg = og / nx;
            if (og + 1u == (tg + 1u) * nx) xb_add(&bar[XB_TOPGEN], 1u);
            else XB_SPIN(xb_ld(&bar[XB_TOPGEN]) == tg, bar);
            __builtin_amdgcn_fence(__ATOMIC_ACQUIRE, "agent");
            xb_add(&bar[XB_XGEN(b.x)], 1u);
            asm volatile("s_waitcnt vmcnt(0)" ::: "memory");
        } else {
            XB_SPIN(xb_ld(&bar[XB_XGEN(b.x)]) == gen, bar);
            __builtin_amdgcn_fence(__ATOMIC_ACQUIRE, "agent");
            asm volatile("s_waitcnt vmcnt(0)" ::: "memory");
        }
    }
    __syncthreads();
}
constexpr int CW_BAR = 16384;

__global__ void __launch_bounds__(512, 2) mega_fwd(Args a) {
    extern __shared__ __attribute__((aligned(16))) unsigned char lds_raw[];
    LAS unsigned char* lds = (LAS unsigned char*)lds_raw;
    cg::grid_group grid = cg::this_grid();
    const int tid = threadIdx.x, wave = __builtin_amdgcn_readfirstlane(tid >> 6);
#define FRESH_LANE(name) int name = threadIdx.x; asm volatile("" : "+v"(name)); name &= 63
    const int G = gridDim.x, bx = blockIdx.x;
    const int vcu = (G % 8 == 0) ? (bx % 8) * (G / 8) + bx / 8 : bx;
    const int gw = vcu * 8 + wave, NGW = G * 8;
#define ws opq(a.ws)
#define ctl ((unsigned*)(ws + WS_CTL))
#define tab ((float*)(ws + WS_TAB))
#define ssq ((float*)(ws + WS_SS))
#define sskv ((float*)(ws + WS_SS))
#define WinT ((bf16_t*)(ws + WS_WIN))
#define WuqT ((bf16_t*)(ws + WS_WUQ))
#define WukvT ((bf16_t*)(ws + WS_WUKV))
#define WoT ((bf16_t*)(ws + WS_WO))
#define WguT ((bf16_t*)(ws + WS_WGU))
#define WdT ((bf16_t*)(ws + WS_WD))
#define MguT ((bf16_t*)(ws + WS_MGU))
#define MdT ((bf16_t*)(ws + WS_MD))
#define Xf ((float*)(ws + WS_X))
#define XB ((bf16_t*)(ws + WS_XB))
#define Y ((ystream_t*)(ws + WS_Y))
#define Hb ((bf16_t*)(ws + WS_H))
#define QMb ((bf16_t*)(ws + WS_QM))
#define KVb ((bf16_t*)(ws + WS_KVB))
#define MRG ((bf16_t*)(ws + WS_MRG))
#define O0buf ((float*)(ws + WS_O0))
#define O1buf ((float*)(ws + WS_O0 + 32 * MiB))
#define ACT ((bf16_t*)(ws + WS_ACT))
#define XG ((bf16_t*)(ws + WS_XG))
#define MACT ((bf16_t*)(ws + WS_MACT))
#define OSLOT ((bf16_t*)(ws + WS_OSLOT))
    LAS float* scr = (LAS float*)(lds + wave * 16384);

    volatile LAS unsigned* bst = (volatile LAS unsigned*)(lds + LDS_BYTES - 64);
    if (tid < 2) bst[tid] = 0u;
    __syncthreads();
    XcdBarrier xbar = xcd_barrier_post((unsigned*)(ws + WS_CTL) + CW_BAR, bst);
    int ph = 0;
    const int lo = a.ph_lo, hi = a.ph_hi;
#ifndef EN
#define EN 0xFFFFF
#endif
#ifndef REP
#define REP 0
#endif
#define PH_BEGIN(k) if (lo <= ph && ph < hi) { if constexpr ((EN >> (k)) & 1) for (int rep_ = 0; rep_ < ((((REP) >> (k)) & 1) ? 2 : 1); ++rep_) {
#define PH_END() } if (ph + 1 < hi) { if (ph == 0) grid.sync(); else xcd_barrier(xbar); } } ++ph;

    PH_BEGIN(0)
    {
        FRESH_LANE(lane_);
#define lane lane_
        constexpr int I_IN = (DM / 64) * (HC / 32), I_UQ = (384 / 64) * (768 / 32), I_UKV = (256 / 64) * (1024 / 32), I_O = (DM / 64) * (DM / 32), I_L = I_IN + I_UQ + I_UKV + I_O;
        constexpr int I_GU = (DM / 64) * (2 * FFD / 32), I_D = (FFD / 64) * (DM / 32), I_F = I_GU + I_D;
        for (int it = gw; it < 4 * I_L + 2 * I_F; it += NGW) {
            if (it < 4 * I_L) { const int l = it / I_L; int r = it % I_L;
                if (r < I_IN) { MapWin f{gfp(a.in[oi(2)]) + (size_t)l * DM * 2240}; cvt_item(f, nullptr, DM, WinT + (size_t)l * HC * DM, scr, r, HC / 32, lane); continue; } r -= I_IN;
                if (r < I_UQ) { MapWuq f{gfp(a.in[oi(5)]) + (size_t)l * 384 * 768}; cvt_item(f, gfp(a.in[oi(3)]) + l * 384, 384, WuqT + (size_t)l * 768 * 384, scr, r, 768 / 32, lane); continue; } r -= I_UQ;
                if (r < I_UKV) { MapWukv f{gfp(a.in[oi(6)]) + (size_t)l * 256 * 512, gfp(a.in[oi(7)]) + (size_t)l * 256 * 512}; cvt_item(f, gfp(a.in[oi(4)]) + l * 256, 256, WukvT + (size_t)l * 1024 * 256, scr, r, 1024 / 32, lane); continue; } r -= I_UKV;
                { MapPlain f{gfp(a.in[oi(10)]) + (size_t)l * DM * DM, DM}; cvt_item(f, nullptr, DM, WoT + (size_t)l * DM * DM, scr, r, DM / 32, lane); }
            } else { const int q = it - 4 * I_L, d = q / I_F; int r = q % I_F;
                if (r < I_GU) { MapGU f{gfp(a.in[oi(15)]) + (size_t)d * DM * FFD, gfp(a.in[oi(16)]) + (size_t)d * DM * FFD, FFD}; cvt_item<MapGU, true>(f, nullptr, DM, (bf16_t*)((unsigned char*)WguT + (size_t)d * 2 * FFD * DM), scr, r, 2 * FFD / 32, lane, W8_GU); }
                else { r -= I_GU; MapPlain f{gfp(a.in[oi(17)]) + (size_t)d * FFD * DM, DM}; cvt_item<MapPlain, true>(f, nullptr, FFD, (bf16_t*)((unsigned char*)WdT + (size_t)d * DM * FFD), scr, r, DM / 32, lane, W8_D); }
            }
        }
        cvt_moe(a, 0, scr, gw, NGW, fresh_lane());
        for (int m = gw; m < M; m += NGW) {
#pragma unroll
            for (int j = 0; j < 4; ++j) { const f32x4 v = *((const f32x4*)(gfp(a.in[oi(0)]) + (size_t)m * DM) + lane + 64 * j); u32x2 w; w.x = cvt_pk_bf16(v[0], v[1]); w.y = cvt_pk_bf16(v[2], v[3]); *((u32x2*)(XB + (size_t)m * DM) + lane + 64 * j) = w; }
        }
        for (int i = bx * 512 + tid; i < SEQ * 32; i += G * 512) { const int pos = i >> 5, fi = i & 31; const float ang = (float)pos * a.inv[fi];
            const double rev = (double)ang * 0.15915494309189535; const float fr = (float)(rev - __builtin_rint(rev));
            tab[2 * i] = __builtin_amdgcn_cosf(fr); tab[2 * i + 1] = __builtin_amdgcn_sinf(fr); }
        if (bx == 0 && tid < 128) ctl[tid] = 0u;
#undef lane
    }
    PH_END()

    for (int l = 0; l < DEPTH; ++l) {
        const bool moe = (l & 1) != 0; const int li = l >> 1;
        const float* xres = (l == 0) ? gfp(a.in[oi(0)]) : Xf;
#define splitA (G == 256)
        PH_BEGIN(1)
        { pg8::StaticOrder S; S.init(M, splitA ? 2048 : HC, G, obx()); pg8::EpiH E{Hb, ssq, sskv, tab};
          pg8::gemm_phase(lds, XB, DM, WinT + (size_t)l * HC * DM, DM, DM, S, E); }
        PH_END()
        PH_BEGIN(2)
        {
#ifndef NOQ
          if (splitA && bx >= 192) { pg8::OneUnit S{obx() - 192, 8, true}; pg8::EpiH E{Hb, ssq, sskv, tab};
            pg8::gemm_phase(lds, XB, DM, WinT + (size_t)l * HC * DM, DM, DM, S, E); }
          else { pg8::StaticOrder S; S.init(M, QMC, splitA ? 192 : G, obx()); pg8::EpiQ E{QMb, ssq, tab};
            pg8::gemm_phase(lds, Hb + C_CQ, HC, WuqT + (size_t)l * 768 * 384, 384, 384, S, E); }
#endif
#ifndef NOKV
          { pg8::StaticOrder S; S.init(M, KVC, G, obx()); pg8::EpiKV E{KVb, sskv};
            pg8::gemm_phase(lds, Hb + C_CKV, HC, WukvT + (size_t)l * 1024 * 256, 256, 256, S, E); }
#endif
        }
        PH_END()
        PH_BEGIN(3)
        {
            unsigned* qc = ctl + 512 + l;
            volatile LAS int* qslot = (volatile LAS int*)(lds + LDS_BYTES - 32);
            for (;;) {
                if (tid == 0) *qslot = (int)atomicAdd(qc, 1u);
                __syncthreads();
                const int it = __builtin_amdgcn_readfirstlane(*qslot);
                __syncthreads();
                if (it >= 768) break;
                int acc = 0, ent = 0, r = 0;
                for (int e = 0; e < 32; ++e) { const int en = (int)a.aq[e]; const int n = (en >> 8) ? 32 : 16; if (it >= acc && it < acc + n) { ent = en; r = it - acc; } acc += n; }
                const int qb = ent & 255; const bool is_diff = (ent >> 8) != 0;
                const int bh = is_diff ? (r >> 1) : r, c = r & 1, b = bh >> 2, hh = bh & 3;
                const size_t rb = (size_t)b * SEQ;
                if (!is_diff) {
                    att::AttnArgs A; A.Q = QMb + rb * QMC + hh * 192; A.K = KVb + rb * KVC + hh * 128; A.K2 = Hb + rb * HC + C_KR;
                    A.V = KVb + rb * KVC + 512 + hh * 128; A.P0 = qb * 256; A.Out = MRG + rb * 1024 + hh * 128; A.O0 = nullptr;
                    att::attn_block<true, 0, PIPE_MLA>(A, (char*)lds_raw);
                } else {
                    if (tid < 128) { const float* rbias = gfp(a.in[oi(1)]); ((float*)(lds_raw + att::LDS_BIAS))[tid] = (rbias[a.bucket[tid] * 4 + hh] - rbias[31 * 4 + hh]) * LOG2E; }
                    __syncthreads();
                    att::AttnArgs A; A.K = nullptr; A.V = Hb + rb * HC + C_DV + hh * 128; A.P0 = qb * 256; A.Out = nullptr;
                    A.O0 = (float*)((bf16_t*)(c ? O1buf : O0buf) + rb * 512 + hh * 128);
                    A.Q = Hb + rb * HC + C_DQ + hh * 128 + c * 64; A.K2 = Hb + rb * HC + C_DK + hh * 128 + c * 64;
                    att::attn_block<false, 1, PIPE_DIFF>(A, (char*)lds_raw);
                    asm volatile("s_waitcnt vmcnt(0)" ::: "memory");
                    __syncthreads();
                    if (tid == 0) {
                        __builtin_amdgcn_fence(__ATOMIC_RELEASE, "agent"); asm volatile("s_waitcnt vmcnt(0)" ::: "memory");
                        const unsigned old_ = __hip_atomic_fetch_add(ctl + 1024 + l * 256 + bh * 16 + qb, 1u, __ATOMIC_RELAXED, __HIP_MEMORY_SCOPE_AGENT);
                        if (old_ == 1u) { __builtin_amdgcn_fence(__ATOMIC_ACQUIRE, "agent"); asm volatile("s_waitcnt vmcnt(0)" ::: "memory"); }
                        *qslot = (int)old_;
                    }
                    __syncthreads();
                    const int second = __builtin_amdgcn_readfirstlane(*qslot);
                    __syncthreads();
                    if (second == 1) {
                        FRESH_LANE(ln_);
                        const float* lp = gfp(a.in[oi(8)]) + (size_t)l * 256;
                        const float s1 = wave_sum(lp[ln_] * lp[64 + ln_]), s2 = wave_sum(lp[128 + ln_] * lp[192 + ln_]);
                        const float lam = __expf(s1) - __expf(s2) + a.lam_init[oi(l)];
                        const float osc = 1.0f - a.lam_init[oi(l)];
                        const float* dn = gfp(a.in[oi(9)]) + l * 128 + (ln_ & 15) * 8;
                        const f32x4 g0 = *(const f32x4*)dn * osc, g1 = *(const f32x4*)(dn + 4) * osc;
                        const size_t row0 = rb + (size_t)qb * 256 + wave * 32 + (ln_ >> 4);
#pragma unroll 2
                        for (int i = 0; i < 8; ++i) { const size_t m = row0 + 4 * i;
                            const u32x4 q0 = *(const u32x4*)((const bf16_t*)O0buf + m * 512 + hh * 128 + (ln_ & 15) * 8), q1 = *(const u32x4*)((const bf16_t*)O1buf + m * 512 + hh * 128 + (ln_ & 15) * 8);
#define BLO(w) __uint_as_float((w) << 16)
#define BHI(w) __uint_as_float((w) & 0xffff0000u)
                            const f32x4 d0 = (f32x4){BLO(q0.x), BHI(q0.x), BLO(q0.y), BHI(q0.y)} - (f32x4){BLO(q1.x), BHI(q1.x), BLO(q1.y), BHI(q1.y)} * lam;
                            const f32x4 d1 = (f32x4){BLO(q0.z), BHI(q0.z), BLO(q0.w), BHI(q0.w)} - (f32x4){BLO(q1.z), BHI(q1.z), BLO(q1.w), BHI(q1.w)} * lam;
#undef BLO
#undef BHI
                            float ss = (d0[0] * d0[0] + d0[1] * d0[1]) + (d0[2] * d0[2] + d0[3] * d0[3]) + (d1[0] * d1[0] + d1[1] * d1[1]) + (d1[2] * d1[2] + d1[3] * d1[3]);
                            ss += __shfl_xor(ss, 1); ss += __shfl_xor(ss, 2); ss += __shfl_xor(ss, 4); ss += __shfl_xor(ss, 8);
                            const float rs = __builtin_amdgcn_rsqf(ss * (1.0f / 128.0f) + 1e-5f);
                            pg8::store8(MRG + m * 1024 + 512 + hh * 128 + (ln_ & 15) * 8, d0 * rs * g0, d1 * rs * g1); }
                    }
                }
            }
        }
        PH_END()
        PH_BEGIN(4)
        { pg8::StaticOrder S; S.init(M, DM, G, obx());
          if (l == 0) { pg8::EpiY E{xres, Y, 1.0f}; pg8::gemm_phase(lds, MRG, DM, WoT + (size_t)l * DM * DM, DM, DM, S, E); }
          else { pg8::EpiYLN E{Y, ssq, gfp(a.in[oi(13)]) + (l - 1) * DM, gfp(a.in[oi(14)]) + (l - 1) * DM, 1.0f, 22};
                 pg8::gemm_phase(lds, MRG, DM, WoT + (size_t)l * DM * DM, DM, DM, S, E); } }
        PH_END()
        PH_BEGIN(5)
        { if (moe) ln_pass<0, true, true, true>(a, Y, nullptr, gfp(a.in[oi(11)]) + l * DM, gfp(a.in[oi(12)]) + l * DM, Xf, (bf16_t*)(ws + WS_XB8), gfp(a.in[oi(18)]) + (size_t)li * DM * 8, ctl + CW_CNT + 8 * li, gw, NGW, fresh_lane(), lds);
          else ln_pass<0, false, true, true>(a, Y, nullptr, gfp(a.in[oi(11)]) + l * DM, gfp(a.in[oi(12)]) + l * DM, Xf, (bf16_t*)(ws + WS_XB8), nullptr, nullptr, gw, NGW, fresh_lane(), lds);
          if (l == 2) cvt_moe(a, 1, scr, gw, NGW, fresh_lane()); }
        PH_END()
        if (!moe) {
            PH_BEGIN(6)
            { pg8::StaticOrder S; S.init(M, 2 * FFD, G, obx()); pg8::EpiSwiGLU8 E{(unsigned char*)ACT, FFD};
              pg8::gemm_phase<pg8::EpiSwiGLU8, pg8::StaticOrder, true>(lds, (const bf16_t*)(ws + WS_XB8), DM / 2, (const bf16_t*)((unsigned char*)WguT + (size_t)li * 2 * FFD * DM), DM / 2, DM / 2, S, E); }
            PH_END()
            PH_BEGIN(7)
            { pg8::StaticOrder S; S.init(M, DM, G, obx()); pg8::EpiYLN E{Y, ssq, gfp(a.in[oi(11)]) + l * DM, gfp(a.in[oi(12)]) + l * DM, 1.0f / (W8_D * A8_ACT), 20};
              pg8::gemm_phase<pg8::EpiYLN, pg8::StaticOrder, true>(lds, ACT, FFD / 2, (const bf16_t*)((unsigned char*)WdT + (size_t)li * DM * FFD), FFD / 2, FFD / 2, S, E); }
            PH_END()
            PH_BEGIN(8)
            { ln_pass<0, false, false, true>(a, Y, nullptr, gfp(a.in[oi(13)]) + l * DM, gfp(a.in[oi(14)]) + l * DM, nullptr, XB, nullptr, nullptr, gw, NGW, fresh_lane(), lds, nullptr, nullptr, 22); }
            PH_END()
        } else {
            unsigned* cnt = ctl + CW_CNT + 8 * li; unsigned* cur = ctl + CW_CUR + 8 * li;
            PH_BEGIN(9)
            {
                FRESH_LANE(lane_);
#define lane lane_
                int rbase[8]; { int acc = 0;
#pragma unroll
                    for (int e = 0; e < 8; ++e) { rbase[e] = acc * 256; acc += (__builtin_amdgcn_readfirstlane((int)__hip_atomic_load(cnt + e, __ATOMIC_RELAXED, __HIP_MEMORY_SCOPE_AGENT)) + 255) >> 8; } }
                const f32x4* route = (const f32x4*)(ws + WS_ROUTE); int* slots = (int*)(ws + WS_ROUTE + 512 * 1024);
                LAS unsigned* lc = (LAS unsigned*)(lds + 131072);
                unsigned long long pk = 0ull;
                for (int m = gw; m < M; m += NGW) { const f32x4 rt = route[m]; pk += (1ull << (8 * __float_as_int(rt[0]))) + (1ull << (8 * __float_as_int(rt[1]))); }
                if (lane < 8) lc[wave * 8 + lane] = (unsigned)((pk >> (8 * lane)) & 255ull);
                __syncthreads();
                if (wave == 0 && lane < 8) {
                    unsigned tot = 0u, pre[8];
#pragma unroll
                    for (int w = 0; w < 8; ++w) { pre[w] = tot; tot += lc[w * 8 + lane]; }
                    int rb = 0;
#pragma unroll
                    for (int e = 0; e < 8; ++e) if (e == lane) rb = rbase[e];
                    const unsigned base = atomicAdd(cur + lane, tot) + (unsigned)rb;
#pragma unroll
                    for (int w = 0; w < 8; ++w) lc[64 + w * 8 + lane] = base + pre[w];
                }
                __syncthreads();
                unsigned nb[8];
#pragma unroll
                for (int e = 0; e < 8; ++e) nb[e] = lc[64 + wave * 8 + e];
                for (int m = gw; m < M; m += NGW) {
                    const f32x4 rt = route[m]; const int e1 = __float_as_int(rt[0]), e2 = __float_as_int(rt[1]);
                    int s1 = 0, s2 = 0;
#pragma unroll
                    for (int e = 0; e < 8; ++e) { if (e == e1) { s1 = (int)nb[e]; nb[e]++; } if (e == e2) { s2 = (int)nb[e]; nb[e]++; } }
                    const u32x4 q = *((const u32x4*)((const unsigned char*)(ws + WS_XB8) + (size_t)m * DM) + lane);
                    *((u32x4*)((unsigned char*)XG + (size_t)s1 * DM) + lane) = q; *((u32x4*)((unsigned char*)XG + (size_t)s2 * DM) + lane) = q;
                    if (lane == 0) { slots[2 * m] = s1; slots[2 * m + 1] = s2; }
                }
#undef lane
            }
            PH_END()
            pg8::MoeOrder MO; { int t[8], tot = 0;
#pragma unroll
                for (int e = 0; e < 8; ++e) { t[e] = (__builtin_amdgcn_readfirstlane((int)__hip_atomic_load(cnt + e, __ATOMIC_RELAXED, __HIP_MEMORY_SCOPE_AGENT)) + 255) >> 8; tot += t[e]; }
                MO.t0 = t[0]; MO.t1 = t[1]; MO.t2 = t[2]; MO.t3 = t[3]; MO.t4 = t[4]; MO.t5 = t[5]; MO.t6 = t[6]; MO.t7 = t[7]; MO.G = G; MO.c = bx; MO.NT = 0; MO.total = tot; MO.ks = 1; MO.kh = 0; }
            PH_BEGIN(10)
            { pg8::MoeOrder S = MO; S.NT = 2 * FFE / 256; S.total = MO.total * S.NT; pg8::EpiSwiGLU8 E{(unsigned char*)MACT, FFE};
              pg8::gemm_phase<pg8::EpiSwiGLU8, pg8::MoeOrder, true>(lds, XG, DM / 2, MguT, DM / 2, DM / 2, S, E); }
            PH_END()
            PH_BEGIN(11)
            { pg8::MoeOrder S = MO; S.NT = DM / 256; S.ks = 2; S.kh = FFE / 4; S.total = MO.total * S.NT * 2; pg8::EpiF8 E{(unsigned char*)OSLOT, DM, (size_t)(WS_OSLOT2 - WS_OSLOT), O8 / (W8_D * A8_ACT)};
              pg8::gemm_phase<pg8::EpiF8, pg8::MoeOrder, true>(lds, MACT, FFE / 2, MdT, FFE / 2, FFE / 4, S, E); }
            PH_END()
            PH_BEGIN(12)
            { if (l == DEPTH - 1) ln_pass<1, false>(a, Y, nullptr, gfp(a.in[oi(13)]) + l * DM, gfp(a.in[oi(14)]) + l * DM, a.out + oz(), nullptr, nullptr, nullptr, gw, NGW, fresh_lane(), lds, gfp(a.in[oi(11)]) + l * DM, gfp(a.in[oi(12)]) + l * DM);
              else ln_pass<1, false, false, true, true>(a, Y, nullptr, gfp(a.in[oi(13)]) + l * DM, gfp(a.in[oi(14)]) + l * DM, nullptr, XB, nullptr, nullptr, gw, NGW, fresh_lane(), lds, gfp(a.in[oi(11)]) + l * DM, gfp(a.in[oi(12)]) + l * DM, 22); }
            PH_END()
        }
    }
#undef PH_BEGIN
#undef PH_END
}
#undef ws
#undef ctl
#undef tab
#undef ssq
#undef sskv
#undef Y
#undef XB
#undef Xf
constexpr int N_PHASES = 1 + 2 * 8 + 2 * 9;

extern "C" void kernel_launch(void* const* d_in, const int* in_sizes, int n_in, void* d_out, int out_size, void* d_ws, size_t ws_size, hipStream_t stream) {
    static int grid = 0;
    if (grid == 0) {
        if (n_in != 22 || in_sizes[0] != M * DM || out_size != M * DM || ws_size < WS_END) { fprintf(stderr, "kernel_launch: unexpected shapes (n_in %d, ws %zu)\n", n_in, ws_size); grid = -1; return; }
        int dev = 0, cus = 0, per_cu = 0;
        (void)hipGetDevice(&dev); (void)hipDeviceGetAttribute(&cus, hipDeviceAttributeMultiprocessorCount, dev);
        if (hipFuncSetAttribute((const void*)mega_fwd, hipFuncAttributeMaxDynamicSharedMemorySize, LDS_BYTES) != hipSuccess) { fprintf(stderr, "kernel_launch: hipFuncSetAttribute failed\n"); grid = -1; return; }
        if (hipOccupancyMaxActiveBlocksPerMultiprocessor(&per_cu, (const void*)mega_fwd, 512, LDS_BYTES) != hipSuccess || per_cu < 1) { fprintf(stderr, "kernel_launch: occupancy query says %d\n", per_cu); per_cu = 1; }
        (void)hipGetLastError();
        grid = cus * 1;
        if (grid <= 0) grid = 256;
    }
    if (grid < 0) return;
    (void)hipMemsetAsync((char*)d_ws + WS_CTL, 0, 1 * MiB, stream);
    Args a{};
    for (int i = 0; i < 22; ++i) a.in[i] = (const float*)d_in[i];
    a.out = (float*)d_out; a.ws = (unsigned char*)d_ws;
    for (int i = 0; i < 32; ++i) a.inv[i] = 1.0f / powf(10000.0f, (float)(2 * i) / 64.0f);
    for (int l = 0; l < 4; ++l) a.lam_init[l] = (float)(0.8 - 0.6 * exp(-0.3 * (double)l));
    for (int n = 0; n < 128; ++n) { int bkt;
        if (n < 16) bkt = n; else { const float nf = (float)n; const float v = logf(nf / 16.0f) / (float)log(8.0) * 16.0f; bkt = 16 + (int)v; if (bkt > 31) bkt = 31; }
        a.bucket[n] = (unsigned char)bkt; }
    {
        int di = 15, mi = 15;
        for (int e = 0; e < 32; ++e) { const float dc = di >= 0 ? 4.0f * (di + 1) : -1.f, mc = mi >= 0 ? 2.8f * (mi + 1) : -1.f;
            if (dc >= mc) { a.aq[e] = (unsigned short)((1 << 8) | di); --di; } else { a.aq[e] = (unsigned short)mi; --mi; } }
    }
#if MK_SPLIT
    for (int p = 0; p < N_PHASES; ++p) { a.ph_lo = p; a.ph_hi = p + 1; hipLaunchKernelGGL(mega_fwd, dim3(grid), dim3(512), LDS_BYTES, stream, a); }
#else
    a.ph_lo = 0; a.ph_hi = N_PHASES;
    void* args[] = {&a};
    hipError_t e = hipLaunchCooperativeKernel((const void*)mega_fwd, dim3(grid), dim3(512), args, LDS_BYTES, stream);
    if (e != hipSuccess) fprintf(stderr, "cooperative launch failed: %s (grid %d)\n", hipGetErrorString(e), grid);
#endif
}
```
